# Optimizing an MI355X kernel written in HIP

```python
import math
import jax, jax.numpy as jnp
from jax import lax
import numpy as np

D_MODEL = 1024
BATCH = 8
SEQ = 2048
DEPTH = 2

CHUNK = 64
Q_BLOCK = 128
EPS = 1e-6
GDN_HEADS = 4
GDN_DK = 128
GDN_DV = 128
GDN_QK_W = GDN_HEADS * GDN_DK
GDN_V_W = GDN_HEADS * GDN_DV
CONV_K = 4
MLA_HEADS = 8
MLA_NOPE = 64
MLA_ROPE = 32
MLA_V = 64
Q_LORA = 384
KV_LORA = 256
ROPE_THETA = 10000.0
N_BRANCH = 2
D_FF = 3584
N_EXPERTS = 8
TOP_K = 2
D_FF_EXPERT = 1792
N_DENSE = (DEPTH + 1) // 2
N_MOE = DEPTH // 2
SPLITS = [GDN_QK_W, GDN_QK_W, GDN_V_W, GDN_V_W, GDN_HEADS, GDN_HEADS,
          Q_LORA, KV_LORA, MLA_ROPE, N_BRANCH * D_MODEL]
IN_COLS = sum(SPLITS)

kernel_name = 'hybrid_gdn_mla_moe_streaming_block'

F32 = jnp.float32


def rmsnorm(x, w):
    xf = x.astype(F32)
    y = xf * lax.rsqrt(jnp.mean(xf * xf, axis=-1, keepdims=True) + EPS)
    return (y * w.astype(F32)).astype(x.dtype)


def l2norm(x):
    return x * lax.rsqrt(jnp.sum(x * x, axis=-1, keepdims=True) + EPS)


def rope(t, cos, sin):
    half = t.shape[-1] // 2
    t1, t2 = t[..., :half].astype(F32), t[..., half:].astype(F32)
    return jnp.concatenate([t1 * cos - t2 * sin, t2 * cos + t1 * sin], axis=-1).astype(t.dtype)


def causal_dwconv(x, w):
    c = x.shape[-1]
    return lax.conv_general_dilated(
        x, w[:, None, :].astype(x.dtype), window_strides=(1,), padding=[(CONV_K - 1, 0)],
        dimension_numbers=('NWC', 'WIO', 'NWC'), feature_group_count=c)


def gated_delta_chunked(q, k, v, g, beta):
    b, s, h, dk = q.shape
    dv = v.shape[-1]
    nc = s // CHUNK

    def chunks(t):
        return t.reshape(b, nc, CHUNK, h, -1).transpose(0, 1, 3, 2, 4)

    qc, kc, vc = chunks(q), chunks(k), chunks(v)
    gc = g.reshape(b, nc, CHUNK, h).transpose(0, 1, 3, 2)
    bc = beta.reshape(b, nc, CHUNK, h).transpose(0, 1, 3, 2)
    G = jnp.cumsum(gc, axis=-1)
    i = jnp.arange(CHUNK)
    incl = i[:, None] >= i[None, :]
    strict = i[:, None] > i[None, :]
    decay = jnp.exp(jnp.where(incl, G[..., :, None] - G[..., None, :], -jnp.inf))
    kb = kc * bc[..., None]
    lower = jnp.where(strict, jnp.einsum('bnhid,bnhjd->bnhij', kb, kc) * decay, 0.0)
    a_mat = lower + jnp.eye(CHUNK, dtype=F32)
    rhs = jnp.concatenate([vc * bc[..., None], kb * jnp.exp(G)[..., None]], axis=-1)
    sol = lax.linalg.triangular_solve(a_mat, rhs, left_side=True, lower=True, unit_diagonal=True)
    u, w = sol[..., :dv], sol[..., dv:]
    intra = jnp.einsum('bnhid,bnhjd->bnhij', qc, kc) * decay
    q_dec = qc * jnp.exp(G)[..., None]
    k_dec = kc * jnp.exp(G[..., -1:] - G)[..., None]
    chunk_decay = jnp.exp(G[..., -1])

    def step(state, inp):
        u_c, w_c, qd, kd, at, cd = inp
        v_new = u_c - jnp.einsum('bhcd,bhde->bhce', w_c, state)
        o = jnp.einsum('bhcd,bhde->bhce', qd, state) + jnp.einsum('bhij,bhje->bhie', at, v_new)
        state = state * cd[..., None, None] + jnp.einsum('bhcd,bhce->bhde', kd, v_new)
        return state, o

    xs = (jnp.moveaxis(u, 1, 0), jnp.moveaxis(w, 1, 0), jnp.moveaxis(q_dec, 1, 0),
          jnp.moveaxis(k_dec, 1, 0), jnp.moveaxis(intra, 1, 0), jnp.moveaxis(chunk_decay, 1, 0))
    s0 = jnp.zeros((b, h, dk, dv), F32)
    _, o = lax.scan(step, s0, xs)
    return o.transpose(1, 0, 3, 2, 4).reshape(b, s, h, dv)


def gdn_branch(q, k, v, z, a, bt, conv_w, a_log, dt_bias, out_norm):
    b, s, _ = q.shape
    qkv = jax.nn.silu(causal_dwconv(jnp.concatenate([q, k, v], axis=-1), conv_w))
    q = qkv[..., :GDN_QK_W].reshape(b, s, GDN_HEADS, GDN_DK).astype(F32)
    k = qkv[..., GDN_QK_W:2 * GDN_QK_W].reshape(b, s, GDN_HEADS, GDN_DK).astype(F32)
    v = qkv[..., 2 * GDN_QK_W:].reshape(b, s, GDN_HEADS, GDN_DV).astype(F32)
    q = l2norm(q) * (GDN_DK ** -0.5)
    k = l2norm(k)
    g = -jnp.exp(a_log.astype(F32)) * jax.nn.softplus(a.astype(F32) + dt_bias.astype(F32))
    beta = jax.nn.sigmoid(bt.astype(F32))
    o = gated_delta_chunked(q, k, v, g, beta)
    o = o * lax.rsqrt(jnp.mean(o * o, axis=-1, keepdims=True) + EPS) * out_norm.astype(F32)
    o = o * jax.nn.silu(z.reshape(b, s, GDN_HEADS, GDN_DV).astype(F32))
    return o.reshape(b, s, GDN_V_W).astype(z.dtype)


def chunk_causal_attention(q, k, v):
    b, s, h, dq = q.shape
    nb = s // Q_BLOCK
    scale = dq ** -0.5
    qb = q.reshape(b, nb, Q_BLOCK, h, dq).transpose(1, 0, 2, 3, 4)
    key_chunk = jnp.arange(s) // CHUNK

    def one_block(args):
        qi, bi = args
        sc = jnp.einsum('bqhd,bkhd->bhqk', qi, k).astype(F32) * scale
        q_chunk = (bi * Q_BLOCK + jnp.arange(Q_BLOCK)) // CHUNK
        mask = key_chunk[None, :] <= q_chunk[:, None]
        p = jax.nn.softmax(jnp.where(mask, sc, -jnp.inf), axis=-1)
        return jnp.einsum('bhqk,bkhe->bqhe', p.astype(v.dtype), v)

    o = lax.map(one_block, (qb, jnp.arange(nb)))
    return o.transpose(1, 0, 2, 3, 4).reshape(b, s, h, v.shape[-1])


def mla_branch(c_q, c_kv, k_r, cos, sin, q_a_norm, w_q_b, kv_a_norm, w_kv_b):
    b, s, _ = c_q.shape
    q = (rmsnorm(c_q, q_a_norm) @ w_q_b).reshape(b, s, MLA_HEADS, MLA_NOPE + MLA_ROPE)
    q_pe = rope(q[..., MLA_NOPE:], cos[:, :, None], sin[:, :, None])
    q = jnp.concatenate([q[..., :MLA_NOPE], q_pe], axis=-1)
    kv = (rmsnorm(c_kv, kv_a_norm) @ w_kv_b).reshape(b, s, MLA_HEADS, MLA_NOPE + MLA_V)
    k_pe = rope(k_r, cos, sin)
    k = jnp.concatenate(
        [kv[..., :MLA_NOPE], jnp.broadcast_to(k_pe[:, :, None, :], (b, s, MLA_HEADS, MLA_ROPE))], axis=-1)
    v = kv[..., MLA_NOPE:]
    o = chunk_causal_attention(q, k, v)
    return o.reshape(b, s, MLA_HEADS * MLA_V)


def swiglu(t, w1, w3, w2):
    return (jax.nn.silu(t @ w1) * (t @ w3)) @ w2


def moe_ffn(h, router_w, w1, w3, w2):
    b, s, d = h.shape
    t = h.reshape(-1, d)
    logits = (t @ router_w).astype(F32)
    top_logits, top_idx = lax.top_k(logits, TOP_K)
    top_w = jax.nn.softmax(top_logits, axis=-1)
    combine = jnp.sum(jax.nn.one_hot(top_idx, N_EXPERTS, dtype=F32) * top_w[..., None], axis=1)
    out = jnp.zeros_like(t)
    for e in range(N_EXPERTS):
        out = out + combine[:, e:e + 1].astype(t.dtype) * swiglu(t, w1[e], w3[e], w2[e])
    return out.reshape(b, s, d)


def setup_inputs(seed: int = 0) -> dict:
    key = jax.random.key(seed)
    ks = jax.random.split(key, 32)
    L = DEPTH

    def nrm(k, shape, fan_in):
        return jax.random.normal(k, shape, F32) * (fan_in ** -0.5)

    def gain(k, shape):
        return 1.0 + 0.02 * jax.random.normal(k, shape, F32)

    x = jax.random.normal(ks[0], (BATCH, SEQ, D_MODEL), F32)
    gaps = jax.random.randint(ks[1], (BATCH, SEQ), 1, 4, dtype=jnp.int32)
    positions = (jnp.cumsum(gaps, axis=1) - gaps[:, :1]).astype(jnp.int32)
    dt = jnp.exp(jax.random.uniform(ks[7], (L, GDN_HEADS), F32, math.log(1e-3), math.log(1e-1)))
    return {
        'x': x,
        'positions': positions,
        'mix_norm': gain(ks[2], (L, D_MODEL)),
        'w_in': nrm(ks[3], (L, D_MODEL, IN_COLS), D_MODEL),
        'gate_bias': 0.01 * jax.random.normal(ks[4], (L, N_BRANCH * D_MODEL), F32),
        'conv_w': nrm(ks[5], (L, CONV_K, 2 * GDN_QK_W + GDN_V_W), CONV_K),
        'a_log': jnp.log(jax.random.uniform(ks[6], (L, GDN_HEADS), F32, 1.0, 16.0)),
        'dt_bias': dt + jnp.log(-jnp.expm1(-dt)),
        'gdn_out_norm': gain(ks[8], (L, GDN_DV)),
        'w_gdn_o': nrm(ks[9], (L, GDN_V_W, D_MODEL), GDN_V_W),
        'q_a_norm': gain(ks[10], (L, Q_LORA)),
        'w_q_b': nrm(ks[11], (L, Q_LORA, MLA_HEADS * (MLA_NOPE + MLA_ROPE)), Q_LORA),
        'kv_a_norm': gain(ks[12], (L, KV_LORA)),
        'w_kv_b': nrm(ks[13], (L, KV_LORA, MLA_HEADS * (MLA_NOPE + MLA_V)), KV_LORA),
        'w_mla_o': nrm(ks[14], (L, MLA_HEADS * MLA_V, D_MODEL), MLA_HEADS * MLA_V),
        'w_out': nrm(ks[15], (L, D_MODEL, D_MODEL), D_MODEL),
        'ffn_norm': gain(ks[16], (L, D_MODEL)),
        'dense_w1': nrm(ks[17], (N_DENSE, D_MODEL, D_FF), D_MODEL),
        'dense_w3': nrm(ks[18], (N_DENSE, D_MODEL, D_FF), D_MODEL),
        'dense_w2': nrm(ks[19], (N_DENSE, D_FF, D_MODEL), D_FF),
        'router_w': nrm(ks[20], (N_MOE, D_MODEL, N_EXPERTS), D_MODEL),
        'moe_w1': nrm(ks[21], (N_MOE, N_EXPERTS, D_MODEL, D_FF_EXPERT), D_MODEL),
        'moe_w3': nrm(ks[22], (N_MOE, N_EXPERTS, D_MODEL, D_FF_EXPERT), D_MODEL),
        'moe_w2': nrm(ks[23], (N_MOE, N_EXPERTS, D_FF_EXPERT, D_MODEL), D_FF_EXPERT),
        'final_norm': gain(ks[24], (D_MODEL,)),
    }


def reference(x, positions, mix_norm, w_in, gate_bias, conv_w, a_log, dt_bias, gdn_out_norm,
              w_gdn_o, q_a_norm, w_q_b, kv_a_norm, w_kv_b, w_mla_o, w_out, ffn_norm,
              dense_w1, dense_w3, dense_w2, router_w, moe_w1, moe_w3, moe_w2, final_norm):
    split_idx = np.cumsum(SPLITS)[:-1].tolist()
    inv_freq = 1.0 / (ROPE_THETA ** (jnp.arange(0, MLA_ROPE, 2, dtype=F32) / MLA_ROPE))
    ang = positions.astype(F32)[..., None] * inv_freq
    cos, sin = jnp.cos(ang), jnp.sin(ang)
    for l in range(DEPTH):
        h = rmsnorm(x, mix_norm[l])
        proj = h @ w_in[l]
        q_g, k_g, v_g, z_g, a_g, b_g, c_q, c_kv, k_r, gate = jnp.split(proj, split_idx, axis=-1)
        o_a = gdn_branch(q_g, k_g, v_g, z_g, a_g, b_g, conv_w[l], a_log[l], dt_bias[l],
                         gdn_out_norm[l]) @ w_gdn_o[l]
        o_b = mla_branch(c_q, c_kv, k_r, cos, sin, q_a_norm[l], w_q_b[l], kv_a_norm[l],
                         w_kv_b[l]) @ w_mla_o[l]
        g = jax.nn.sigmoid((gate + gate_bias[l]).astype(F32)).astype(x.dtype)
        merged = g[..., :D_MODEL] * o_a + g[..., D_MODEL:] * o_b
        x = x + merged @ w_out[l]
        h2 = rmsnorm(x, ffn_norm[l])
        if l % 2 == 0:
            x = x + swiglu(h2, dense_w1[l // 2], dense_w3[l // 2], dense_w2[l // 2])
        else:
            x = x + moe_ffn(h2, router_w[l // 2], moe_w1[l // 2], moe_w3[l // 2], moe_w2[l // 2])
    return rmsnorm(x, final_norm)
```

```cpp
#define MEGA_MASK 0xFFF
#define ONE_LAUNCH 1
#include <hip/hip_runtime.h>
#include <stdint.h>

typedef unsigned short bf16_t;
#define DI __device__ __forceinline__
#define GAS __attribute__((address_space(1)))
#define LAS __attribute__((address_space(3)))
typedef short bf16x8 __attribute__((ext_vector_type(8)));
typedef short s16x4 __attribute__((ext_vector_type(4)));
typedef float f32x2 __attribute__((ext_vector_type(2)));
typedef float f32x4 __attribute__((ext_vector_type(4)));
typedef float f32x16 __attribute__((ext_vector_type(16)));
typedef unsigned u32x2 __attribute__((ext_vector_type(2)));
typedef unsigned u32x4 __attribute__((ext_vector_type(4)));
typedef GAS unsigned gu32;
#define RLX_AGENT __ATOMIC_RELAXED, __HIP_MEMORY_SCOPE_AGENT
#define LDS_WAIT() asm volatile("s_waitcnt lgkmcnt(0)" ::: "memory")
#define VM_WAIT() asm volatile("s_waitcnt vmcnt(0)" ::: "memory")

DI float bf2f(bf16_t v) { return __uint_as_float(((unsigned)v) << 16); }
DI unsigned f2bf(float f) { unsigned u = __float_as_uint(f); return (u + 0x7fffu + ((u >> 16) & 1u)) >> 16; }
DI unsigned pk2(float lo, float hi) { return f2bf(lo) | (f2bf(hi) << 16); }
DI float bflo(unsigned w) { return __uint_as_float(w << 16); }
DI float bfhi(unsigned w) { return __uint_as_float(w & 0xffff0000u); }
DI float siluf(float x) { return x * __builtin_amdgcn_rcpf(1.f + __expf(-x)); }
DI float sigmf(float x) { return __builtin_amdgcn_rcpf(1.f + __expf(-x)); }
DI void lds_barrier() { asm volatile("s_waitcnt lgkmcnt(0)" ::: "memory"); __builtin_amdgcn_s_barrier(); asm volatile("" ::: "memory"); }
DI int lane_id_asm() { int l; asm volatile("v_mbcnt_lo_u32_b32 %0, -1, 0\n\tv_mbcnt_hi_u32_b32 %0, -1, %0" : "=v"(l)); return l; }
template <int K> DI float swz_xor(float v) { return __int_as_float(__builtin_amdgcn_ds_swizzle(__float_as_int(v), (K << 10) | 0x1F)); }
DI float xor32_sum(float v) { const auto rr = __builtin_amdgcn_permlane32_swap(__float_as_uint(v), __float_as_uint(v), false, false); return __uint_as_float(rr[0]) + __uint_as_float(rr[1]); }
DI float wave_sum(float v) {
    v += swz_xor<1>(v); v += swz_xor<2>(v); v += swz_xor<4>(v); v += swz_xor<8>(v); v += swz_xor<16>(v);
    return xor32_sum(v);
}

constexpr int M = 16384, D = 1024, SEQ = 2048, NBATCH = 8;
constexpr int IN_COLS = 4776;
constexpr int NPROJ = 4864;
constexpr int MC_CQ = 0, MC_CKV = 384, MC_KR = 640, MC_A = 672, MC_B = 676, MISC_LD = 768;
constexpr int QKV_LD = 1536, Z_LD = 512, GATE_LD = 2048;
constexpr int WC_Q = 0, WC_Z = 1536, WC_A = 2048, WC_B = 2052, WC_CQ = 2056, WC_CKV = 2440, WC_KR = 2696, WC_GATE = 2728;
constexpr int D_FF = 3584, NE = 8, DFE = 1792;
constexpr int MOE_ROWS = 34816;
constexpr float EPS = 1e-6f;
constexpr float QSCALE = 0.10206207261596575f * 1.4426950408889634f;
constexpr int NCHUNK = 32;

constexpr size_t MiB = 1u << 20, KiB = 1u << 10;
constexpr size_t WS_CTL = 0, CTL_ZERO_BYTES = 256 * KiB;
constexpr size_t WS_WIN = 1 * MiB;
constexpr size_t WIN_STRIDE = (size_t)NPROJ * 1024 * 2;
constexpr size_t WS_WGDNO = 20 * MiB;
constexpr size_t WS_WMLAO = 22 * MiB;
constexpr size_t WS_WOUT = 24 * MiB;
constexpr size_t WS_WQB = 28 * MiB;
constexpr size_t WS_WKVB = 29 * MiB + 512 * KiB;
constexpr size_t WS_WD13 = 31 * MiB;
constexpr size_t WS_WD2 = 45 * MiB;
constexpr size_t WS_WM2 = 1 * MiB;
constexpr size_t WS_GATE = 53 * MiB;
constexpr size_t WS_Z = 117 * MiB;
constexpr size_t WS_MISC = 133 * MiB;
constexpr size_t WS_QKV = 157 * MiB;
constexpr size_t WS_Q = 157 * MiB;
constexpr size_t WS_K = 181 * MiB;
constexpr size_t WS_GDNL = 205 * MiB;
constexpr size_t WS_UT = 205 * MiB, WS_W = 221 * MiB, WS_QD = 237 * MiB, WS_KDT = 253 * MiB, WS_AT = 269 * MiB;
constexpr size_t WS_V = 205 * MiB;
constexpr size_t WS_AO = 221 * MiB;
constexpr size_t WS_GO = 237 * MiB;
constexpr size_t WS_QN = 205 * MiB, WS_KN = 221 * MiB, WS_VN = 237 * MiB, WS_QRAW = 253 * MiB;
constexpr size_t WS_XB = 277 * MiB;
constexpr float W8_SCALE = 32.f, H8_SCALE = 4.f;
#ifndef DENSE_UP_FP8
#define DENSE_UP_FP8 0
#endif
#ifndef DENSE_DN_FP8
#define DENSE_DN_FP8 0
#endif
constexpr float W8S_UNUSED = 32.f;
constexpr size_t OUT_XN = 32 * MiB;
constexpr size_t WS_XN_UNUSED = 277 * MiB;
constexpr size_t WS_ORAW = 277 * MiB;
constexpr size_t WS_MERGED = 277 * MiB;
constexpr size_t WS_HB = 53 * MiB;
constexpr size_t WS_XG = 85 * MiB;
constexpr size_t WS_Y = 85 * MiB;
constexpr size_t WS_H = 153 * MiB;
constexpr size_t WS_MOE = 309 * MiB;
constexpr size_t WS_COS = 311 * MiB, WS_SIN = 312 * MiB;
constexpr size_t WS_RSTD = 313 * MiB;
constexpr size_t WS_CD = 313 * MiB + 256 * KiB;
constexpr size_t WS_GB = 313 * MiB + 512 * KiB;
constexpr size_t WS_END = 314 * MiB;
constexpr int CW_CNT = 64;
constexpr int CW_BAR = 4096;
constexpr int CW_CMAX = 32768;
constexpr size_t WS_SA = 314 * MiB;
#ifndef I8_INPROJ
#define I8_INPROJ 1
#endif
#ifndef I8_DUP
#define I8_DUP 1
#endif
namespace pg8 {
constexpr int BM = 256, BK = 64, HALF = 128, HTB = HALF * BK * 2  , STAGE_BYTES = 8 * HTB, NXCD = 8, WGM = 8;

__host__ __device__ __forceinline__ int lds_byte(int r, int c) { const int st = (r >> 4) * 2 + (c >> 5), rr = r & 15, cc = c & 31, ob = rr * 64 + cc * 2; return st * 1024 + (ob ^ (((ob >> 9) & 1) << 5)); }
__host__ __device__ __forceinline__ void stage_rc(int b, int& R, int& C) { const int st = b / 1024, sb = b % 1024, swz = sb ^ (((sb >> 9) & 1) << 5); R = (st >> 1) * 16 + swz / 64; C = (st & 1) * 32 + (swz % 64) / 2; }
__host__ __device__ __forceinline__ int perm32(int rho) { const int n = rho >> 4, i = rho & 15; return 8 * (i >> 2) + 4 * n + (i & 3); }

struct Unit { int pm, pn; size_t boff; size_t aoff; int kind; };
struct Gemm { const bf16_t* A; const bf16_t* Bt; int lda, K; const float* sA; const float* sB; };

struct StaticOrder {
    static constexpr bool GATHER = false;
    int nM, nN, nwg, G, c;
    __device__ void init(int Mr, int N, int G_, int c_) { nM = Mr / BM; nN = N / BM; nwg = nM * nN; G = G_; c = c_; }
    __device__ bool next(int i, Unit& u) const {
        const long L = (long)i * G + c; if (L >= nwg) return false;
        int wgid = (int)L; { const int q = nwg / NXCD, r = nwg % NXCD, xcd = wgid % NXCD, off = wgid / NXCD; wgid = (xcd < r ? xcd * (q + 1) : r * (q + 1) + (xcd - r) * q) + off; }
        const int nig = WGM * nN, gid = wgid / nig, fm = gid * WGM, gsz = (nM - fm) < WGM ? (nM - fm) : WGM;
        u.pm = fm + ((wgid % nig) % gsz); u.pn = (wgid % nig) / gsz; u.boff = 0; u.aoff = 0; u.kind = 0; return true;
    }
    __device__ __forceinline__ void a_ready(const Unit&) const {}
    __device__ __forceinline__ void done(const Unit&) const {}
};
struct TwoSegOrder {
    static constexpr bool GATHER = false;
    StaticOrder so; size_t aoff1, boff1;
    __device__ void init(int Mr, int N, int G_, int c_, size_t aoff1_, size_t boff1_) { so.init(Mr, N, G_, c_); aoff1 = aoff1_; boff1 = boff1_; }
    __device__ bool next(int i, Unit& u) const {
        if (!so.next(i >> 1, u)) return false;
        const int sgm = i & 1; u.kind = sgm; u.aoff = sgm ? aoff1 : 0; u.boff = sgm ? 0 : boff1; return true;
    }
    __device__ __forceinline__ void a_ready(const Unit&) const {}
    __device__ __forceinline__ void done(const Unit&) const {}
};
DI void load_counts8(const unsigned* cnt, int (&cn)[8]) {
    const int l = lane_id_asm();
    const int v = (int)__hip_atomic_load(cnt + (l & 7), __ATOMIC_RELAXED, __HIP_MEMORY_SCOPE_AGENT);
#pragma unroll
    for (int e = 0; e < 8; ++e) cn[e] = __builtin_amdgcn_readlane(v, e);
}
struct MoeOrder {
    static constexpr bool GATHER = false;
    int nN, G, c, nunits; int o1, o2, o3, o4, o5, o6, o7; size_t estride;
    __device__ void init(const unsigned* cnt, int N, int G_, int c_, size_t estride_) {
        nN = N / BM; G = G_; c = c_; estride = estride_;
        int o[9]; int a = 0; int cn8[8]; load_counts8(cnt, cn8);
#pragma unroll
        for (int e = 0; e < 8; ++e) { o[e] = a; a += (cn8[e] + 255) & ~255; }
        o[8] = a;
        o1 = o[1]; o2 = o[2]; o3 = o[3]; o4 = o[4]; o5 = o[5]; o6 = o[6]; o7 = o[7];
        nunits = (a / BM) * nN;
    }
    __device__ bool next(int i, Unit& u) const {
        const long L = (long)i * G + c; if (L >= nunits) return false;
        const int rt = (int)L / nN, pn = (int)L % nN, r0 = rt * BM;
        const int e = (r0 >= o1) + (r0 >= o2) + (r0 >= o3) + (r0 >= o4) + (r0 >= o5) + (r0 >= o6) + (r0 >= o7);
        u.pm = rt; u.pn = pn; u.boff = (size_t)e * estride; u.aoff = 0; u.kind = e; return true;
    }
    __device__ __forceinline__ void a_ready(const Unit&) const {}
    __device__ __forceinline__ void done(const Unit&) const {}
};

struct MoeGatherOrder {
    static constexpr bool GATHER = true;
    int nN, G, c, nunits; int o[9]; int cn[8]; size_t estride; const int* list; int rowbytes;
    __device__ void init(const unsigned* cnt, const int* list_, int N, int G_, int c_, size_t estride_, int rowbytes_) {
        nN = N / BM; G = G_; c = c_; estride = estride_; list = list_; rowbytes = rowbytes_;
        int a = 0; load_counts8(cnt, cn);
#pragma unroll
        for (int e = 0; e < 8; ++e) { o[e] = a; a += (cn[e] + 255) & ~255; }
        o[8] = a; nunits = (a / BM) * nN;
    }
    __device__ bool next(int i, Unit& u) const {
        const long L = (long)i * G + c; if (L >= nunits) return false;
        const int rt = (int)L / nN, pn = (int)L % nN, r0 = rt * BM;
        int e = 0;
#pragma unroll
        for (int k = 1; k < 8; ++k) e += (r0 >= o[k]);
        u.pm = rt; u.pn = pn; u.boff = (size_t)e * estride; u.aoff = 0; u.kind = e; return true;
    }
    __device__ __forceinline__ unsigned row_off(const Unit& u, int R) const {
        int oe = 0, ce = 0;
#pragma unroll
        for (int k = 0; k < 8; ++k) if (u.kind == k) { oe = o[k]; ce = cn[k]; }
        const int p = u.pm * BM + R - oe;
        const int tok = (p < ce) ? (list[(size_t)u.kind * 16384 + p] >> 1) : 0;
        return (unsigned)tok * (unsigned)rowbytes;
    }
    __device__ __forceinline__ void a_ready(const Unit&) const {}
    __device__ __forceinline__ void done(const Unit&) const {}
};

DI unsigned cvt_pk_bf16(float lo, float hi) { unsigned r; asm volatile("v_cvt_pk_bf16_f32 %0, %1, %2" : "=v"(r) : "v"(lo), "v"(hi)); return r; }
DI u32x4 pack8(const f32x4 v0, const f32x4 v1) { u32x4 w; w.x = cvt_pk_bf16(v0[0], v0[1]); w.y = cvt_pk_bf16(v0[2], v0[3]); w.z = cvt_pk_bf16(v1[0], v1[1]); w.w = cvt_pk_bf16(v1[2], v1[3]); return w; }
DI f32x4 sig4(f32x4 v) { f32x4 r; r[0] = sigmf(v[0]); r[1] = sigmf(v[1]); r[2] = sigmf(v[2]); r[3] = sigmf(v[3]); return r; }
DI f32x4 silu4(f32x4 v) { f32x4 r; r[0] = siluf(v[0]); r[1] = siluf(v[1]); r[2] = siluf(v[2]); r[3] = siluf(v[3]); return r; }

typedef const f32x4 (&AccRef)[2][2][4][2];
typedef int i32x4_t __attribute__((ext_vector_type(4)));

struct EpiInProj {
    static constexpr bool AFTER_DRAIN = false; static constexpr bool TWOSEG = false; static constexpr bool PERM = true;
    bf16_t *QKV, *Z, *MISC, *GATE; const float* bias;
    DI void operator()(AccRef acc, const Unit& u, int wr, int wc, int fr, int fq) const {
        const int pn = u.pn; const int row0 = u.pm * BM + wr * 64 + fr;
        if (pn >= 11) {
            const int j = pn - 11, c0 = j * HALF + wc * 32 + 8 * fq;
            f32x4 ba[2], bb[2];
#pragma unroll
            for (int n = 0; n < 2; ++n) { ba[n] = *(const f32x4*)(bias + c0 + 4 * n); bb[n] = *(const f32x4*)(bias + 1024 + c0 + 4 * n); }
#pragma unroll
            for (int ai = 0; ai < 2; ++ai)
#pragma unroll
                for (int m = 0; m < 4; ++m) { bf16_t* rowp = GATE + (size_t)(row0 + ai * HALF + m * 16) * GATE_LD + c0;
                    f32x4 ga0 = sig4(acc[ai][0][m][0] + ba[0]), ga1 = sig4(acc[ai][0][m][1] + ba[1]);
                    f32x4 gb0 = sig4(acc[ai][1][m][0] + bb[0]), gb1 = sig4(acc[ai][1][m][1] + bb[1]);
                    const u32x4 wa = pack8(ga0, ga1);
                    f32x4 ra0, ra1; ra0[0] = bflo(wa.x); ra0[1] = bfhi(wa.x); ra0[2] = bflo(wa.y); ra0[3] = bfhi(wa.y); ra1[0] = bflo(wa.z); ra1[1] = bfhi(wa.z); ra1[2] = bflo(wa.w); ra1[3] = bfhi(wa.w);
#pragma unroll
                    for (int i = 0; i < 4; ++i) { gb0[i] *= __builtin_amdgcn_rcpf(ra0[i]); gb1[i] *= __builtin_amdgcn_rcpf(ra1[i]); }
                    __builtin_nontemporal_store(wa, (u32x4*)rowp); __builtin_nontemporal_store(pack8(gb0, gb1), (u32x4*)(rowp + 1024));
                    asm volatile("" ::: "memory"); }
            return;
        }
        bf16_t* base; int ld, colt;
        if (pn < 6) { base = QKV; ld = QKV_LD; colt = pn * 256; }
        else if (pn < 8) { base = Z; ld = Z_LD; colt = (pn - 6) * 256; }
        else { base = MISC; ld = MISC_LD; colt = (pn - 8) * 256; }
        const int col0 = colt + wc * 32 + 8 * fq;
#pragma unroll
        for (int ai = 0; ai < 2; ++ai)
#pragma unroll
            for (int m = 0; m < 4; ++m) { bf16_t* rowp = base + (size_t)(row0 + ai * HALF + m * 16) * ld + col0;
#pragma unroll
                for (int bj = 0; bj < 2; ++bj) *(u32x4*)(rowp + bj * HALF) = pack8(acc[ai][bj][m][0], acc[ai][bj][m][1]);
                asm volatile("" ::: "memory"); }
    }
};
struct EpiQRope {
    static constexpr bool AFTER_DRAIN = false; static constexpr bool TWOSEG = false; static constexpr bool PERM = false;
    bf16_t* Q; const float* rstd; const float* COS; const float* SIN;
    DI void operator()(AccRef acc, const Unit& u, int wr, int wc, int fr, int fq) const {
        const int row0 = u.pm * BM + wr * 64 + fr;
#pragma unroll
        for (int ai = 0; ai < 2; ++ai) {
            float scv[4]; f32x4 csv[4], snv[4];
#pragma unroll
            for (int m = 0; m < 4; ++m) { const int row = row0 + ai * HALF + m * 16; scv[m] = rstd[row]; csv[m] = *(const f32x4*)(COS + (size_t)row * 16 + 4 * fq); snv[m] = *(const f32x4*)(SIN + (size_t)row * 16 + 4 * fq); }
#pragma unroll
            for (int m = 0; m < 4; ++m) {
                const int row = row0 + ai * HALF + m * 16;
                const float sc = scv[m] * QSCALE;
                const f32x4 cs = csv[m], sn = snv[m];
#pragma unroll
                for (int bj = 0; bj < 2; ++bj) {
                    const int gi = 8 * u.pn + 4 * bj + wc;
                    f32x4 v0 = acc[ai][bj][m][0] * sc, v1 = acc[ai][bj][m][1] * sc;
                    if (gi % 3 == 2) { const f32x4 o0 = v0 * cs - v1 * sn, o1 = v1 * cs + v0 * sn; v0 = o0; v1 = o1; }
                    bf16_t* p = Q + (size_t)row * 768 + gi * 32 + 4 * fq;
                    u32x2 w0, w1; w0.x = cvt_pk_bf16(v0[0], v0[1]); w0.y = cvt_pk_bf16(v0[2], v0[3]); w1.x = cvt_pk_bf16(v1[0], v1[1]); w1.y = cvt_pk_bf16(v1[2], v1[3]);
                    *(u32x2*)p = w0; *(u32x2*)(p + 16) = w1;
                }
            }
            asm volatile("" ::: "memory");
        }
    }
};
struct EpiKV {
    static constexpr bool AFTER_DRAIN = true; static constexpr bool TWOSEG = false; static constexpr bool PERM = true;
    bf16_t* K; bf16_t* V; const float* rstd;
    DI void operator()(AccRef, const Unit&, int, int, int, int) const {}
    DI void after(AccRef acc, const Unit& u, int wr, int wc, int fr, int fq, LAS unsigned char* lds, int tid) const {
#pragma unroll
        for (int ai = 0; ai < 2; ++ai)
#pragma unroll
            for (int m = 0; m < 4; ++m) { const int r = wr * 64 + ai * HALF + m * 16 + fr; const float sc = rstd[u.pm * BM + r];
#pragma unroll
                for (int bj = 0; bj < 2; ++bj) *(LAS u32x4*)(lds + r * 528 + (bj * HALF + wc * 32 + 8 * fq) * 2) = pack8(acc[ai][bj][m][0] * sc, acc[ai][bj][m][1] * sc); }
        asm volatile("s_waitcnt lgkmcnt(0)" ::: "memory"); __builtin_amdgcn_s_barrier(); asm volatile("" ::: "memory");
        const int ch = tid & 31, r0 = tid >> 5;
#pragma unroll 4
        for (int i = 0; i < 16; ++i) {
            const int r = r0 + 16 * i;
            const u32x4 a = *(const LAS u32x4*)(lds + r * 528 + ch * 16);
            const size_t row = (size_t)(u.pm * BM + r); const int c = (u.pn & 1) * 256 + ch * 8;
            bf16_t* p = (u.pn < 2) ? K + row * 768 + (c >> 6) * 96 + (c & 63) : V + row * 512 + c;
            *(u32x4*)p = a;
        }
    }
};
template <int MODE> struct EpiMerge {
    static constexpr bool AFTER_DRAIN = false; static constexpr bool TWOSEG = false; static constexpr bool PERM = true;
    bf16_t* MG; const bf16_t* GATE;
    DI void operator()(AccRef acc, const Unit& u, int wr, int wc, int fr, int fq) const {
        const int row0 = u.pm * BM + wr * 64 + fr, col0 = u.pn * BM + wc * 32 + 8 * fq;
#pragma unroll
        for (int ai = 0; ai < 2; ++ai)
#pragma unroll
            for (int m = 0; m < 4; ++m) { const size_t row = (size_t)(row0 + ai * HALF + m * 16);
#pragma unroll
                for (int bj = 0; bj < 2; ++bj) {
                    const u32x4 g = *(const u32x4*)(GATE + row * GATE_LD + MODE * 1024 + col0 + bj * HALF);
                    bf16_t* p = MG + row * 1024 + col0 + bj * HALF;
                    f32x4 v0 = acc[ai][bj][m][0], v1 = acc[ai][bj][m][1];
                    v0[0] *= bflo(g.x); v0[1] *= bfhi(g.x); v0[2] *= bflo(g.y); v0[3] *= bfhi(g.y);
                    v1[0] *= bflo(g.z); v1[1] *= bfhi(g.z); v1[2] *= bflo(g.w); v1[3] *= bfhi(g.w);
                    if (MODE == 1) { const u32x4 o = *(const u32x4*)p;
                        v0[0] += bflo(o.x); v0[1] += bfhi(o.x); v0[2] += bflo(o.y); v0[3] += bfhi(o.y);
                        v1[0] += bflo(o.z); v1[1] += bfhi(o.z); v1[2] += bflo(o.w); v1[3] += bfhi(o.w); }
                    *(u32x4*)p = pack8(v0, v1);
                }
                asm volatile("" ::: "memory");
            }
    }
};
struct EpiMerge2 {
    static constexpr bool AFTER_DRAIN = true; static constexpr bool TWOSEG = true; static constexpr bool PERM = true;
    bf16_t* MG; const bf16_t* GATE;
    DI void mid(f32x4 (&acc)[2][2][4][2], const Unit& u, int wr, int wc, int fr, int fq) const {
        const int row0 = u.pm * BM + wr * 64 + fr, col0 = u.pn * BM + wc * 32 + 8 * fq;
#pragma unroll
        for (int ai = 0; ai < 2; ++ai) {
            u32x4 rr[4][2];
#pragma unroll
            for (int m = 0; m < 4; ++m)
#pragma unroll
                for (int bj = 0; bj < 2; ++bj) rr[m][bj] = *(const u32x4*)(GATE + (size_t)(row0 + ai * HALF + m * 16) * GATE_LD + 1024 + col0 + bj * HALF);
#pragma unroll
            for (int m = 0; m < 4; ++m)
#pragma unroll
                for (int bj = 0; bj < 2; ++bj) { const u32x4 r = rr[m][bj];
                    f32x4& v0 = acc[ai][bj][m][0]; f32x4& v1 = acc[ai][bj][m][1];
                    v0[0] *= bflo(r.x); v0[1] *= bfhi(r.x); v0[2] *= bflo(r.y); v0[3] *= bfhi(r.y);
                    v1[0] *= bflo(r.z); v1[1] *= bfhi(r.z); v1[2] *= bflo(r.w); v1[3] *= bfhi(r.w); }
            asm volatile("" ::: "memory"); }
    }
    DI void operator()(AccRef, const Unit&, int, int, int, int) const {}
    DI void after(AccRef acc, const Unit& u, int wr, int wc, int fr, int fq, LAS unsigned char* lds, int tid) const {
#pragma unroll
        for (int ai = 0; ai < 2; ++ai)
#pragma unroll
            for (int m = 0; m < 4; ++m) { const int r = wr * 64 + ai * HALF + m * 16 + fr;
#pragma unroll
                for (int bj = 0; bj < 2; ++bj) *(LAS u32x4*)(lds + r * 528 + (bj * HALF + wc * 32 + 8 * fq) * 2) = pack8(acc[ai][bj][m][0], acc[ai][bj][m][1]); }
        asm volatile("s_waitcnt lgkmcnt(0)" ::: "memory"); __builtin_amdgcn_s_barrier(); asm volatile("" ::: "memory");
        const int ch = tid & 31, r0 = tid >> 5;
        u32x4 gg[16];
#pragma unroll
        for (int i = 0; i < 16; ++i) gg[i] = *(const u32x4*)(GATE + (size_t)(u.pm * BM + r0 + 16 * i) * GATE_LD + u.pn * BM + ch * 8);
#pragma unroll
        for (int i = 0; i < 16; ++i) {
            const int r = r0 + 16 * i;
            const u32x4 a = *(const LAS u32x4*)(lds + r * 528 + ch * 16);
            const size_t row = (size_t)(u.pm * BM + r); const int col = u.pn * BM + ch * 8;
            const u32x4 g = gg[i];
            f32x4 v0, v1; v0[0] = bflo(a.x) * bflo(g.x); v0[1] = bfhi(a.x) * bfhi(g.x); v0[2] = bflo(a.y) * bflo(g.y); v0[3] = bfhi(a.y) * bfhi(g.y);
            v1[0] = bflo(a.z) * bflo(g.z); v1[1] = bfhi(a.z) * bfhi(g.z); v1[2] = bflo(a.w) * bflo(g.w); v1[3] = bfhi(a.w) * bfhi(g.w);
            *(u32x4*)(MG + row * 1024 + col) = pack8(v0, v1);
        }
    }
};
struct EpiResid {
    static constexpr bool AFTER_DRAIN = false; static constexpr bool TWOSEG = false; static constexpr bool PERM = false;
    const float* res; float* out;
    DI void operator()(AccRef acc, const Unit& u, int wr, int wc, int fr, int fq) const {
        const int row0 = u.pm * BM + wr * 64 + fr, col0 = u.pn * BM + wc * 32 + 4 * fq;
#pragma unroll
        for (int ai = 0; ai < 2; ++ai)
#pragma unroll
            for (int m = 0; m < 4; ++m) { const size_t off = (size_t)(row0 + ai * HALF + m * 16) * D + col0;
#pragma unroll
                for (int bj = 0; bj < 2; ++bj)
#pragma unroll
                    for (int n = 0; n < 2; ++n) { const f32x4 r = *(const f32x4*)(res + off + bj * HALF + n * 16); *(f32x4*)(out + off + bj * HALF + n * 16) = r + acc[ai][bj][m][n]; }
                asm volatile("" ::: "memory"); }
    }
};
template <bool RES_F32> struct EpiResidB {
    static constexpr bool AFTER_DRAIN = true; static constexpr bool TWOSEG = false; static constexpr bool PERM = true;
    const void* res; bf16_t* out; float scale;
    DI void operator()(AccRef, const Unit&, int, int, int, int) const {}
    DI void after(AccRef acc, const Unit& u, int wr, int wc, int fr, int fq, LAS unsigned char* lds, int tid) const {
#pragma unroll
        for (int ai = 0; ai < 2; ++ai)
#pragma unroll
            for (int m = 0; m < 4; ++m) { const int r = wr * 64 + ai * HALF + m * 16 + fr;
#pragma unroll
                for (int bj = 0; bj < 2; ++bj) *(LAS u32x4*)(lds + r * 528 + (bj * HALF + wc * 32 + 8 * fq) * 2) = pack8(acc[ai][bj][m][0] * scale, acc[ai][bj][m][1] * scale); }
        asm volatile("s_waitcnt lgkmcnt(0)" ::: "memory"); __builtin_amdgcn_s_barrier(); asm volatile("" ::: "memory");
        const int ch = tid & 31, r0 = tid >> 5;
#pragma unroll
        for (int i0 = 0; i0 < 16; i0 += 8) {
        f32x4 rf[RES_F32 ? 8 : 1][2]; u32x4 rb[RES_F32 ? 1 : 8];
#pragma unroll
        for (int i = 0; i < 8; ++i) { const size_t off = (size_t)(u.pm * BM + r0 + 16 * (i0 + i)) * D + u.pn * BM + ch * 8;
            if (RES_F32) { const float* rp = (const float*)res + off; rf[RES_F32 ? i : 0][0] = __builtin_nontemporal_load((const f32x4*)rp); rf[RES_F32 ? i : 0][1] = __builtin_nontemporal_load((const f32x4*)(rp + 4)); }
            else rb[RES_F32 ? 0 : i] = *(const u32x4*)((const bf16_t*)res + off); }
#pragma unroll
        for (int i = 0; i < 8; ++i) {
            const int r = r0 + 16 * (i0 + i);
            const u32x4 a = *(const LAS u32x4*)(lds + r * 528 + ch * 16);
            const size_t off = (size_t)(u.pm * BM + r) * D + u.pn * BM + ch * 8;
            f32x4 v0, v1; v0[0] = bflo(a.x); v0[1] = bfhi(a.x); v0[2] = bflo(a.y); v0[3] = bfhi(a.y); v1[0] = bflo(a.z); v1[1] = bfhi(a.z); v1[2] = bflo(a.w); v1[3] = bfhi(a.w);
            if (RES_F32) { v0 = v0 + rf[RES_F32 ? i : 0][0]; v1 = v1 + rf[RES_F32 ? i : 0][1]; }
            else { const u32x4 rr = rb[RES_F32 ? 0 : i];
                v0[0] += bflo(rr.x); v0[1] += bfhi(rr.x); v0[2] += bflo(rr.y); v0[3] += bfhi(rr.y); v1[0] += bflo(rr.z); v1[1] += bfhi(rr.z); v1[2] += bflo(rr.w); v1[3] += bfhi(rr.w); }
            *(u32x4*)(out + off) = pack8(v0, v1);
        }
        }
    }
};
struct EpiSwiGLU {
    static constexpr bool AFTER_DRAIN = false; static constexpr bool TWOSEG = false; static constexpr bool PERM = true;
    bf16_t* H; int ldh; float scale; float oscale;
    DI void operator()(AccRef acc, const Unit& u, int wr, int wc, int fr, int fq) const {
        const int row0 = u.pm * BM + wr * 64 + fr, col0 = u.pn * HALF + wc * 32 + 8 * fq;
#pragma unroll
        for (int ai = 0; ai < 2; ++ai)
#pragma unroll
            for (int m = 0; m < 4; ++m) {
                const f32x4 v0 = silu4(acc[ai][0][m][0] * scale) * (acc[ai][1][m][0] * scale), v1 = silu4(acc[ai][0][m][1] * scale) * (acc[ai][1][m][1] * scale);
                if (oscale != 0.f) { f32x4 w0 = v0 * oscale, w1 = v1 * oscale; u32x2 o;
#pragma unroll
                    for (int i = 0; i < 4; ++i) { w0[i] = __builtin_amdgcn_fmed3f(w0[i], -448.f, 448.f); w1[i] = __builtin_amdgcn_fmed3f(w1[i], -448.f, 448.f); }
                    o.x = __builtin_amdgcn_cvt_pk_fp8_f32(w0[0], w0[1], 0, false); o.x = __builtin_amdgcn_cvt_pk_fp8_f32(w0[2], w0[3], o.x, true);
                    o.y = __builtin_amdgcn_cvt_pk_fp8_f32(w1[0], w1[1], 0, false); o.y = __builtin_amdgcn_cvt_pk_fp8_f32(w1[2], w1[3], o.y, true);
                    __builtin_nontemporal_store(o, (u32x2*)((unsigned char*)H + (size_t)(row0 + ai * HALF + m * 16) * ldh + col0)); }
                else __builtin_nontemporal_store(pack8(v0, v1), (u32x4*)(H + (size_t)(row0 + ai * HALF + m * 16) * ldh + col0));
                asm volatile("" ::: "memory");
            }
    }
};
struct EpiStore {
    static constexpr bool AFTER_DRAIN = false; static constexpr bool TWOSEG = false; static constexpr bool PERM = true;
    bf16_t* O; int ldc; float scale;
    DI void operator()(AccRef acc, const Unit& u, int wr, int wc, int fr, int fq) const {
        const int row0 = u.pm * BM + wr * 64 + fr, col0 = u.pn * BM + wc * 32 + 8 * fq;
#pragma unroll
        for (int ai = 0; ai < 2; ++ai)
#pragma unroll
            for (int m = 0; m < 4; ++m) { bf16_t* rowp = O + (size_t)(row0 + ai * HALF + m * 16) * ldc + col0;
#pragma unroll
                for (int bj = 0; bj < 2; ++bj) *(u32x4*)(rowp + bj * HALF) = pack8(acc[ai][bj][m][0] * scale, acc[ai][bj][m][1] * scale);
                asm volatile("" ::: "memory"); }
    }
};

template <class Epi, class Sched, bool ALIGN_EPI, int QM = 0>
DI void gemm_phase(LAS unsigned char* lds, const Gemm g, const Sched& S, const Epi& E, int tid_in) {
    constexpr bool FP8 = (QM == 1); constexpr bool I8 = (QM == 2);
    int tid_ = tid_in * 64 + lane_id_asm();
    const int tid = tid_, wid = tid_in, lane = tid & 63, wr = wid >> 2, wc = wid & 3, fr = lane & 15, fq = lane >> 4;
    constexpr int EB = QM ? 1 : 2;
    const int K = g.K, lda = g.lda, nt = K * EB / (BK * 2);
    const char* gA = (const char*)g.A; const char* gB = (const char*)g.Bt;
    asm volatile("" : "+s"(gA), "+s"(gB));
    const __amdgpu_buffer_rsrc_t rsA = __builtin_amdgcn_make_buffer_rsrc((void*)gA, 0, 0x7ffff000, 0x00020000), rsB = __builtin_amdgcn_make_buffer_rsrc((void*)gB, 0, 0x7ffff000, 0x00020000);
    unsigned voffA[2], voffB[2];
#pragma unroll
    for (int i = 0; i < 2; ++i) { int R, C; stage_rc(tid * 16 + i * 8192, R, C); const int Rb = Epi::PERM ? ((R & ~31) + perm32(R & 31)) : R;
        voffA[i] = (unsigned)(R * lda * EB + C * 2); voffB[i] = (unsigned)(Rb * K * EB + C * 2); }
    constexpr bool GATHER = Sched::GATHER;
    const unsigned kstep = (unsigned)(BK * 2);
    const unsigned hstepA = GATHER ? 0u : (unsigned)(HALF * lda * EB), hstepB = (unsigned)(HALF * K * EB);
    const unsigned tstepA = GATHER ? 0u : 2u * hstepA, tstepB = 2u * hstepB;
    unsigned va[2][2] = {{0u, 0u}, {0u, 0u}}, vaN[2][2] = {{0u, 0u}, {0u, 0u}};
    const unsigned ldsw = (unsigned)wid * 1024u;
    const int aoff = lds_byte(wr * 64 + fr, fq * 8), boff = lds_byte(wc * 32 + fr, fq * 8);
#define PG8_SA(b, h) (((b) * 2 + (h)) * HTB)
#define PG8_SB(b, h) ((4 + (b) * 2 + (h)) * HTB)
#define PG8_STAGE(bufoff, goff, voff) do { _Pragma("unroll") for (int _i = 0; _i < 2; ++_i) \
        __builtin_amdgcn_raw_ptr_buffer_load_lds(rsB, (LAS unsigned*)(lds + (bufoff) + ldsw + _i * 8192), 16, (voff)[_i], (goff), 0, 0); } while (0)
#define PG8_STAGE_A(bufoff, goff, NX, h) do { _Pragma("unroll") for (int _i = 0; _i < 2; ++_i) \
        __builtin_amdgcn_raw_ptr_buffer_load_lds(rsA, (LAS unsigned*)(lds + (bufoff) + ldsw + _i * 8192), 16, GATHER ? ((NX) ? vaN[h][_i] : va[h][_i]) : voffA[_i], (goff), 0, 0); } while (0)
#define PG8_GOFFS(dst, u) do { int gR0_, gC_; stage_rc((wid * 64 + lane_id_asm()) * 16, gR0_, gC_);     \
        _Pragma("unroll") for (int _h = 0; _h < 2; ++_h) _Pragma("unroll") for (int _i = 0; _i < 2; ++_i) dst[_h][_i] = S.row_off(u, _h * HALF + gR0_ + 64 * _i) + (unsigned)(gC_ * 2); } while (0)
#define PG8_LD32(base) ({ typedef int v4i_t __attribute__((ext_vector_type(4))); const v4i_t lo_ = *(const LAS v4i_t*)(base), hi_ = *(const LAS v4i_t*)((base) + 1024); __builtin_shufflevector(lo_, hi_, 0, 1, 2, 3, 4, 5, 6, 7); })
#define PG8_LDA(dst, b, h) do { if constexpr (FP8) { _Pragma("unroll") for (int m = 0; m < 4; ++m) A8[m] = PG8_LD32(lds + PG8_SA(b, h) + aoff + m * 2048); } \
        else { _Pragma("unroll") for (int m = 0; m < 4; ++m) _Pragma("unroll") for (int k = 0; k < 2; ++k) dst[m][k] = *(const LAS bf16x8*)(lds + PG8_SA(b, h) + aoff + m * 2048 + k * 1024); } } while (0)
#define PG8_LDB(dst, b, h) do { if constexpr (FP8) { _Pragma("unroll") for (int n = 0; n < 2; ++n) dst##8[n] = PG8_LD32(lds + PG8_SB(b, h) + boff + n * 2048); } \
        else { _Pragma("unroll") for (int n = 0; n < 2; ++n) _Pragma("unroll") for (int k = 0; k < 2; ++k) dst[n][k] = *(const LAS bf16x8*)(lds + PG8_SB(b, h) + boff + n * 2048 + k * 1024); } } while (0)
#define PG8_MMA(ai, bj, At, Bt) do { __builtin_amdgcn_s_setprio(1); _Pragma("unroll") for (int m = 0; m < 4; ++m) _Pragma("unroll") for (int n = 0; n < 2; ++n) { \
        if constexpr (FP8) acc[ai][bj][m][n] = __builtin_amdgcn_mfma_scale_f32_16x16x128_f8f6f4(Bt##8[n], A8[m], acc[ai][bj][m][n], 0, 0, 0, 0, 0, 0); \
        else if constexpr (I8) { _Pragma("unroll") for (int k = 0; k < 2; ++k) acc[ai][bj][m][n] = __builtin_bit_cast(f32x4, __builtin_amdgcn_mfma_i32_16x16x64_i8(__builtin_bit_cast(i32x4_t, Bt[n][k]), __builtin_bit_cast(i32x4_t, At[m][k]), __builtin_bit_cast(i32x4_t, acc[ai][bj][m][n]), 0, 0, 0)); } \
        else { _Pragma("unroll") for (int k = 0; k < 2; ++k) acc[ai][bj][m][n] = __builtin_amdgcn_mfma_f32_16x16x32_bf16(Bt[n][k], At[m][k], acc[ai][bj][m][n], 0, 0, 0); } } \
        __builtin_amdgcn_s_setprio(0); } while (0)
#define PG8_WAIT_V(n) asm volatile("s_waitcnt vmcnt(" #n ")" ::: "memory")
#define PG8_WAIT_L(n) asm volatile("s_waitcnt lgkmcnt(" #n ")" ::: "memory")
#define PG8_BAR __builtin_amdgcn_s_barrier()
#define PG8_SCHED __builtin_amdgcn_sched_barrier(0)
    Unit cur, nxt; int ui = 0;
    if (!S.next(0, cur)) return;
    f32x4 acc[2][2][4][2];
#pragma unroll
    for (int a = 0; a < 2; ++a)
#pragma unroll
        for (int b = 0; b < 2; ++b)
#pragma unroll
            for (int m = 0; m < 4; ++m)
#pragma unroll
                for (int n = 0; n < 2; ++n) acc[a][b][m][n] = (f32x4){0.f, 0.f, 0.f, 0.f};
    typedef int v8i_t __attribute__((ext_vector_type(8)));
    bf16x8 At[FP8 ? 1 : 4][2], B0[2][FP8 ? 1 : 2], B1[2][FP8 ? 1 : 2];
    v8i_t A8[FP8 ? 4 : 1], B08[FP8 ? 2 : 1], B18[FP8 ? 2 : 1];
    unsigned cA = (unsigned)cur.aoff + (unsigned)cur.pm * tstepA, cB = (unsigned)cur.boff + (unsigned)cur.pn * tstepB;
    S.a_ready(cur);
    if constexpr (GATHER) PG8_GOFFS(va, cur);
    PG8_STAGE(PG8_SB(0, 0), cB, voffB); PG8_STAGE(PG8_SB(0, 1), cB + hstepB, voffB); PG8_STAGE_A(PG8_SA(0, 0), cA, false, 0); PG8_STAGE_A(PG8_SA(0, 1), cA + hstepA, false, 1);
    if (wr == 1) PG8_BAR;
    PG8_WAIT_V(2); PG8_BAR;
    PG8_STAGE(PG8_SB(1, 0), cB + kstep, voffB); PG8_STAGE_A(PG8_SA(1, 0), cA + kstep, false, 0); PG8_STAGE(PG8_SB(1, 1), cB + hstepB + kstep, voffB);
    PG8_WAIT_V(6); PG8_BAR;
    for (;;) {
        const bool has_next = S.next(ui + 1, nxt);
        if constexpr (GATHER) { if (has_next) PG8_GOFFS(vaN, nxt); else { _Pragma("unroll") for (int _h = 0; _h < 2; ++_h) _Pragma("unroll") for (int _i = 0; _i < 2; ++_i) vaN[_h][_i] = va[_h][_i]; } }
        const unsigned nA = has_next ? (unsigned)nxt.aoff + (unsigned)nxt.pm * tstepA : cA, nB = has_next ? (unsigned)nxt.boff + (unsigned)nxt.pn * tstepB : cB;
#pragma unroll 1
        for (int t = 0; t < nt; t += 2) {
            const bool last = (t == nt - 2);
            const unsigned a1 = cA + (unsigned)(t + 1) * kstep;
            const unsigned a2 = last ? nA : cA + (unsigned)(t + 2) * kstep, b2 = last ? nB : cB + (unsigned)(t + 2) * kstep;
            const unsigned a3 = a2 + kstep, b3 = b2 + kstep;
            if (last && has_next) S.a_ready(nxt);
            PG8_LDB(B0, 0, 0); PG8_LDB(B1, 0, 1); PG8_SCHED; PG8_LDA(At, 0, 0); PG8_STAGE_A(PG8_SA(1, 1), a1 + hstepA, false, 1);
            PG8_WAIT_V(8); PG8_WAIT_L(0); PG8_BAR; PG8_MMA(0, 0, At, B0); PG8_MMA(0, 1, At, B1); PG8_BAR; PG8_SCHED;
            PG8_LDA(At, 0, 1); PG8_STAGE(PG8_SB(0, 0), b2, voffB); PG8_STAGE(PG8_SB(0, 1), b2 + hstepB, voffB); PG8_STAGE_A(PG8_SA(0, 0), a2, last, 0);
            PG8_WAIT_V(8); PG8_WAIT_L(0); PG8_BAR; PG8_MMA(1, 0, At, B0); PG8_MMA(1, 1, At, B1); PG8_BAR; PG8_SCHED;
            PG8_LDB(B0, 1, 0); PG8_LDB(B1, 1, 1); PG8_SCHED; PG8_LDA(At, 1, 0); PG8_STAGE_A(PG8_SA(0, 1), a2 + hstepA, last, 1);
            PG8_WAIT_V(8); PG8_WAIT_L(0); PG8_BAR; PG8_MMA(0, 0, At, B0); PG8_MMA(0, 1, At, B1); PG8_BAR; PG8_SCHED;
            PG8_LDA(At, 1, 1); PG8_STAGE(PG8_SB(1, 0), b3, voffB); PG8_STAGE(PG8_SB(1, 1), b3 + hstepB, voffB); PG8_STAGE_A(PG8_SA(1, 0), a3, last, 0);
            PG8_WAIT_V(8); PG8_WAIT_L(0); PG8_BAR; PG8_MMA(1, 0, At, B0); PG8_MMA(1, 1, At, B1); PG8_BAR; PG8_SCHED;
        }
        if constexpr (ALIGN_EPI) { if (wr == 0) PG8_BAR; }
        if constexpr (I8) { const int l2 = lane_id_asm();
            const float* sAp = g.sA + cur.pm * BM + wr * 64 + (l2 & 15); const float* sBp = g.sB + cur.pn * BM + wc * 32 + 8 * (l2 >> 4);
            float rs[2][4]; f32x4 cs[2][2];
#pragma unroll
            for (int ai = 0; ai < 2; ++ai)
#pragma unroll
                for (int m = 0; m < 4; ++m) rs[ai][m] = sAp[ai * HALF + m * 16];
#pragma unroll
            for (int bj = 0; bj < 2; ++bj)
#pragma unroll
                for (int n = 0; n < 2; ++n) cs[bj][n] = *(const f32x4*)(sBp + bj * HALF + 4 * n);
#pragma unroll
            for (int bj = 0; bj < 2; ++bj)
#pragma unroll
                for (int n = 0; n < 2; ++n) cs[bj][n] = cs[bj][n] * (1.f / 127.f);
#pragma unroll
            for (int ai = 0; ai < 2; ++ai)
#pragma unroll
                for (int m = 0; m < 4; ++m)
#pragma unroll
                    for (int bj = 0; bj < 2; ++bj)
#pragma unroll
                        for (int n = 0; n < 2; ++n) { const i32x4_t iv = __builtin_bit_cast(i32x4_t, acc[ai][bj][m][n]);
                            acc[ai][bj][m][n] = (f32x4){(float)iv[0], (float)iv[1], (float)iv[2], (float)iv[3]} * (cs[bj][n] * rs[ai][m]); }
        }
        { const int l2 = lane_id_asm();
          if constexpr (Epi::TWOSEG) { if (cur.kind == 0) E.mid(acc, cur, wr, wc, l2 & 15, l2 >> 4); else E(acc, cur, wr, wc, l2 & 15, l2 >> 4); }
          else E(acc, cur, wr, wc, l2 & 15, l2 >> 4); } S.done(cur);
        if (!has_next) break;
        if (!(Epi::TWOSEG && cur.kind == 0))
#pragma unroll
        for (int a = 0; a < 2; ++a)
#pragma unroll
            for (int b = 0; b < 2; ++b)
#pragma unroll
                for (int m = 0; m < 4; ++m)
#pragma unroll
                    for (int n = 0; n < 2; ++n) acc[a][b][m][n] = (f32x4){0.f, 0.f, 0.f, 0.f};
        cur = nxt; cA = nA; cB = nB; ++ui;
        if constexpr (GATHER) { _Pragma("unroll") for (int _h = 0; _h < 2; ++_h) _Pragma("unroll") for (int _i = 0; _i < 2; ++_i) va[_h][_i] = vaN[_h][_i]; }
        if constexpr (ALIGN_EPI) { if (wr == 1) PG8_BAR; }
    }
    PG8_WAIT_V(0);
    if constexpr (!ALIGN_EPI) { if (wr == 0) PG8_BAR; }
    PG8_BAR;
    if constexpr (Epi::AFTER_DRAIN) { const int l2 = lane_id_asm(); E.after(acc, cur, wr, wc, l2 & 15, l2 >> 4, lds, wid * 64 + l2); }
#undef PG8_SA
#undef PG8_SB
#undef PG8_STAGE
#undef PG8_STAGE_A
#undef PG8_GOFFS
#undef PG8_LD32
#undef PG8_LDA
#undef PG8_LDB
#undef PG8_MMA
#undef PG8_WAIT_V
#undef PG8_WAIT_L
#undef PG8_BAR
#undef PG8_SCHED
}
}
#define XB_TMO      128
#define XB_XCNT(j)  (256  + 64 * (j))
#define XB_XSUB(j)  (1280 + 64 * (j))
#define XB_XGEN(j)  (2304 + 64 * (j))
#define XB_TOP      3328
#define XB_TOPGEN   3392
#define XCD_BAR_WORDS 3456
#define XB_SPIN_CAP (1u << 18)

__device__ __forceinline__ unsigned xb_ld(unsigned* p)              { return __hip_atomic_load(p, __ATOMIC_RELAXED, __HIP_MEMORY_SCOPE_AGENT); }
__device__ __forceinline__ unsigned xb_add(unsigned* p, unsigned v) { return __hip_atomic_fetch_add(p, v, __ATOMIC_RELAXED, __HIP_MEMORY_SCOPE_AGENT); }
__device__ __forceinline__ unsigned xb_xcc_id() { return (unsigned)__builtin_amdgcn_s_getreg((3 << 11) | 20) & 0xFu; }
#define XB_SPIN(cond, bar) do { unsigned _sp = 0; while (cond) { __builtin_amdgcn_s_sleep(1); \
    if ((++_sp & 255u) == 0u) { if (xb_ld(&(bar)[XB_TMO])) break; if (_sp > XB_SPIN_CAP) { atomicAdd(&(bar)[XB_TMO], 1u); break; } } } } while (0)

struct XcdBarrier {
    unsigned* bar; unsigned x; int wave;
    volatile LAS unsigned* st;
};

__device__ __forceinline__ XcdBarrier xcd_barrier_post(unsigned* bar, volatile LAS unsigned* st) {
    XcdBarrier b; b.bar = bar; b.x = xb_xcc_id(); b.st = st;
    if (threadIdx.x == 0) (void)xb_add(&bar[XB_XCNT(b.x)], 1u);
    return b;
}
__device__ __forceinline__ void xcd_barrier_complete(unsigned* bar, unsigned x, unsigned& nloc, unsigned& nx) {
    const unsigned G = gridDim.x * gridDim.y * gridDim.z;
    unsigned sum, cnt, mine, sp = 0u;
    for (;;) {
        sum = 0u; cnt = 0u; mine = 0u;
#pragma unroll
        for (unsigned j = 0; j < 16; ++j) { const unsigned c = xb_ld(&bar[XB_XCNT(j)]); sum += c; cnt += (c > 0u) ? 1u : 0u; mine = (j == x) ? c : mine; }
        if (sum == G) break;
        __builtin_amdgcn_s_sleep(1);
        if ((++sp & 255u) == 0u) { if (xb_ld(&bar[XB_TMO])) break; if (sp > XB_SPIN_CAP) { atomicAdd(&bar[XB_TMO], 1u); break; } }
    }
    nloc = mine > 0u ? mine : 1u; nx = cnt > 0u ? cnt : 1u;
}

__device__ __noinline__ void xcd_barrier(const XcdBarrier b) {
    asm volatile("s_waitcnt vmcnt(0)" ::: "memory");
    __syncthreads();
    if (b.wave == 0 && lane_id_asm() == 0) {
        unsigned* bar = b.bar;
        __builtin_amdgcn_s_waitcnt(0);
        unsigned nloc = b.st[0], nx = b.st[1];
        if (nloc == 0u) { xcd_barrier_complete(bar, b.x, nloc, nx); b.st[0] = nloc; b.st[1] = nx; }
        const unsigned old = xb_add(&bar[XB_XSUB(b.x)], 1u);
        const unsigned gen = old / nloc;
        if (old + 1u == (gen + 1u) * nloc) {
            __builtin_amdgcn_fence(__ATOMIC_RELEASE, "agent");
            asm volatile("s_waitcnt vmcnt(0)" ::: "memory");
            const unsigned og = xb_add(&bar[XB_TOP], 1u);
            const unsigned tg = og / nx;
            if (og + 1u == (tg + 1u) * nx) xb_add(&bar[XB_TOPGEN], 1u);
            else XB_SPIN(xb_ld(&bar[XB_TOPGEN]) == tg, bar);
            __builtin_amdgcn_fence(__ATOMIC_ACQUIRE, "agent");
            xb_add(&bar[XB_XGEN(b.x)], 1u);
            asm volatile("s_waitcnt vmcnt(0)" ::: "memory");
        } else {
            XB_SPIN(xb_ld(&bar[XB_XGEN(b.x)]) == gen, bar);
            __builtin_amdgcn_fence(__ATOMIC_ACQUIRE, "agent");
            asm volatile("s_waitcnt vmcnt(0)" ::: "memory");
        }
    }
    __syncthreads();
}
namespace att {
constexpr float ATT_THR = 8.f;
constexpr int KROW = 208;
constexpr int KBUF = 64 * KROW;
constexpr int VBUF = 8192;
constexpr int BUF = KBUF + VBUF;
constexpr int WSF_OFF = 3 * BUF;
constexpr int LDS_NEED = WSF_OFF + 8 * 256;
typedef short v4i16_t __attribute__((ext_vector_type(4)));
DI s16x4 vtr(const LAS unsigned char* p) { return __builtin_bit_cast(s16x4, __builtin_amdgcn_ds_read_tr16_b64_v4i16((LAS v4i16_t*)p)); }
DI float xor32_max(float v) { const auto rr = __builtin_amdgcn_permlane32_swap(__float_as_uint(v), __float_as_uint(v), false, false); return fmaxf(__uint_as_float(rr[0]), __uint_as_float(rr[1])); }
DI bf16x8 pack_p(const f32x16& x, int s) {
    u32x4 p;
    p.x = pg8::cvt_pk_bf16(x[8 * s + 0], x[8 * s + 1]); p.y = pg8::cvt_pk_bf16(x[8 * s + 2], x[8 * s + 3]);
    p.z = pg8::cvt_pk_bf16(x[8 * s + 4], x[8 * s + 5]); p.w = pg8::cvt_pk_bf16(x[8 * s + 6], x[8 * s + 7]);
    return __builtin_bit_cast(bf16x8, p);
}

DI void qk_tile(f32x16& s0, f32x16& s1, const LAS unsigned char* buf, int koff, const bf16x8 (&qf)[6], const f32x16& negv) {
    s0 = negv; s1 = negv;
    __builtin_amdgcn_s_setprio(1);
#pragma unroll
    for (int ks = 0; ks < 6; ++ks) {
        const bf16x8 a0 = *(const LAS bf16x8*)(buf + koff + ks * 32);
        const bf16x8 a1 = *(const LAS bf16x8*)(buf + koff + 32 * KROW + ks * 32);
        s0 = __builtin_amdgcn_mfma_f32_32x32x16_bf16(a0, qf[ks], s0, 0, 0, 0);
        s1 = __builtin_amdgcn_mfma_f32_32x32x16_bf16(a1, qf[ks], s1, 0, 0, 0);
    }
    __builtin_amdgcn_s_setprio(0);
}
DI void attn_unit(LAS unsigned char* lds, const bf16_t* Q, const bf16_t* K, const bf16_t* V, bf16_t* AO, int b, int h, int qb, int tid_, int wave, int lane_) {
    const int lane = lane_id_asm(), tid = wave * 64 + lane; (void)tid_; (void)lane_;
    const int r32 = lane & 31, hi = lane >> 5;
    const int NT = 4 * (qb + 1);
    const size_t rowbase = (size_t)b * SEQ;
    const int q0 = qb * 256 + wave * 32;
    const int cw = q0 >> 6;
    bf16x8 qf[6];
    { const bf16_t* qp = Q + (rowbase + q0 + r32) * 768 + h * 96 + hi * 8;
#pragma unroll
      for (int ks = 0; ks < 6; ++ks) qf[ks] = *(const bf16x8*)(qp + ks * 16); }
    f32x16 o0, o1;
#pragma unroll
    for (int r = 0; r < 16; ++r) { o0[r] = 0.f; o1[r] = 0.f; }
    float mref = 0.f, lrun = 0.f, pend = 0.f;
    f32x16 negv;
#pragma unroll
    for (int r = 0; r < 16; ++r) negv[r] = 0.f;
    const int vkey = tid >> 3, vc = tid & 7;
    const bf16_t* vsrc = V + (rowbase + vkey) * 512 + h * 64 + vc * 8;
    const int vdst = KBUF + (vc >> 2) * 4096 + vkey * 64 + (vc & 3) * 16;
    const int ka = tid / 12, kac = tid - ka * 12;
    const bf16_t* ksrc0 = K + (rowbase + ka) * 768 + h * 96 + kac * 8;
    const int kdst0 = ka * KROW + kac * 16;
    const int i1 = tid + 512, kb = i1 / 12, kbc = i1 - kb * 12;
    const bf16_t* ksrc1 = K + (rowbase + kb) * 768 + h * 96 + kbc * 8;
    const int kdst1 = kb * KROW + kbc * 16;
    const bool has1 = tid < 256;
    u32x4 rk0, rk1 = (u32x4){0u, 0u, 0u, 0u}, rv;
#pragma unroll
    for (int t0 = 0; t0 < 2; ++t0) {
        const size_t adv = (size_t)t0 * 64;
        rk0 = *(const u32x4*)(ksrc0 + adv * 768); if (has1) rk1 = *(const u32x4*)(ksrc1 + adv * 768); rv = *(const u32x4*)(vsrc + adv * 512);
        LAS unsigned char* d = lds + t0 * BUF;
        *(LAS u32x4*)(d + kdst0) = rk0; if (has1) *(LAS u32x4*)(d + kdst1) = rk1; *(LAS u32x4*)(d + vdst) = rv;
    }
    { const size_t adv = (size_t)2 * 64; rk0 = *(const u32x4*)(ksrc0 + adv * 768); if (has1) rk1 = *(const u32x4*)(ksrc1 + adv * 768); rv = *(const u32x4*)(vsrc + adv * 512); }
    lds_barrier();
    LAS float* wsf = (LAS float*)(lds + WSF_OFF + wave * 256);
    const int koff = r32 * KROW + hi * 16;
    const int voff = KBUF + (((lane >> 4) & 1) * 16 + (lane & 3) * 4) * 2 + (4 * hi + ((lane & 15) >> 2)) * 64;
    f32x16 sa0, sa1, sb0, sb1;
    qk_tile(sa0, sa1, lds, koff, qf, negv);
    int scur = 0, snxt = BUF, sfree = 2 * BUF;
#define ATT_STEP(SA0, SA1, SB0, SB1) do { \
        if (t + 2 < NT) { LAS unsigned char* d = lds + sfree; *(LAS u32x4*)(d + kdst0) = rk0; if (has1) *(LAS u32x4*)(d + kdst1) = rk1; *(LAS u32x4*)(d + vdst) = rv; }     \
        if (t + 3 < NT) { const size_t adv = (size_t)(t + 3) * 64; rk0 = *(const u32x4*)(ksrc0 + adv * 768); if (has1) rk1 = *(const u32x4*)(ksrc1 + adv * 768); rv = *(const u32x4*)(vsrc + adv * 512); } \
        const bool act = (t <= cw), actn = (t + 1 <= cw) && (t + 1 < NT); \
        if (actn) qk_tile(SB0, SB1, lds + snxt, koff, qf, negv);         \
        if (act) { \
            if (__any(pend != 0.f)) {                                        \
                _Pragma("unroll") for (int r = 0; r < 16; ++r) { SA0[r] -= pend; SA1[r] -= pend; } \
            } \
            float mx = SA0[0]; \
            _Pragma("unroll") for (int r = 0; r < 16; ++r) mx = __builtin_fmaxf(__builtin_fmaxf(mx, SA0[r]), SA1[r]); \
            mx = xor32_max(mx); \
            pend = 0.f; \
            if (t == 0 || __any(mx > ATT_THR)) {                             \
                const float dl = (t == 0) ? mx : __builtin_fmaxf(mx, 0.f); \
                mref += dl; pend = dl; \
                _Pragma("unroll") for (int r = 0; r < 16; ++r) { SA0[r] -= dl; SA1[r] -= dl; negv[r] = -mref; } \
                if (t != 0) {                                                   \
                    const float f = __builtin_amdgcn_exp2f(-dl); \
                    lrun *= f; \
                    if (hi == 0) wsf[r32] = f; \
                    LDS_WAIT(); \
                    _Pragma("unroll") for (int g = 0; g < 4; ++g) { const f32x4 fv = *(const LAS f32x4*)(wsf + 8 * g + 4 * hi); \
                        _Pragma("unroll") for (int j = 0; j < 4; ++j) { o0[4 * g + j] *= fv[j]; o1[4 * g + j] *= fv[j]; } } \
                } \
            } \
            float ps = 0.f; \
            _Pragma("unroll") for (int r = 0; r < 16; ++r) { SA0[r] = __builtin_amdgcn_exp2f(SA0[r]); SA1[r] = __builtin_amdgcn_exp2f(SA1[r]); ps += SA0[r] + SA1[r]; } \
            lrun += ps; \
            const LAS unsigned char* cur = lds + scur; \
            __builtin_amdgcn_s_setprio(1); \
            _Pragma("unroll") for (int s = 0; s < 4; ++s) { \
                const bf16x8 pa = pack_p((s < 2) ? SA0 : SA1, s & 1); \
                const LAS unsigned char* vp = cur + voff + s * 16 * 64; \
                const s16x4 l0 = vtr(vp), h0 = vtr(vp + 8 * 64), l1 = vtr(vp + 4096), h1 = vtr(vp + 4096 + 8 * 64); \
                const bf16x8 vb0 = (bf16x8){l0[0], l0[1], l0[2], l0[3], h0[0], h0[1], h0[2], h0[3]}; \
                const bf16x8 vb1 = (bf16x8){l1[0], l1[1], l1[2], l1[3], h1[0], h1[1], h1[2], h1[3]}; \
                o0 = __builtin_amdgcn_mfma_f32_32x32x16_bf16(pa, vb0, o0, 0, 0, 0); \
                o1 = __builtin_amdgcn_mfma_f32_32x32x16_bf16(pa, vb1, o1, 0, 0, 0); \
            } \
            __builtin_amdgcn_s_setprio(0); \
        } \
        lds_barrier(); \
        { const int tmp = scur; scur = snxt; snxt = sfree; sfree = tmp; } \
    } while (0)
#pragma unroll 1
    for (int t2 = 0; t2 < NT; t2 += 2) {
        { const int t = t2; ATT_STEP(sa0, sa1, sb0, sb1); }
        { const int t = t2 + 1; ATT_STEP(sb0, sb1, sa0, sa1); }
    }
#undef ATT_STEP
    lrun = xor32_sum(lrun);
    if (hi == 0) wsf[r32] = __builtin_amdgcn_rcpf(lrun);
    LDS_WAIT();
    bf16_t* op = AO + (rowbase + q0) * 512 + h * 64 + r32;
#pragma unroll
    for (int g = 0; g < 4; ++g) { const f32x4 fv = *(const LAS f32x4*)(wsf + 8 * g + 4 * hi);
#pragma unroll
        for (int j = 0; j < 4; ++j) { const int q = 8 * g + 4 * hi + j;
            op[(size_t)q * 512] = (bf16_t)f2bf(o0[4 * g + j] * fv[j]); op[(size_t)q * 512 + 32] = (bf16_t)f2bf(o1[4 * g + j] * fv[j]); } }
    LDS_WAIT();
    __syncthreads();
}
}

DI void gdn_gate_rows(int gw, int NGW, int lane, const float* ORAW, const bf16_t* Zb, const float* out_norm, bf16_t* GO) {
    const int c0 = lane * 8, e0 = c0 & 127;
    const f32x4 n0 = *(const f32x4*)(out_norm + e0), n1 = *(const f32x4*)(out_norm + e0 + 4);
    f32x4 na = (f32x4){0.f, 0.f, 0.f, 0.f}, nb = na; u32x4 nz = (u32x4){0u, 0u, 0u, 0u};
    if (gw < M) { const GAS f32x4* o4 = (const GAS f32x4*)(ORAW + (size_t)gw * 512 + c0); na = o4[0]; nb = o4[1]; nz = *(const GAS u32x4*)(Zb + (size_t)gw * Z_LD + c0); }
    for (int m = gw; m < M; m += NGW) {
        f32x4 a = na, b = nb; u32x4 zz = nz;
        asm volatile("" : "+v"(a), "+v"(b), "+v"(zz));
        if (m + NGW < M) { const GAS f32x4* o4 = (const GAS f32x4*)(ORAW + (size_t)(m + NGW) * 512 + c0); na = o4[0]; nb = o4[1]; nz = *(const GAS u32x4*)(Zb + (size_t)(m + NGW) * Z_LD + c0); }
        float ss = (a.x * a.x + a.y * a.y) + (a.z * a.z + a.w * a.w) + (b.x * b.x + b.y * b.y) + (b.z * b.z + b.w * b.w);
        ss += swz_xor<1>(ss); ss += swz_xor<2>(ss); ss += swz_xor<4>(ss); ss += swz_xor<8>(ss);
        const float r = rsqrtf(ss * (1.f / 128.f) + EPS);
        u32x4 o;
        o.x = pk2(a.x * r * n0.x * siluf(bflo(zz.x)), a.y * r * n0.y * siluf(bfhi(zz.x)));
        o.y = pk2(a.z * r * n0.z * siluf(bflo(zz.y)), a.w * r * n0.w * siluf(bfhi(zz.y)));
        o.z = pk2(b.x * r * n1.x * siluf(bflo(zz.z)), b.y * r * n1.y * siluf(bfhi(zz.z)));
        o.w = pk2(b.z * r * n1.z * siluf(bflo(zz.w)), b.w * r * n1.w * siluf(bfhi(zz.w)));
        *(GAS u32x4*)(GO + (size_t)m * 512 + c0) = o;
    }
}

DI void mla_prep_rows(int gw, int NGW, int lane, const bf16_t* MISC, float* rstdq, float* rstdkv) {
    unsigned nq[3] = {0u, 0u, 0u}, nk[2] = {0u, 0u};
#define MLA_ISSUE(mm) do { const bf16_t* pr_ = MISC + (size_t)(mm) * MISC_LD; \
        _Pragma("unroll") for (int i = 0; i < 3; ++i) nq[i] = *(const GAS unsigned*)(pr_ + MC_CQ + 2 * lane + 128 * i); \
        _Pragma("unroll") for (int i = 0; i < 2; ++i) nk[i] = *(const GAS unsigned*)(pr_ + MC_CKV + 2 * lane + 128 * i); } while (0)
    if (gw < M) MLA_ISSUE(gw);
    for (int m = gw; m < M; m += NGW) {
        unsigned q0 = nq[0], q1 = nq[1], q2 = nq[2], k0 = nk[0], k1 = nk[1];
        asm volatile("" : "+v"(q0), "+v"(q1), "+v"(q2), "+v"(k0), "+v"(k1));
        if (m + NGW < M) MLA_ISSUE(m + NGW);
        float ss = (bflo(q0) * bflo(q0) + bfhi(q0) * bfhi(q0)) + (bflo(q1) * bflo(q1) + bfhi(q1) * bfhi(q1)) + (bflo(q2) * bflo(q2) + bfhi(q2) * bfhi(q2));
        ss = wave_sum(ss);
        const float rq = rsqrtf(ss * (1.f / 384.f) + EPS);
        ss = (bflo(k0) * bflo(k0) + bfhi(k0) * bfhi(k0)) + (bflo(k1) * bflo(k1) + bfhi(k1) * bfhi(k1));
        ss = wave_sum(ss);
        const float rkv = rsqrtf(ss * (1.f / 256.f) + EPS);
        if (lane == 0) { rstdq[m] = rq; rstdkv[m] = rkv; }
    }
#undef MLA_ISSUE
}
DI void mla_kpe_rows(int gw, int NGW, int lane, const bf16_t* MISC, const float* COS, const float* SIN, bf16_t* Kb) {
    const int sub = lane >> 4, j = lane & 15;
    for (int m = 4 * gw + sub; m < M; m += 4 * NGW) {
        const bf16_t* pr = MISC + (size_t)m * MISC_LD;
        const float c = COS[(size_t)m * 16 + j], s = SIN[(size_t)m * 16 + j];
        const float t1 = bf2f(pr[MC_KR + j]), t2 = bf2f(pr[MC_KR + 16 + j]);
        const bf16_t o1 = (bf16_t)f2bf(t1 * c - t2 * s), o2 = (bf16_t)f2bf(t2 * c + t1 * s);
#pragma unroll
        for (int h = 0; h < 8; ++h) { Kb[(size_t)m * 768 + h * 96 + 64 + j] = o1; Kb[(size_t)m * 768 + h * 96 + 80 + j] = o2; }
    }
}

namespace gdn {
constexpr int ROWB = 272;
constexpr int GV = 0, LS = 1024, PART = 18432, QS = 26624, KS = 44032, VS = 61440;
constexpr int LDS_NEED = VS + 17408;


constexpr int T_GV = 0, T_LS = 1024, T_PART = 1024  , T_QS = 18432, T_KS = 35840, T_VS = 53248, TEAM_LDS = 70656;
DI void conv8(float (&y)[8][8], float (&ps)[8], const bf16_t* QKV, const float* conv_w, size_t m0, int c, int ch, int rg) {
    f32x4 cw[4][2];
#pragma unroll
    for (int j = 0; j < 4; ++j) { cw[j][0] = *(const f32x4*)(conv_w + j * 1536 + ch); cw[j][1] = *(const f32x4*)(conv_w + j * 1536 + ch + 4); }
    u32x4 xw[11];
#pragma unroll
    for (int i = 0; i < 11; ++i) {
        const int row = 8 * rg - 3 + i;
        xw[i] = (u32x4){0u, 0u, 0u, 0u};
        if (row >= 0 || c > 0) xw[i] = *(const GAS u32x4*)((const GAS char*)(QKV + (m0 - 3) * QKV_LD) + (unsigned)(((row + 3) * QKV_LD + ch) * 2));
    }
#pragma unroll
    for (int r = 0; r < 8; ++r) {
        float p = 0.f;
#pragma unroll
        for (int i = 0; i < 8; ++i) {
            float a = 0.f;
#pragma unroll
            for (int j = 0; j < 4; ++j) { const unsigned w = xw[r + j][i >> 1]; a += cw[j][i >> 2][i & 3] * ((i & 1) ? bfhi(w) : bflo(w)); }
            a = siluf(a); y[r][i] = a; p += a * a;
        }
        ps[r] = p;
    }
}
DI void local_pair(LAS unsigned char* lds_, const bf16_t* QKV, const bf16_t* MISC, const float* conv_w, const float* a_log, const float* dt_bias,
                   bf16_t* UT, bf16_t* Wb, bf16_t* QD, bf16_t* KDT, bf16_t* AT, float* CD, int up, int wave8) {
    const int lane = lane_id_asm();
    const int team = wave8 >> 2, w4 = wave8 & 3, un = 2 * up + team;
    LAS unsigned char* lds = lds_ + team * TEAM_LDS;
    const int bh = un >> 5, c = un & 31, b = bh >> 2, h = bh & 3;
    const size_t m0 = (size_t)b * SEQ + (size_t)c * 64;
    unsigned vz = 0u; asm volatile("" : "+v"(vz));
    LAS unsigned char* ldv = lds + vz;
    LAS float* Gs = (LAS float*)(ldv + T_GV); LAS float* Bs = Gs + 64; LAS float* EGs = Gs + 128; LAS float* ELs = Gs + 192;
    const int cg = lane & 15, rg = 4 * (w4 & 1) + (lane >> 4);
    if (w4 < 2) {
        float y[8][8], ps[8];
        conv8(y, ps, QKV, conv_w, m0, c, 1024 + h * 128 + cg * 8, rg);
#pragma unroll
        for (int r = 0; r < 8; ++r) { u32x4 w; w.x = pk2(y[r][0], y[r][1]); w.y = pk2(y[r][2], y[r][3]); w.z = pk2(y[r][4], y[r][5]); w.w = pk2(y[r][6], y[r][7]);
            *(LAS u32x4*)(lds + T_VS + (8 * rg + r) * ROWB + cg * 16) = w; }
    } else if (w4 == 2) {
        const size_t m = m0 + lane;
        const float a = bf2f(MISC[m * MISC_LD + MC_A + h]) + dt_bias[h];
        const float ea = __expf(a);
        const float sp = a > 20.f ? a : (ea < 0.015625f ? ea * (1.f - ea * (0.5f - ea * (1.f / 3.f - 0.25f * ea))) : __logf(1.f + ea));
        const float g = -__expf(a_log[h]) * sp;
        Bs[lane] = sigmf(bf2f(MISC[m * MISC_LD + MC_B + h]));
        Gs[lane] = g;
        LDS_WAIT();
        float G = 0.f;
#pragma unroll
        for (int j4 = 0; j4 < 16; ++j4) { const f32x4 gv = *(const LAS f32x4*)(Gs + 4 * j4);
#pragma unroll
            for (int jj = 0; jj < 4; ++jj) G += (4 * j4 + jj <= lane) ? gv[jj] : 0.f; }
        const float GL = __int_as_float(__builtin_amdgcn_readlane(__float_as_int(G), 63));
        LDS_WAIT();
        Gs[lane] = G; EGs[lane] = __expf(G); ELs[lane] = __expf(GL - G);
        if (lane == 63) CD[un] = __expf(GL);
    }
    const int mat = w4 >> 1;
    float y[8][8];
    {
        float ps[8];
        conv8(y, ps, QKV, conv_w, m0, c, mat * 512 + h * 128 + cg * 8, rg);
#pragma unroll
        for (int r = 0; r < 8; ++r) ((LAS float*)(lds + T_PART))[(mat * 64 + 8 * rg + r) * 16 + cg] = ps[r];
    }
    lds_barrier();
    {
        LAS unsigned char* tile = lds + (mat == 0 ? T_QS : T_KS);
#pragma unroll
        for (int r = 0; r < 8; ++r) {
            const LAS f32x4* pp = (const LAS f32x4*)(ldv + T_PART) + (mat * 64 + 8 * rg + r) * 4;
            const f32x4 p0 = pp[0], p1 = pp[1], p2 = pp[2], p3 = pp[3];
            const float ss = ((p0.x + p0.y) + (p0.z + p0.w)) + ((p1.x + p1.y) + (p1.z + p1.w)) + ((p2.x + p2.y) + (p2.z + p2.w)) + ((p3.x + p3.y) + (p3.z + p3.w));
            const float rn = rsqrtf(ss + EPS) * (mat == 0 ? 0.08838834764831845f : 1.f);
            const int row = 8 * rg + r;
            u32x4 w; w.x = pk2(y[r][0] * rn, y[r][1] * rn); w.y = pk2(y[r][2] * rn, y[r][3] * rn); w.z = pk2(y[r][4] * rn, y[r][5] * rn); w.w = pk2(y[r][6] * rn, y[r][7] * rn);
            *(LAS u32x4*)(tile + row * ROWB + cg * 16) = w;
            if (mat == 0) {
                const float eg = EGs[row];
                u32x4 d; d.x = pk2(bflo(w.x) * eg, bfhi(w.x) * eg); d.y = pk2(bflo(w.y) * eg, bfhi(w.y) * eg); d.z = pk2(bflo(w.z) * eg, bfhi(w.z) * eg); d.w = pk2(bflo(w.w) * eg, bfhi(w.w) * eg);
                *(GAS u32x4*)(QD + (((size_t)un * 16 + (row >> 4) * 4 + (cg >> 2)) * 64 + (row & 15) + 16 * (cg & 3)) * 8) = d;
            }
        }
    }
    lds_barrier();
    {
        const int r32 = lane & 31, hi = lane >> 5, bi = w4 >> 1, bj = w4 & 1;
        const int j = 32 * bj + r32; const float Gj = Gs[j];
#pragma unroll
        for (int pass = 0; pass < 2; ++pass) {
            const bool qk = pass == 1;
            f32x16 acc;
#pragma unroll
            for (int r = 0; r < 16; ++r) acc[r] = 0.f;
            if (w4 != 1) {
                const LAS unsigned char* At = lds + (qk ? T_QS : T_KS) + (32 * bi + r32) * ROWB + hi * 16;
                const LAS unsigned char* Bt = lds + T_KS + (32 * bj + r32) * ROWB + hi * 16;
#pragma unroll
                for (int ks = 0; ks < 8; ++ks) acc = __builtin_amdgcn_mfma_f32_32x32x16_bf16(*(const LAS bf16x8*)(At + ks * 32), *(const LAS bf16x8*)(Bt + ks * 32), acc, 0, 0, 0);
            }
#pragma unroll
            for (int g4 = 0; g4 < 4; ++g4) {
                const int ib = 32 * bi + 8 * g4 + 4 * hi;
                const f32x4 Gi = *(const LAS f32x4*)(Gs + ib), Bi = *(const LAS f32x4*)(Bs + ib);
#pragma unroll
                for (int jj = 0; jj < 4; ++jj) {
                    const int i = ib + jj; const float d = __expf(Gi[jj] - Gj); const float cv = acc[4 * g4 + jj];
                    if (!qk) ((LAS float*)(lds + T_LS))[i * 68 + j] = (i > j) ? Bi[jj] * cv * d : 0.f;
                    else AT[(((size_t)un * 8 + (i >> 4) * 2 + (j >> 5)) * 64 + (i & 15) + 16 * ((j & 31) >> 3)) * 8 + (j & 7)] = (bf16_t)f2bf((i >= j) ? cv * d : 0.f);
                }
            }
        }
    }
    lds_barrier();
    {
        const int col = 64 * w4 + lane;
        const bool isk = w4 >= 2;
        const LAS unsigned char* src = lds + (isk ? T_KS : T_VS) + (col & 127) * 2;
        f32x2 sol[32];
#pragma unroll
        for (int t = 0; t < 32; ++t) { sol[t].x = bf2f(*(const LAS bf16_t*)(src + (2 * t) * ROWB)); sol[t].y = bf2f(*(const LAS bf16_t*)(src + (2 * t + 1) * ROWB)); }
        if (isk) {
            const int dkk = col & 127;
#pragma unroll
            for (int t8 = 0; t8 < 8; ++t8) { const f32x4 e0 = *(const LAS f32x4*)(ELs + 8 * t8), e1 = *(const LAS f32x4*)(ELs + 8 * t8 + 4);
                u32x4 w; w.x = pk2(sol[4 * t8].x * e0.x, sol[4 * t8].y * e0.y); w.y = pk2(sol[4 * t8 + 1].x * e0.z, sol[4 * t8 + 1].y * e0.w);
                w.z = pk2(sol[4 * t8 + 2].x * e1.x, sol[4 * t8 + 2].y * e1.y); w.w = pk2(sol[4 * t8 + 3].x * e1.z, sol[4 * t8 + 3].y * e1.w);
                *(GAS u32x4*)(KDT + (((size_t)un * 16 + (dkk >> 4) * 2 + (t8 >> 2)) * 64 + (dkk & 15) + 16 * (t8 & 3)) * 8) = w; }
        }
#pragma unroll
        for (int t4 = 0; t4 < 16; ++t4) { const f32x4 bb = *(const LAS f32x4*)(Bs + 4 * t4); f32x4 ee = (f32x4){1.f, 1.f, 1.f, 1.f}; if (isk) ee = *(const LAS f32x4*)(EGs + 4 * t4);
            sol[2 * t4].x *= bb[0] * ee[0]; sol[2 * t4].y *= bb[1] * ee[1]; sol[2 * t4 + 1].x *= bb[2] * ee[2]; sol[2 * t4 + 1].y *= bb[3] * ee[3]; }
        const LAS float* Lm = (const LAS float*)(ldv + T_LS);
        f32x4 La[8], Lb[8]; f32x2 acc = (f32x2){0.f, 0.f};
#define GL_INFO(sx) const int i_ = (sx) < 32 ? (sx) + 1 : 33 + (((sx) - 32) >> 1); const int tot_ = (i_ + 3) / 4; const int q0_ = ((sx) >= 32 && (((sx) - 32) & 1)) ? 8 : 0; const int nq_ = (sx) < 32 ? tot_ : ((((sx) - 32) & 1) ? tot_ - 8 : 8)
#define GL_LOAD(buf, sx) do { GL_INFO(sx); _Pragma("unroll") for (int q_ = 0; q_ < nq_; ++q_) buf[q_] = *(const LAS f32x4*)(Lm + i_ * 68 + 4 * (q0_ + q_)); } while (0)
#define GL_APPLY(buf, sx) do { GL_INFO(sx); if (q0_ == 0) acc = (f32x2){(i_ & 1) ? sol[i_ >> 1].y : sol[i_ >> 1].x, 0.f}; \
            _Pragma("unroll") for (int q_ = 0; q_ < nq_; ++q_) { acc = acc - (f32x2){buf[q_].x, buf[q_].y} * sol[2 * (q0_ + q_)]; acc = acc - (f32x2){buf[q_].z, buf[q_].w} * sol[2 * (q0_ + q_) + 1]; } \
            if (q0_ + nq_ == tot_) { if (i_ & 1) sol[i_ >> 1].y = acc.x + acc.y; else sol[i_ >> 1].x = acc.x + acc.y; } } while (0)
        GL_LOAD(La, 0);
#pragma unroll
        for (int sx = 0; sx < 94; sx += 2) {
            GL_LOAD(Lb, sx + 1);
            __builtin_amdgcn_sched_barrier(0);
            GL_APPLY(La, sx);
            if (sx + 2 < 94) GL_LOAD(La, sx + 2);
            __builtin_amdgcn_sched_barrier(0);
            GL_APPLY(Lb, sx + 1);
        }
#undef GL_INFO
#undef GL_LOAD
#undef GL_APPLY
        if (!isk) {
            GAS u32x4* upp = (GAS u32x4*)(UT + ((size_t)un * 128 + col) * 64);
#pragma unroll
            for (int t8 = 0; t8 < 8; ++t8) { u32x4 w; w.x = pk2(sol[4 * t8].x, sol[4 * t8].y); w.y = pk2(sol[4 * t8 + 1].x, sol[4 * t8 + 1].y); w.z = pk2(sol[4 * t8 + 2].x, sol[4 * t8 + 2].y); w.w = pk2(sol[4 * t8 + 3].x, sol[4 * t8 + 3].y); upp[t8] = w; }
        } else {
            const int dk = col & 127;
            bf16_t* wp = Wb + (((size_t)un * 16 + (dk >> 5)) * 64 + 16 * ((dk & 31) >> 3)) * 8 + (dk & 7);
#pragma unroll
            for (int t = 0; t < 64; ++t) wp[(((t >> 4) * 4) * 64 + (t & 15)) * 8] = (bf16_t)f2bf((t & 1) ? sol[t >> 1].y : sol[t >> 1].x);
        }
    }
    lds_barrier();
}

constexpr int ST_OFF = 0, ST_ROWB = 272, VN_OFF = 4352, VN_ROWB = 144, SCAN_LDS = VN_OFF + 16 * VN_ROWB;
struct Frag { bf16x8 w[4], qd[4], at[2], kd[2][2]; u32x2 u; float cd; };
struct ScanRs { __amdgpu_buffer_rsrc_t w, qd, kdt, at, ut; const float* CD; };
DI ScanRs scan_rs(const bf16_t* UT, const bf16_t* Wb, const bf16_t* QD, const bf16_t* KDT, const bf16_t* AT, const float* CD) {
    ScanRs r; r.w = __builtin_amdgcn_make_buffer_rsrc((void*)Wb, 0, 0x7ffff000, 0x00020000); r.qd = __builtin_amdgcn_make_buffer_rsrc((void*)QD, 0, 0x7ffff000, 0x00020000);
    r.kdt = __builtin_amdgcn_make_buffer_rsrc((void*)KDT, 0, 0x7ffff000, 0x00020000); r.at = __builtin_amdgcn_make_buffer_rsrc((void*)AT, 0, 0x7ffff000, 0x00020000);
    r.ut = __builtin_amdgcn_make_buffer_rsrc((void*)UT, 0, 0x7ffff000, 0x00020000); r.CD = CD; return r;
}
DI bf16x8 ld128(__amdgpu_buffer_rsrc_t rs, unsigned voff, unsigned soff) { return __builtin_bit_cast(bf16x8, __builtin_amdgcn_raw_buffer_load_b128(rs, voff, soff, 0)); }
DI void load_frag(Frag& f, const ScanRs& R, int un, int sl, int wave, unsigned vl16, unsigned vut) {
    const unsigned sw = (unsigned)((un * 16 + wave * 4) * 1024);
#pragma unroll
    for (int ks = 0; ks < 4; ++ks) { f.w[ks] = ld128(R.w, vl16, sw + ks * 1024); f.qd[ks] = ld128(R.qd, vl16, sw + ks * 1024); }
    const unsigned sa = (unsigned)((un * 8 + wave * 2) * 1024);
#pragma unroll
    for (int ks = 0; ks < 2; ++ks) f.at[ks] = ld128(R.at, vl16, sa + ks * 1024);
#pragma unroll
    for (int rb = 0; rb < 2; ++rb) { const unsigned sk = (unsigned)((un * 16 + (2 * wave + rb) * 2) * 1024);
#pragma unroll
        for (int ks = 0; ks < 2; ++ks) f.kd[rb][ks] = ld128(R.kdt, vl16, sk + ks * 1024); }
    f.u = __builtin_bit_cast(u32x2, __builtin_amdgcn_raw_buffer_load_b64(R.ut, vut, (unsigned)(((un * 128 + 16 * sl) * 64 + 16 * wave) * 2), 0));
    f.cd = R.CD[un];
}
DI void scan_step(LAS unsigned char* lds, const Frag& cur, f32x4& S0, f32x4& S1, __amdgpu_buffer_rsrc_t ro, unsigned vo, int n, int b, int h, int sl, int wave, int e, int kc) {
    f32x4 oq = (f32x4){0.f, 0.f, 0.f, 0.f};
    {
        f32x4 ws = (f32x4){0.f, 0.f, 0.f, 0.f};
#pragma unroll
        for (int ks = 0; ks < 4; ++ks) { const bf16x8 sb = *(const LAS bf16x8*)(lds + ST_OFF + e * ST_ROWB + (32 * ks + 8 * kc) * 2);
            ws = __builtin_amdgcn_mfma_f32_16x16x32_bf16(cur.w[ks], sb, ws, 0, 0, 0);
            oq = __builtin_amdgcn_mfma_f32_16x16x32_bf16(cur.qd[ks], sb, oq, 0, 0, 0); }
        const float v0 = bflo(cur.u.x) - ws[0], v1 = bfhi(cur.u.x) - ws[1], v2 = bflo(cur.u.y) - ws[2], v3 = bfhi(cur.u.y) - ws[3];
        u32x2 vw; vw.x = pk2(v0, v1); vw.y = pk2(v2, v3);
        *(LAS u32x2*)(lds + VN_OFF + e * VN_ROWB + (16 * wave + 4 * kc) * 2) = vw;
    }
    lds_barrier();
    {
        bf16x8 vb[2];
#pragma unroll
        for (int ks = 0; ks < 2; ++ks) vb[ks] = *(const LAS bf16x8*)(lds + VN_OFF + e * VN_ROWB + (32 * ks + 8 * kc) * 2);
#pragma unroll
        for (int ks = 0; ks < 2; ++ks) oq = __builtin_amdgcn_mfma_f32_16x16x32_bf16(cur.at[ks], vb[ks], oq, 0, 0, 0);
        const unsigned so = (unsigned)((((b * SEQ + 64 * n + 16 * wave) * 512) + h * 128 + 16 * sl) * 4);
#pragma unroll
        for (int i = 0; i < 4; ++i) __builtin_amdgcn_raw_buffer_store_b32(__float_as_uint(oq[i]), ro, vo + i * 2048, so, 0);
        S0 = S0 * cur.cd; S1 = S1 * cur.cd;
#pragma unroll
        for (int ks = 0; ks < 2; ++ks) { S0 = __builtin_amdgcn_mfma_f32_16x16x32_bf16(cur.kd[0][ks], vb[ks], S0, 0, 0, 0); S1 = __builtin_amdgcn_mfma_f32_16x16x32_bf16(cur.kd[1][ks], vb[ks], S1, 0, 0, 0); }
        u32x2 s0w, s1w; s0w.x = pk2(S0[0], S0[1]); s0w.y = pk2(S0[2], S0[3]); s1w.x = pk2(S1[0], S1[1]); s1w.y = pk2(S1[2], S1[3]);
        *(LAS u32x2*)(lds + ST_OFF + e * ST_ROWB + (32 * wave + 4 * kc) * 2) = s0w;
        *(LAS u32x2*)(lds + ST_OFF + e * ST_ROWB + (32 * wave + 16 + 4 * kc) * 2) = s1w;
    }
    lds_barrier();
}
DI void scan_unit(LAS unsigned char* lds, const bf16_t* UT, const bf16_t* Wb, const bf16_t* QD, const bf16_t* KDT, const bf16_t* AT, const float* CD, float* ORAW,
                  int bh, int sl, int tid, int wave, int lane) {
    static_assert(NCHUNK == 32, "the trip structure below is 10 x 3 + 2 steps");
    const int e = lane & 15, kc = lane >> 4, b = bh >> 2, h = bh & 3;
    for (int i = tid; i < SCAN_LDS / 4; i += 256) ((LAS unsigned*)lds)[i] = 0u;
    f32x4 S0 = (f32x4){0.f, 0.f, 0.f, 0.f}, S1 = S0;
    const ScanRs R = scan_rs(UT, Wb, QD, KDT, AT, CD);
    const __amdgpu_buffer_rsrc_t ro = __builtin_amdgcn_make_buffer_rsrc((void*)ORAW, 0, 0x7ffff000, 0x00020000);
    const unsigned vl16 = (unsigned)lane * 16u, vut = (unsigned)((e * 64 + 4 * kc) * 2), vo = (unsigned)((4 * kc * 512 + e) * 4);
    Frag f0, f1, f2;
    load_frag(f0, R, bh * 32, sl, wave, vl16, vut); load_frag(f1, R, bh * 32 + 1, sl, wave, vl16, vut);
    lds_barrier();
#pragma unroll 1
    for (int n = 0; n < 30; n += 3) {
        load_frag(f2, R, bh * 32 + n + 2, sl, wave, vl16, vut);
        scan_step(lds, f0, S0, S1, ro, vo, n, b, h, sl, wave, e, kc);
        load_frag(f0, R, bh * 32 + n + 3, sl, wave, vl16, vut);
        scan_step(lds, f1, S0, S1, ro, vo, n + 1, b, h, sl, wave, e, kc);
        load_frag(f1, R, bh * 32 + n + 4, sl, wave, vl16, vut);
        scan_step(lds, f2, S0, S1, ro, vo, n + 2, b, h, sl, wave, e, kc);
    }
    scan_step(lds, f0, S0, S1, ro, vo, 30, b, h, sl, wave, e, kc);
    scan_step(lds, f1, S0, S1, ro, vo, 31, b, h, sl, wave, e, kc);
}
}
constexpr int NWAVES = 8;
constexpr int RING_OFF = 0, RING_BYTES = 155648;
constexpr int LDSCTL_OFF = RING_BYTES, MISC_OFF = LDSCTL_OFF + 320;
constexpr int LDS_BYTES = 163840;

struct Frame {
    LAS unsigned char* lds;
    int tid, lane, wave;
    int vcu, G;
};

struct Args {
    const float* in[25]; float* out; unsigned char* ws;
    int ph_lo, ph_hi, flags, pad;
};
typedef const __attribute__((address_space(4))) Args* KArgs;

enum { WJ_PLAIN = 0, WJ_IN = 1, WJ_KV = 2, WJ_GLU = 3 };
struct WJob { const float* W; const float* W2; const float* gain; bf16_t* dst; int ldw, K, type, nblk; int fp8; unsigned* cmax; };
DI void wjob_src(const WJob& J, int db, const float*& src, int& scol, int& nvalid) {
    src = J.W; scol = 32 * db; nvalid = 32;
    if (J.type == WJ_IN) {
        if (db < 64) scol = 32 * db;
        else if (db < 76) scol = WC_CQ + 32 * (db - 64);
        else if (db < 84) scol = WC_CKV + 32 * (db - 76);
        else if (db == 84) scol = WC_KR;
        else if (db == 85) { scol = WC_A; nvalid = 8; }
        else if (db < 88) { scol = 0; nvalid = 0; }
        else { const int d2 = db - 88, j = d2 >> 3, w = d2 & 7;
               scol = WC_GATE + (w < 4 ? 0 : 1024) + j * 128 + 32 * (w & 3); }
    } else if (J.type == WJ_KV) {
        if (db < 16) scol = (db >> 1) * 128 + 32 * (db & 1);
        else scol = ((db - 16) >> 1) * 128 + 64 + 32 * (db & 1);
    } else if (J.type == WJ_GLU) {
        const int j = db >> 3, w = db & 7;
        if (w < 4) scol = j * 128 + 32 * w; else { src = J.W2; scol = j * 128 + 32 * (w - 4); }
    }
}
DI void wjob_absmax_item(const WJob& J, int item, int lane) {
    const int nkb = J.K >> 6; const int db = item / nkb, kb = item - db * nkb, k0 = kb << 6;
    const float* src; int scol, nvalid; wjob_src(J, db, src, scol, nvalid);
    const int n4 = (lane & 7) * 4, kr = lane >> 3;
    if (nvalid == 0) return;
    f32x4 mx = (f32x4){0.f, 0.f, 0.f, 0.f};
    if (n4 < nvalid) {
#pragma unroll
        for (int i = 0; i < 8; ++i) { const f32x4 v = *(const GAS f32x4*)(src + (size_t)(k0 + kr + 8 * i) * J.ldw + scol + n4);
            mx.x = fmaxf(mx.x, fabsf(v.x)); mx.y = fmaxf(mx.y, fabsf(v.y)); mx.z = fmaxf(mx.z, fabsf(v.z)); mx.w = fmaxf(mx.w, fabsf(v.w)); }
    }
#pragma unroll
    for (int e = 0; e < 4; ++e) { float t = mx[e]; t = fmaxf(t, swz_xor<8>(t)); t = fmaxf(t, swz_xor<16>(t));
        const auto rr = __builtin_amdgcn_permlane32_swap(__float_as_uint(t), __float_as_uint(t), false, false); mx[e] = fmaxf(__uint_as_float(rr[0]), __uint_as_float(rr[1])); }
    if (lane < 8) {
#pragma unroll
        for (int e = 0; e < 4; ++e) __hip_atomic_fetch_max(J.cmax + 32 * db + n4 + e, __float_as_uint(mx[e]), RLX_AGENT);
    }
}
DI void wjob_absmax_run(const WJob& J, int& base, int gw, int NGW, int lane) {
    const int nitems = J.nblk * (J.K >> 6);
    int it = gw - (base % NGW); if (it < 0) it += NGW;
    for (; it < nitems; it += NGW) wjob_absmax_item(J, it, lane);
    base += nitems;
}
DI void wjob_load(const WJob& J, int item, int lane, f32x4 (&v)[8]) {
    const int nkb = J.K >> 6; const int db = item / nkb, kb = item - db * nkb, k0 = kb << 6;
    const float* src; int scol, nvalid; wjob_src(J, db, src, scol, nvalid);
    const int n4 = (lane & 7) * 4, kr = lane >> 3;
    const bool nin = n4 < nvalid;
#pragma unroll
    for (int i = 0; i < 8; ++i) { v[i] = (f32x4){0.f, 0.f, 0.f, 0.f}; if (nin) v[i] = __builtin_nontemporal_load((const GAS f32x4*)(src + (size_t)(k0 + kr + 8 * i) * J.ldw + scol + n4)); }
}
DI void wjob_fin1(const WJob& J, int item, LAS float* scr, int lane, const f32x4 (&v)[8]) {
    const int nkb = J.K >> 6; const int db = item / nkb, kb = item - db * nkb, k0 = kb << 6;
    const int n4 = (lane & 7) * 4, kr = lane >> 3;
#pragma unroll
    for (int i = 0; i < 8; ++i) { const int kk = kr + 8 * i; f32x4 t = v[i];
        if (J.gain) t = t * J.gain[k0 + kk];
        LAS float* d = scr + kk * 33 + n4;
        d[0] = t.x; d[1] = t.y; d[2] = t.z; d[3] = t.w; }
}
DI void wjob_fin2(const WJob& J, int item, LAS float* scr, int lane, const float (&inv)[4]) {
    const int nkb = J.K >> 6; const int db = item / nkb, kb = item - db * nkb, k0 = kb << 6;
    const int c = lane & 7;
#pragma unroll
    for (int j = 0; j < 4; ++j) { const int nn = (lane >> 3) + 8 * j; const LAS float* s = scr + (8 * c) * 33 + nn;
        if (J.fp8 == 2) {
            unsigned w0 = 0u, w1 = 0u;
#pragma unroll
            for (int i = 0; i < 4; ++i) { w0 = __builtin_amdgcn_cvt_pk_u8_f32(__builtin_rintf(s[i * 33] * inv[j]) + 128.f, i, w0); w1 = __builtin_amdgcn_cvt_pk_u8_f32(__builtin_rintf(s[(i + 4) * 33] * inv[j]) + 128.f, i, w1); }
            u32x2 o; o.x = w0 ^ 0x80808080u; o.y = w1 ^ 0x80808080u;
            *(GAS u32x2*)((unsigned char*)J.dst + (size_t)(32 * db + nn) * J.K + k0 + 8 * c) = o;
        } else if (J.fp8) {
            float q[8];
#pragma unroll
            for (int i = 0; i < 8; ++i) q[i] = __builtin_amdgcn_fmed3f(s[i * 33] * W8_SCALE, -448.f, 448.f);
            unsigned w0 = __builtin_amdgcn_cvt_pk_fp8_f32(q[0], q[1], 0, false); w0 = __builtin_amdgcn_cvt_pk_fp8_f32(q[2], q[3], w0, true);
            unsigned w1 = __builtin_amdgcn_cvt_pk_fp8_f32(q[4], q[5], 0, false); w1 = __builtin_amdgcn_cvt_pk_fp8_f32(q[6], q[7], w1, true);
            u32x2 o; o.x = w0; o.y = w1;
            *(GAS u32x2*)((unsigned char*)J.dst + (size_t)(32 * db + nn) * J.K + k0 + 8 * c) = o;
        } else {
        u32x4 o; o.x = pk2(s[0 * 33], s[1 * 33]); o.y = pk2(s[2 * 33], s[3 * 33]); o.z = pk2(s[4 * 33], s[5 * 33]); o.w = pk2(s[6 * 33], s[7 * 33]);
        *(GAS u32x4*)(J.dst + (size_t)(32 * db + nn) * J.K + k0 + 8 * c) = o; } }
}
DI void wjob_item(const WJob& J, int item, LAS float* scr, int lane) {
    f32x4 v[8]; wjob_load(J, item, lane, v);
    float inv[4] = {0.f, 0.f, 0.f, 0.f};
    if (J.fp8 == 2) { const int db = item / (J.K >> 6);
#pragma unroll
        for (int j = 0; j < 4; ++j) { const float cm = __uint_as_float(__hip_atomic_load(J.cmax + 32 * db + (lane >> 3) + 8 * j, RLX_AGENT)); inv[j] = cm > 0.f ? 127.f / cm : 0.f; } }
    wjob_fin1(J, item, scr, lane, v);
    LDS_WAIT(); asm volatile("" ::: "memory");
    wjob_fin2(J, item, scr, lane, inv);
    LDS_WAIT(); asm volatile("" ::: "memory");
}
DI void wjob_run(const WJob& J, int& base, int gw, int NGW, LAS float* scr, int lane) {
    const int nitems = J.nblk * (J.K >> 6);
    int it = gw - (base % NGW); if (it < 0) it += NGW;
    for (; it < nitems; it += NGW) wjob_item(J, it, scr, lane);
    base += nitems;
}

DI void dec_proj(KArgs ap, unsigned char* ws, int l, int idx, WJob& J, int& item) {
    if (idx < 256) { J = WJob{ap->in[9] + (size_t)l * 512 * D, nullptr, nullptr, (bf16_t*)(ws + WS_WGDNO + l * MiB), D, 512, WJ_PLAIN, 32, 0, nullptr}; item = idx; }
    else if (idx < 512) { J = WJob{ap->in[14] + (size_t)l * 512 * D, nullptr, nullptr, (bf16_t*)(ws + WS_WMLAO + l * MiB), D, 512, WJ_PLAIN, 32, 0, nullptr}; item = idx - 256; }
    else { J = WJob{ap->in[15] + (size_t)l * D * D, nullptr, nullptr, (bf16_t*)(ws + WS_WOUT + l * 2 * MiB), D, 1024, WJ_PLAIN, 32, 0, nullptr}; item = idx - 512; }
}
DI void dec_qkv(KArgs ap, unsigned char* ws, int l, int idx, WJob& J, int& item) {
    if (idx < 144) { J = WJob{ap->in[11] + (size_t)l * 384 * 768, nullptr, ap->in[10] + l * 384, (bf16_t*)(ws + WS_WQB + l * 768 * KiB), 768, 384, WJ_PLAIN, 24, 0, nullptr}; item = idx; }
    else { J = WJob{ap->in[13] + (size_t)l * 256 * 1024, nullptr, ap->in[12] + l * 256, (bf16_t*)(ws + WS_WKVB + l * 512 * KiB), 1024, 256, WJ_KV, 32, 0, nullptr}; item = idx - 144; }
}
constexpr int NPROJ_ITEMS = 1024, NQKV_ITEMS = 272, NCONV_L0 = NPROJ_ITEMS + 32 * (D_FF / 64);
constexpr int MOE_ITEMS_E = (2 * DFE / 32) * 16 + 32 * (DFE / 64), MOE_ITEMS = NE * MOE_ITEMS_E;
DI void dec_moe(KArgs ap, unsigned char* ws, int idx, WJob& J, int& item) {
    const int e = idx / MOE_ITEMS_E, r = idx - e * MOE_ITEMS_E;
    if (r < (2 * DFE / 32) * 16) { J = WJob{ap->in[21] + (size_t)e * D * DFE, ap->in[22] + (size_t)e * D * DFE, nullptr, (bf16_t*)((unsigned char*)ap->out + e * (7 * MiB / 2)), DFE, 1024, WJ_GLU, 2 * DFE / 32, 1, nullptr}; item = r; }
    else { J = WJob{ap->in[23] + (size_t)e * DFE * D, nullptr, nullptr, (bf16_t*)(ws + WS_WM2 + e * (7 * MiB / 4)), D, DFE, WJ_PLAIN, 32, 1, nullptr}; item = r - (2 * DFE / 32) * 16; }
}
DI void conv_dec(KArgs ap, unsigned char* ws, int mode, int idx, WJob& J, int& item) {
    if (mode == 2) dec_moe(ap, ws, idx, J, item);
    else if (idx < NPROJ_ITEMS) dec_proj(ap, ws, 1, idx, J, item);
    else { J = WJob{ap->in[19], nullptr, nullptr, (bf16_t*)(ws + WS_WD2), D, D_FF, WJ_PLAIN, 32, DENSE_DN_FP8, nullptr}; item = idx - NPROJ_ITEMS; }
}
#define CONV_BAR0() do { asm volatile("s_waitcnt lgkmcnt(0)" ::: "memory"); __builtin_amdgcn_s_barrier(); asm volatile("" ::: "memory"); } while (0)
constexpr unsigned OOB = 0x80000000u;
DI void cjob_load(const WJob& J, int item, bool valid, int lane, f32x4 (&v)[8]) {
    const int nkb = J.K >> 6; const int db = item / nkb, kb = item - db * nkb, k0 = kb << 6;
    const float* src; int scol, nvalid; wjob_src(J, db, src, scol, nvalid);
    const __amdgpu_buffer_rsrc_t rs = __builtin_amdgcn_make_buffer_rsrc((void*)src, 0, 0x7ffff000, 0x00020000);
    const int n4 = (lane & 7) * 4, kr = lane >> 3;
    const unsigned bad = (valid && n4 < nvalid) ? 0u : OOB;
#pragma unroll
    for (int i = 0; i < 8; ++i) v[i] = __builtin_bit_cast(f32x4, __builtin_amdgcn_raw_buffer_load_b128(rs, (unsigned)(((k0 + kr + 8 * i) * J.ldw + scol + n4) * 4) | bad, 0, 2));
}
DI void cjob_fin1(LAS float* scr, int lane, const f32x4 (&v)[8]) {
    const int n4 = (lane & 7) * 4, kr = lane >> 3;
#pragma unroll
    for (int i = 0; i < 8; ++i) { LAS float* d = scr + (kr + 8 * i) * 33 + n4; d[0] = v[i].x; d[1] = v[i].y; d[2] = v[i].z; d[3] = v[i].w; }
}
DI void cjob_fin2(const WJob& J, int item, bool valid, LAS float* scr, int lane, const float (&inv)[4]) {
    const int nkb = J.K >> 6; const int db = item / nkb, kb = item - db * nkb, k0 = kb << 6;
    const int c = lane & 7;
    const __amdgpu_buffer_rsrc_t rd = __builtin_amdgcn_make_buffer_rsrc((void*)J.dst, 0, 0x7ffff000, 0x00020000);
    const unsigned bad = valid ? 0u : OOB;
#pragma unroll
    for (int j = 0; j < 4; ++j) { const int nn = (lane >> 3) + 8 * j; const LAS float* s = scr + (8 * c) * 33 + nn;
        if (J.fp8 == 2) {
            unsigned w0 = 0u, w1 = 0u;
#pragma unroll
            for (int i = 0; i < 4; ++i) { w0 = __builtin_amdgcn_cvt_pk_u8_f32(__builtin_rintf(s[i * 33] * inv[j]) + 128.f, i, w0); w1 = __builtin_amdgcn_cvt_pk_u8_f32(__builtin_rintf(s[(i + 4) * 33] * inv[j]) + 128.f, i, w1); }
            u32x2 o; o.x = w0 ^ 0x80808080u; o.y = w1 ^ 0x80808080u;
            __builtin_amdgcn_raw_buffer_store_b64(o, rd, (unsigned)((32 * db + nn) * J.K + k0 + 8 * c) | bad, 0, 2);
        } else if (J.fp8) {
            float q[8];
#pragma unroll
            for (int i = 0; i < 8; ++i) q[i] = __builtin_amdgcn_fmed3f(s[i * 33] * W8_SCALE, -448.f, 448.f);
            unsigned w0 = __builtin_amdgcn_cvt_pk_fp8_f32(q[0], q[1], 0, false); w0 = __builtin_amdgcn_cvt_pk_fp8_f32(q[2], q[3], w0, true);
            unsigned w1 = __builtin_amdgcn_cvt_pk_fp8_f32(q[4], q[5], 0, false); w1 = __builtin_amdgcn_cvt_pk_fp8_f32(q[6], q[7], w1, true);
            u32x2 o; o.x = w0; o.y = w1;
            __builtin_amdgcn_raw_buffer_store_b64(o, rd, (unsigned)((32 * db + nn) * J.K + k0 + 8 * c) | bad, 0, 2);
        } else {
            u32x4 o; o.x = pk2(s[0 * 33], s[1 * 33]); o.y = pk2(s[2 * 33], s[3 * 33]); o.z = pk2(s[4 * 33], s[5 * 33]); o.w = pk2(s[6 * 33], s[7 * 33]);
            __builtin_amdgcn_raw_buffer_store_b128(o, rd, (unsigned)(((32 * db + nn) * J.K + k0 + 8 * c) * 2) | bad, 0, 2); } }
}
DI void cjob_pad_stores(unsigned char* ws, int lane) {
    const __amdgpu_buffer_rsrc_t rd = __builtin_amdgcn_make_buffer_rsrc((void*)ws, 0, 0x7ffff000, 0x00020000);
    u32x2 z; z.x = (unsigned)lane; z.y = (unsigned)lane;
#pragma unroll
    for (int j = 0; j < 4; ++j) __builtin_amdgcn_raw_buffer_store_b64(z, rd, OOB, 0, 0);
}
DI void conv_stream(KArgs ap, unsigned char* ws, int mode, int first, int stride, int total, int nbar, LAS float* scr, int lane) {
    f32x4 va[8], vb[8]; WJob J; int item; const float inv0[4] = {0.f, 0.f, 0.f, 0.f};
    int pa = first, pb2 = first + stride, nxt = first + 2 * stride;
    conv_dec(ap, ws, mode, pa < total ? pa : 0, J, item); cjob_load(J, item, pa < total, lane, va); cjob_pad_stores(ws, lane);
    conv_dec(ap, ws, mode, pb2 < total ? pb2 : 0, J, item); cjob_load(J, item, pb2 < total, lane, vb); cjob_pad_stores(ws, lane);
    int step = 0;
    if (nbar > 0) CONV_BAR0();
#pragma unroll 1
    for (;;) {
        const bool paced = nbar > 0 && step < NCHUNK;
        if (!paced && pa >= total) break;
        { const int pc = pa; WJob Jc; int ic;
          conv_dec(ap, ws, mode, pc < total ? pc : 0, Jc, ic); cjob_fin1(scr, lane, va);
          pa = nxt; nxt += stride; conv_dec(ap, ws, mode, pa < total ? pa : 0, J, item); cjob_load(J, item, pa < total, lane, va);
          if (paced) lds_barrier(); else { LDS_WAIT(); asm volatile("" ::: "memory"); }
          cjob_fin2(Jc, ic, pc < total, scr, lane, inv0);
          if (paced) lds_barrier(); else { LDS_WAIT(); asm volatile("" ::: "memory"); } }
        { const int pc = pb2; WJob Jc; int ic;
          conv_dec(ap, ws, mode, pc < total ? pc : 0, Jc, ic); cjob_fin1(scr, lane, vb);
          pb2 = nxt; nxt += stride; conv_dec(ap, ws, mode, pb2 < total ? pb2 : 0, J, item); cjob_load(J, item, pb2 < total, lane, vb);
          if (paced) lds_barrier(); else { LDS_WAIT(); asm volatile("" ::: "memory"); }
          cjob_fin2(Jc, ic, pc < total, scr, lane, inv0);
          if (paced) lds_barrier(); else { LDS_WAIT(); asm volatile("" ::: "memory"); } }
        step += 2;
    }
#pragma unroll 1
    for (int u = 1; u < nbar; ++u) { CONV_BAR0();
#pragma unroll 1
        for (int n = 0; n < 2 * NCHUNK; ++n) lds_barrier(); }
}
DI void absmax_acc(f32x4& mx, const f32x4 (&v)[8]) {
#pragma unroll
    for (int i = 0; i < 8; ++i) { mx.x = fmaxf(mx.x, fabsf(v[i].x)); mx.y = fmaxf(mx.y, fabsf(v[i].y)); mx.z = fmaxf(mx.z, fabsf(v[i].z)); mx.w = fmaxf(mx.w, fabsf(v[i].w)); }
}
DI void conv_i8_block(const WJob& J, int db, bool bars, LAS float* scr, int lane) {
    f32x4 va[8], vb[8]; f32x4 mx = (f32x4){0.f, 0.f, 0.f, 0.f};
    cjob_load(J, db * 16, true, lane, va); cjob_load(J, db * 16 + 1, true, lane, vb);
    if (bars) CONV_BAR0();
#pragma unroll 1
    for (int kb = 0; kb < 16; kb += 2) {
        absmax_acc(mx, va); cjob_load(J, db * 16 + ((kb + 2) & 15), true, lane, va);
        if (bars) { lds_barrier(); lds_barrier(); }
        absmax_acc(mx, vb); cjob_load(J, db * 16 + ((kb + 3) & 15), true, lane, vb);
        if (bars) { lds_barrier(); lds_barrier(); }
    }
#pragma unroll
    for (int e = 0; e < 4; ++e) { float t = mx[e]; t = fmaxf(t, swz_xor<8>(t)); t = fmaxf(t, swz_xor<16>(t));
        const auto rr = __builtin_amdgcn_permlane32_swap(__float_as_uint(t), __float_as_uint(t), false, false); mx[e] = fmaxf(__uint_as_float(rr[0]), __uint_as_float(rr[1])); }
    if (lane < 8) {
#pragma unroll
        for (int e = 0; e < 4; ++e) { J.cmax[32 * db + 4 * lane + e] = __float_as_uint(mx[e]); scr[2112 + 4 * lane + e] = mx[e]; } }
    LDS_WAIT(); asm volatile("" ::: "memory");
    float inv[4];
#pragma unroll
    for (int j = 0; j < 4; ++j) { const float cm = scr[2112 + (lane >> 3) + 8 * j]; inv[j] = cm > 0.f ? 127.f / cm : 0.f; }
#pragma unroll 1
    for (int kb = 0; kb < 16; kb += 2) {
        cjob_fin1(scr, lane, va); cjob_load(J, db * 16 + ((kb + 2) & 15), kb + 2 < 16, lane, va);
        if (bars) lds_barrier(); else { LDS_WAIT(); asm volatile("" ::: "memory"); }
        cjob_fin2(J, db * 16 + kb, true, scr, lane, inv);
        if (bars) lds_barrier(); else { LDS_WAIT(); asm volatile("" ::: "memory"); }
        cjob_fin1(scr, lane, vb); cjob_load(J, db * 16 + ((kb + 3) & 15), kb + 3 < 16, lane, vb);
        if (bars) lds_barrier(); else { LDS_WAIT(); asm volatile("" ::: "memory"); }
        cjob_fin2(J, db * 16 + kb + 1, true, scr, lane, inv);
        if (bars) lds_barrier(); else { LDS_WAIT(); asm volatile("" ::: "memory"); }
    }
}
constexpr int NI8_L1 = NPROJ / 32, NI8_BLOCKS = NPROJ / 32 + 2 * D_FF / 32;
DI void conv_i8_job(KArgs ap, unsigned char* ws, int b, WJob& J, int& db) {
    unsigned* cmx = (unsigned*)(ws + WS_CTL) + CW_CMAX;
    if (b < NI8_L1) { J = WJob{ap->in[3] + (size_t)D * IN_COLS, nullptr, nullptr, (bf16_t*)(ws + WS_WIN + WIN_STRIDE), IN_COLS, 1024, WJ_IN, NPROJ / 32, 2, cmx + NPROJ}; db = b; }
    else { J = WJob{ap->in[17], ap->in[18], nullptr, (bf16_t*)(ws + WS_WD13), D_FF, 1024, WJ_GLU, 2 * D_FF / 32, 2, cmx + 2 * NPROJ}; db = b - NI8_L1; }
}
DI void scan_converter(KArgs ap, unsigned char* ws, int l, int cw, int NCW, int nun, LAS float* scr, int lane) {
    int nb = nun;
    if (l == 0) {
        const bool split = NCW >= NI8_BLOCKS + 64;
#pragma unroll 1
        for (int b = cw; b < NI8_BLOCKS; b += NCW) { WJob J; int db; conv_i8_job(ap, ws, b, J, db); conv_i8_block(J, db, nb > 0, scr, lane); if (nb > 0) --nb; }
        if (split) { if (cw >= NI8_BLOCKS) conv_stream(ap, ws, 1, cw - NI8_BLOCKS, NCW - NI8_BLOCKS, NCONV_L0, nb, scr, lane); else conv_stream(ap, ws, 1, 0, 1, 0, nb, scr, lane); }
        else conv_stream(ap, ws, 1, cw, NCW, NCONV_L0, nb, scr, lane);
    } else conv_stream(ap, ws, 2, cw, NCW, MOE_ITEMS, nb, scr, lane);
}

DI float rms_row_load(const float* xrow, const float* gain, int lane, f32x4 (&v)[4]) {
    const GAS f32x4* xr = (const GAS f32x4*)xrow + lane;
    float ss = 0.f;
#pragma unroll
    for (int j = 0; j < 4; ++j) { v[j] = xr[64 * j]; ss += (v[j].x * v[j].x + v[j].y * v[j].y) + (v[j].z * v[j].z + v[j].w * v[j].w); }
    ss = wave_sum(ss);
    const float rstd = rsqrtf(ss * (1.f / D) + EPS);
    const GAS f32x4* gr = (const GAS f32x4*)gain + lane;
#pragma unroll
    for (int j = 0; j < 4; ++j) v[j] = v[j] * gr[64 * j] * rstd;
    return rstd;
}
DI float rms_row_load_b(const bf16_t* xrow, const float* gain, int lane, f32x4 (&v)[4]) {
    const GAS u32x2* xr = (const GAS u32x2*)xrow + lane;
    float ss = 0.f;
#pragma unroll
    for (int j = 0; j < 4; ++j) { const u32x2 w = xr[64 * j]; v[j] = (f32x4){bflo(w.x), bfhi(w.x), bflo(w.y), bfhi(w.y)}; ss += (v[j].x * v[j].x + v[j].y * v[j].y) + (v[j].z * v[j].z + v[j].w * v[j].w); }
    ss = wave_sum(ss);
    const float rstd = rsqrtf(ss * (1.f / D) + EPS);
    const GAS f32x4* gr = (const GAS f32x4*)gain + lane;
#pragma unroll
    for (int j = 0; j < 4; ++j) v[j] = v[j] * gr[64 * j] * rstd;
    return rstd;
}
DI void row_store_bf16(bf16_t* orow, int lane, const f32x4 (&v)[4]) {
    GAS u32x2* o8 = (GAS u32x2*)orow + lane;
#pragma unroll
    for (int j = 0; j < 4; ++j) { u32x2 w; w.x = pk2(v[j].x, v[j].y); w.y = pk2(v[j].z, v[j].w); o8[64 * j] = w; }
}
DI float wave_max(float v) {
    v = fmaxf(v, swz_xor<1>(v)); v = fmaxf(v, swz_xor<2>(v)); v = fmaxf(v, swz_xor<4>(v)); v = fmaxf(v, swz_xor<8>(v)); v = fmaxf(v, swz_xor<16>(v));
    const auto rr = __builtin_amdgcn_permlane32_swap(__float_as_uint(v), __float_as_uint(v), false, false); return fmaxf(__uint_as_float(rr[0]), __uint_as_float(rr[1]));
}
DI void row_store_i8(unsigned char* orow, float* srow, int lane, const f32x4 (&v)[4]) {
    float am = 0.f;
#pragma unroll
    for (int j = 0; j < 4; ++j) am = fmaxf(fmaxf(am, fmaxf(fabsf(v[j].x), fabsf(v[j].y))), fmaxf(fabsf(v[j].z), fabsf(v[j].w)));
    am = wave_max(am);
    const float inv = am > 0.f ? 127.f / am : 0.f;
    GAS unsigned* o = (GAS unsigned*)orow + lane;
#pragma unroll
    for (int j = 0; j < 4; ++j) { unsigned w = 0u;
        w = __builtin_amdgcn_cvt_pk_u8_f32(__builtin_rintf(v[j].x * inv) + 128.f, 0, w); w = __builtin_amdgcn_cvt_pk_u8_f32(__builtin_rintf(v[j].y * inv) + 128.f, 1, w);
        w = __builtin_amdgcn_cvt_pk_u8_f32(__builtin_rintf(v[j].z * inv) + 128.f, 2, w); w = __builtin_amdgcn_cvt_pk_u8_f32(__builtin_rintf(v[j].w * inv) + 128.f, 3, w);
        o[64 * j] = w ^ 0x80808080u; }
    if (lane == 0) *srow = am * (1.f / 127.f);
}
DI void row_issue_b(const bf16_t* xrow, int lane, u32x2 (&w)[4]) { const GAS u32x2* xr = (const GAS u32x2*)xrow + lane;
#pragma unroll
    for (int j = 0; j < 4; ++j) w[j] = xr[64 * j]; }
DI void row_issue_f(const float* xrow, int lane, f32x4 (&w)[4]) { const GAS f32x4* xr = (const GAS f32x4*)xrow + lane;
#pragma unroll
    for (int j = 0; j < 4; ++j) w[j] = __builtin_nontemporal_load(xr + 64 * j); }
DI void row_norm_b(const u32x2 (&w)[4], const f32x4 (&g)[4], f32x4 (&v)[4]) {
    float ss = 0.f;
#pragma unroll
    for (int j = 0; j < 4; ++j) { v[j] = (f32x4){bflo(w[j].x), bfhi(w[j].x), bflo(w[j].y), bfhi(w[j].y)}; ss += (v[j].x * v[j].x + v[j].y * v[j].y) + (v[j].z * v[j].z + v[j].w * v[j].w); }
    ss = wave_sum(ss); const float rstd = rsqrtf(ss * (1.f / D) + EPS);
#pragma unroll
    for (int j = 0; j < 4; ++j) v[j] = v[j] * g[j] * rstd;
}
DI void row_norm_f(const f32x4 (&w)[4], const f32x4 (&g)[4], f32x4 (&v)[4]) {
    float ss = 0.f;
#pragma unroll
    for (int j = 0; j < 4; ++j) { v[j] = w[j]; ss += (v[j].x * v[j].x + v[j].y * v[j].y) + (v[j].z * v[j].z + v[j].w * v[j].w); }
    ss = wave_sum(ss); const float rstd = rsqrtf(ss * (1.f / D) + EPS);
#pragma unroll
    for (int j = 0; j < 4; ++j) v[j] = v[j] * g[j] * rstd;
}
DI void norm_rows_i8(int gw, int NGW, int lane, const float* X, const float* gain, bf16_t* XN8, float* sA) {
    f32x4 g[4]; { const GAS f32x4* gr = (const GAS f32x4*)gain + lane;
#pragma unroll
        for (int j = 0; j < 4; ++j) g[j] = gr[64 * j]; }
    f32x4 wn[4];
#pragma unroll
    for (int j = 0; j < 4; ++j) wn[j] = (f32x4){0.f, 0.f, 0.f, 0.f};
    if (gw < M) row_issue_f(X + (size_t)gw * D, lane, wn);
#pragma unroll 1
    for (int m = gw; m < M; m += NGW) {
        f32x4 wc[4];
#pragma unroll
        for (int j = 0; j < 4; ++j) wc[j] = wn[j];
        asm volatile("" : "+v"(wc[0]), "+v"(wc[1]), "+v"(wc[2]), "+v"(wc[3]));
        if (m + NGW < M) row_issue_f(X + (size_t)(m + NGW) * D, lane, wn);
        f32x4 v[4]; row_norm_f(wc, g, v); row_store_i8((unsigned char*)XN8 + (size_t)m * D, sA + m, lane, v);
    }
}
DI void norm_rows_bi8(int gw, int NGW, int lane, const bf16_t* X, const float* gain, bf16_t* XN8, float* sA) {
    f32x4 g[4]; { const GAS f32x4* gr = (const GAS f32x4*)gain + lane;
#pragma unroll
        for (int j = 0; j < 4; ++j) g[j] = gr[64 * j]; }
    u32x2 wn[4];
#pragma unroll
    for (int j = 0; j < 4; ++j) wn[j] = (u32x2){0u, 0u};
    if (gw < M) row_issue_b(X + (size_t)gw * D, lane, wn);
#pragma unroll 1
    for (int m = gw; m < M; m += NGW) {
        u32x2 wc[4];
#pragma unroll
        for (int j = 0; j < 4; ++j) wc[j] = wn[j];
        asm volatile("" : "+v"(wc[0]), "+v"(wc[1]), "+v"(wc[2]), "+v"(wc[3]));
        if (m + NGW < M) row_issue_b(X + (size_t)(m + NGW) * D, lane, wn);
        f32x4 v[4]; row_norm_b(wc, g, v); row_store_i8((unsigned char*)XN8 + (size_t)m * D, sA + m, lane, v);
    }
}
DI void norm_rows_b8(int gw, int NGW, int lane, const bf16_t* X, const float* gain, bf16_t* XN8) {
    for (int m = gw; m < M; m += NGW) { f32x4 v[4]; rms_row_load_b(X + (size_t)m * D, gain, lane, v);
        GAS unsigned* o8 = (GAS unsigned*)((unsigned char*)XN8 + (size_t)m * D) + lane;
#pragma unroll
        for (int j = 0; j < 4; ++j) { const float c0 = __builtin_amdgcn_fmed3f(v[j].x, -448.f, 448.f), c1 = __builtin_amdgcn_fmed3f(v[j].y, -448.f, 448.f), c2 = __builtin_amdgcn_fmed3f(v[j].z, -448.f, 448.f), c3 = __builtin_amdgcn_fmed3f(v[j].w, -448.f, 448.f);
            unsigned w = __builtin_amdgcn_cvt_pk_fp8_f32(c0, c1, 0, false); w = __builtin_amdgcn_cvt_pk_fp8_f32(c2, c3, w, true); o8[64 * j] = w; } }
}
DI void norm_rows_b(int gw, int NGW, int lane, const bf16_t* X, const float* gain, bf16_t* XN) {
    for (int m = gw; m < M; m += NGW) { f32x4 v[4]; rms_row_load_b(X + (size_t)m * D, gain, lane, v); row_store_bf16(XN + (size_t)m * D, lane, v); }
}
DI void norm_rows(int gw, int NGW, int lane, const float* X, const float* gain, bf16_t* XN) {
    for (int m = gw; m < M; m += NGW) { f32x4 v[4]; rms_row_load(X + (size_t)m * D, gain, lane, v); row_store_bf16(XN + (size_t)m * D, lane, v); }
}

#ifdef PROBE_MFMA
typedef int i32x4 __attribute__((ext_vector_type(4)));
__device__ __noinline__ void mfma_rate_probe(unsigned* sink, int iters) {
    const int l = lane_id_asm();
    i32x4 a = (i32x4){l, l * 3, l * 5, l * 7}, b = (i32x4){l * 11, l * 13, l * 17, l * 19};
#if PROBE_MFMA == 2
    i32x4 acc[8];
#pragma unroll
    for (int i = 0; i < 8; ++i) acc[i] = (i32x4){0, 0, 0, 0};
#pragma unroll 1
    for (int it = 0; it < iters; ++it) {
#pragma unroll
        for (int i = 0; i < 8; ++i) acc[i] = __builtin_amdgcn_mfma_i32_16x16x64_i8(a, b, acc[i], 0, 0, 0);
        asm volatile("" : "+v"(a), "+v"(b));
    }
    int s = 0;
#pragma unroll
    for (int i = 0; i < 8; ++i) s += acc[i][0] + acc[i][1] + acc[i][2] + acc[i][3];
    if (s == 0x12345678) sink[l] = (unsigned)s;
#else
    f32x4 acc[8];
#pragma unroll
    for (int i = 0; i < 8; ++i) acc[i] = (f32x4){0.f, 0.f, 0.f, 0.f};
    bf16x8 a8 = __builtin_bit_cast(bf16x8, a), b8 = __builtin_bit_cast(bf16x8, b);
#pragma unroll 1
    for (int it = 0; it < iters; ++it) {
#pragma unroll
        for (int i = 0; i < 8; ++i) acc[i] = __builtin_amdgcn_mfma_f32_16x16x32_bf16(a8, b8, acc[i], 0, 0, 0);
        asm volatile("" : "+v"(a8), "+v"(b8));
    }
    float s = 0.f;
#pragma unroll
    for (int i = 0; i < 8; ++i) s += acc[i][0] + acc[i][1] + acc[i][2] + acc[i][3];
    if (s == 123.456f) sink[l] = __float_as_uint(s);
#endif
}
#endif
#define PHASE_BUFS \
    const float* x = ap->in[0]; const int* pos = (const int*)ap->in[1]; \
    const float* mix_norm = ap->in[2]; const float* w_in = ap->in[3]; const float* gate_bias = ap->in[4]; \
    const float* conv_w = ap->in[5]; const float* a_log = ap->in[6]; const float* dt_bias = ap->in[7]; const float* gdn_out_norm = ap->in[8]; \
    const float* w_gdn_o = ap->in[9]; const float* q_a_norm = ap->in[10]; \
    const float* w_q_b = ap->in[11]; const float* kv_a_norm = ap->in[12]; const float* w_kv_b = ap->in[13]; \
    const float* w_mla_o = ap->in[14]; const float* w_out = ap->in[15]; const float* ffn_norm = ap->in[16]; \
    const float* dense_w1 = ap->in[17]; const float* dense_w3 = ap->in[18]; const float* dense_w2 = ap->in[19]; \
    const float* router_w = ap->in[20]; const float* moe_w1 = ap->in[21]; const float* moe_w3 = ap->in[22]; \
    const float* moe_w2 = ap->in[23]; const float* final_norm = ap->in[24]; \
    float* X = ap->out; \
    bf16_t* GATE = (bf16_t*)(ws + WS_GATE); bf16_t* Zb = (bf16_t*)(ws + WS_Z); bf16_t* MISC = (bf16_t*)(ws + WS_MISC); bf16_t* QKV = (bf16_t*)(ws + WS_QKV); \
    bf16_t* Qb = (bf16_t*)(ws + WS_Q); bf16_t* Kb = (bf16_t*)(ws + WS_K); bf16_t* Vb = (bf16_t*)(ws + WS_V); bf16_t* AO = (bf16_t*)(ws + WS_AO); bf16_t* GO = (bf16_t*)(ws + WS_GO); \
    bf16_t* XN = (bf16_t*)((unsigned char*)ap->out + OUT_XN); bf16_t* MERGED = XN; bf16_t* XB = (bf16_t*)(ws + WS_XB); \
    bf16_t* HB = (bf16_t*)(ws + WS_HB); bf16_t* XG = (bf16_t*)(ws + WS_XG); bf16_t* Hm = (bf16_t*)(ws + WS_H); bf16_t* Yb = (bf16_t*)(ws + WS_Y); \
    float* ORAW = (float*)((unsigned char*)ap->out + OUT_XN); float* COS = (float*)(ws + WS_COS); float* SIN = (float*)(ws + WS_SIN); float* rstdq = (float*)(ws + WS_RSTD); float* rstdkv = rstdq + M; \
    int* topi = (int*)(ws + WS_MOE); float* topw = (float*)(topi + 2 * M); int* pairrow = (int*)(topw + 2 * M); int* list = pairrow + 2 * M; int* offs = list + NE * M; \
    unsigned* cnt = (unsigned*)(ws + WS_CTL) + CW_CNT; unsigned* cmx = (unsigned*)(ws + WS_CTL) + CW_CMAX; float* SAq = (float*)(ws + WS_SA);
__global__ void __launch_bounds__(NWAVES * 64, 2) mega_fwd(Args args) {
    extern __shared__ __attribute__((aligned(16))) unsigned char lds_raw[];
    Frame F;
    F.lds = (LAS unsigned char*)lds_raw;
    volatile LAS unsigned* MISCW = (volatile LAS unsigned*)(F.lds + MISC_OFF);
    F.tid = threadIdx.x; F.lane = F.tid & 63; F.wave = __builtin_amdgcn_readfirstlane(F.tid >> 6);
    F.G = gridDim.x; { const int bx = blockIdx.x; F.vcu = (F.G % 8 == 0) ? (bx % 8) * (F.G / 8) + bx / 8 : bx; }
    unsigned* ctl = (unsigned*)(args.ws + WS_CTL);
    for (int u = F.tid; u < (LDS_BYTES - LDSCTL_OFF) / 4; u += NWAVES * 64) ((LAS unsigned*)(F.lds + LDSCTL_OFF))[u] = 0u;
    __syncthreads();
    XcdBarrier bar = xcd_barrier_post(ctl + CW_BAR, MISCW + 8); bar.wave = F.wave;
    const int lo = args.ph_lo, hi = args.ph_hi;
#ifndef PROBE_LOCAL_X
#define PROBE_LOCAL_X 1
#endif
#ifndef PHASE_ENABLE
#define PHASE_ENABLE 0xFFFFFFF
#endif
#define P_ON(k) (((PHASE_ENABLE) >> (k)) & 1)
#define IN(k) (lo <= (k) && (k) < hi)
#define PHASE_BEGIN int pw = F.wave, pbx = (int)blockIdx.x, pG = F.G; asm volatile("" : "+s"(pw), "+s"(pbx), "+s"(pG)); int lane_ = lane_id_asm(); const int lane = lane_, tid = pw * 64 + lane_; (void)tid; const int gw = F.vcu * NWAVES + pw, NGW = F.G * NWAVES; (void)gw; (void)NGW; LAS float* scr = (LAS float*)(F.lds + RING_OFF + pw * 16384); (void)scr; KArgs ap = (KArgs)__builtin_amdgcn_kernarg_segment_ptr(); asm volatile("" : "+s"(ap)); unsigned char* ws = ap->ws; PHASE_BUFS
#define SEAM(k) do { if (IN(k) && IN((k) + 1)) xcd_barrier(bar); } while (0)


#ifdef PROBE_MFMA
    mfma_rate_probe((unsigned*)(args.ws + WS_END), 2000);
#endif
    if (IN(0) && P_ON(12)) { PHASE_BEGIN;
        WJob Jin{w_in, nullptr, nullptr, (bf16_t*)(ws + WS_WIN), IN_COLS, 1024, WJ_IN, NPROJ / 32, 2, cmx};
        const int nin = (NPROJ / 32) * 16;
        for (int i = gw; i < nin + NPROJ_ITEMS + 2 * NQKV_ITEMS; i += NGW) {
            if (i < nin) wjob_absmax_item(Jin, i, lane);
            else { WJob J; int item; const int r = i - nin;
                if (r < NPROJ_ITEMS) dec_proj(ap, ws, 0, r, J, item); else if (r < NPROJ_ITEMS + NQKV_ITEMS) dec_qkv(ap, ws, 0, r - NPROJ_ITEMS, J, item); else dec_qkv(ap, ws, 1, r - NPROJ_ITEMS - NQKV_ITEMS, J, item);
                wjob_item(J, item, scr, lane); }
        }
        for (int i = pbx * (NWAVES * 64) + tid; i < M * 16; i += pG * NWAVES * 64) {
            const int m = i >> 4, j = i & 15;
            const float ang = (float)pos[m] * powf(10000.f, -(float)j / 16.f);
            COS[i] = cosf(ang); SIN[i] = sinf(ang);
        }
    }
    if (IN(0)) xcd_barrier(bar);
    if (IN(0) && P_ON(12)) { PHASE_BEGIN;
        WJob Jin{w_in, nullptr, nullptr, (bf16_t*)(ws + WS_WIN), IN_COLS, 1024, WJ_IN, NPROJ / 32, 2, cmx};
        for (int i = gw; i < (NPROJ / 32) * 16; i += NGW) wjob_item(Jin, i, scr, lane);
        norm_rows_i8(gw, NGW, lane, x, mix_norm, XN, SAq);
    }
    SEAM(0);

#pragma unroll 1
    for (int l = 0; l < 2; ++l) {
        const int pb = 1 + 12 * l;
        if (IN(pb + 0) && P_ON(0)) { PHASE_BEGIN;
            pg8::Gemm g{XN, (const bf16_t*)(ws + WS_WIN + l * WIN_STRIDE), D, D, SAq, (const float*)(cmx + l * NPROJ)}; pg8::StaticOrder S; S.init(M, NPROJ, pG, pbx);
            pg8::EpiInProj E{QKV, Zb, MISC, GATE, gate_bias + l * 2048};
            pg8::gemm_phase<pg8::EpiInProj, pg8::StaticOrder, true, I8_INPROJ ? 2 : 0>(F.lds + RING_OFF, g, S, E, pw);
        }
        SEAM(pb + 0);
        if (IN(pb + 1) && P_ON(1)) { PHASE_BEGIN;
            bf16_t* UT = (bf16_t*)(ws + WS_UT); bf16_t* Wg = (bf16_t*)(ws + WS_W); bf16_t* QD = (bf16_t*)(ws + WS_QD); bf16_t* KDT = (bf16_t*)(ws + WS_KDT); bf16_t* ATb = (bf16_t*)(ws + WS_AT); float* CD = (float*)(ws + WS_CD);
            for (int up = F.vcu; up < 512; up += pG) gdn::local_pair(F.lds + RING_OFF, QKV, MISC, conv_w + l * 4 * 1536, a_log + l * 4, dt_bias + l * 4, UT, Wg, QD, KDT, ATb, CD, up, pw);
            if (!(args.flags & 2)) mla_prep_rows(gw, NGW, lane, MISC, rstdq, rstdkv);
        }
        SEAM(pb + 1);
        if (IN(pb + 2) && P_ON(2)) { PHASE_BEGIN;
            bf16_t* UT = (bf16_t*)(ws + WS_UT); bf16_t* Wg = (bf16_t*)(ws + WS_W); bf16_t* QD = (bf16_t*)(ws + WS_QD); bf16_t* KDT = (bf16_t*)(ws + WS_KDT); bf16_t* ATb = (bf16_t*)(ws + WS_AT); float* CD = (float*)(ws + WS_CD);
            if (pw < 4) { __builtin_amdgcn_s_setprio(3);
                for (int u = F.vcu; u < 256; u += pG) gdn::scan_unit(F.lds + RING_OFF, UT, Wg, QD, KDT, ATb, CD, ORAW, u >> 3, u & 7, tid, pw, lane);
                __builtin_amdgcn_s_setprio(0); }
            else scan_converter(ap, ws, l, (pw - 4) * pG + F.vcu, 4 * pG, F.vcu < 256 ? (256 - F.vcu + pG - 1) / pG : 0, scr, lane);
        }
        SEAM(pb + 2);
        if (IN(pb + 3) && P_ON(3)) { PHASE_BEGIN;
            mla_kpe_rows(gw, NGW, lane, MISC, COS, SIN, Kb);
            { pg8::Gemm g{MISC + MC_CQ, (const bf16_t*)(ws + WS_WQB + l * 768 * KiB), MISC_LD, 384}; pg8::StaticOrder S; S.init(M, 768, pG, pbx);
              pg8::EpiQRope E{Qb, rstdq, COS, SIN};
              pg8::gemm_phase<pg8::EpiQRope, pg8::StaticOrder, false>(F.lds + RING_OFF, g, S, E, pw); }
            { pg8::Gemm g{MISC + MC_CKV, (const bf16_t*)(ws + WS_WKVB + l * 512 * KiB), MISC_LD, 256}; pg8::StaticOrder S; S.init(M, 1024, pG, pbx);
              pg8::EpiKV E{Kb, Vb, rstdkv};
              pg8::gemm_phase<pg8::EpiKV, pg8::StaticOrder, false>(F.lds + RING_OFF, g, S, E, pw); }
        }
        SEAM(pb + 3);
        if (IN(pb + 4) && P_ON(4)) { PHASE_BEGIN;
            if (!(args.flags & 1)) {
                for (int u = F.vcu; u < 256; u += pG) {
                    const int bh = u >> 2, sp = u & 3, b = bh >> 3, h = bh & 7;
                    att::attn_unit(F.lds + RING_OFF, Qb, Kb, Vb, AO, b, h, 7 - sp, tid, pw, lane);
                    att::attn_unit(F.lds + RING_OFF, Qb, Kb, Vb, AO, b, h, sp, tid, pw, lane);
                }
            }
            if (!(args.flags & 2)) gdn_gate_rows(gw, NGW, lane, ORAW, Zb, gdn_out_norm + l * 128, GO);
        }
        SEAM(pb + 4);
        if (IN(pb + 5) && P_ON(5)) { PHASE_BEGIN;
            pg8::Gemm g{AO, (const bf16_t*)(ws + WS_WGDNO + l * MiB), 512, 512}; pg8::TwoSegOrder S;
            S.init(M, D, pG, pbx, (size_t)(WS_GO - WS_AO), (size_t)(WS_WMLAO - WS_WGDNO));
            pg8::EpiMerge2 E{MERGED, GATE};
            pg8::gemm_phase<pg8::EpiMerge2, pg8::TwoSegOrder, false>(F.lds + RING_OFF, g, S, E, pw);
        }
        SEAM(pb + 5);
        if (IN(pb + 6) && P_ON(6)) { PHASE_BEGIN;
            pg8::Gemm g{MERGED, (const bf16_t*)(ws + WS_WOUT + l * 2 * MiB), D, D}; pg8::StaticOrder S; S.init(M, D, pG, pbx);
            if (l == 0) { pg8::EpiResidB<true> E{x, XB, 1.f}; pg8::gemm_phase<pg8::EpiResidB<true>, pg8::StaticOrder, false>(F.lds + RING_OFF, g, S, E, pw); }
            else { pg8::EpiResidB<false> E{XB, XB, 1.f}; pg8::gemm_phase<pg8::EpiResidB<false>, pg8::StaticOrder, false>(F.lds + RING_OFF, g, S, E, pw); }
        }
        SEAM(pb + 6);
        if (IN(pb + 7) && P_ON(7)) { PHASE_BEGIN;
            if (l == 0) { if (I8_DUP) norm_rows_bi8(gw, NGW, lane, XB, ffn_norm, XN, SAq); else if (DENSE_UP_FP8) norm_rows_b8(gw, NGW, lane, XB, ffn_norm, XN); else norm_rows_b(gw, NGW, lane, XB, ffn_norm, XN); }
            else {
                __syncthreads();
                LAS unsigned* rbc = (LAS unsigned*)(F.lds + 131072);
                LAS int* rinfo = (LAS int*)(F.lds + 131072 + 64);
                if (tid < 16) rbc[tid] = 0u;
                __syncthreads();
                int nrow = 0;
                f32x4 gn[4]; { const GAS f32x4* gr = (const GAS f32x4*)(ffn_norm + D) + lane;
#pragma unroll
                    for (int j = 0; j < 4; ++j) gn[j] = gr[64 * j]; }
                u32x2 wc[4], wn[4];
#pragma unroll
                for (int j = 0; j < 4; ++j) { wc[j] = (u32x2){0u, 0u}; wn[j] = wc[j]; }
                if (gw < M) row_issue_b(XB + (size_t)gw * D, lane, wn);
                f32x4 rw[16][2];
#pragma unroll
                for (int j = 0; j < 4; ++j)
#pragma unroll
                    for (int i = 0; i < 4; ++i) { const float* rp = router_w + (size_t)(4 * (lane + 64 * j) + i) * NE; rw[4 * j + i][0] = *(const f32x4*)rp; rw[4 * j + i][1] = *(const f32x4*)(rp + 4); }
                for (int m = gw; m < M; m += NGW) {
#pragma unroll
                    for (int j = 0; j < 4; ++j) wc[j] = wn[j];
                    asm volatile("" : "+v"(wc[0]), "+v"(wc[1]), "+v"(wc[2]), "+v"(wc[3]));
                    if (m + NGW < M) row_issue_b(XB + (size_t)(m + NGW) * D, lane, wn);
                    f32x4 v[4]; row_norm_b(wc, gn, v);
                    { GAS unsigned* o8 = (GAS unsigned*)((unsigned char*)XN + (size_t)m * D) + lane;
#pragma unroll
                      for (int j = 0; j < 4; ++j) { const float c0 = __builtin_amdgcn_fmed3f(v[j].x, -448.f, 448.f), c1 = __builtin_amdgcn_fmed3f(v[j].y, -448.f, 448.f), c2 = __builtin_amdgcn_fmed3f(v[j].z, -448.f, 448.f), c3 = __builtin_amdgcn_fmed3f(v[j].w, -448.f, 448.f);
                        unsigned w = __builtin_amdgcn_cvt_pk_fp8_f32(c0, c1, 0, false); w = __builtin_amdgcn_cvt_pk_fp8_f32(c2, c3, w, true); o8[64 * j] = w; } }
                    float lg[NE];
#pragma unroll
                    for (int e = 0; e < NE; ++e) lg[e] = 0.f;
#pragma unroll
                    for (int j = 0; j < 4; ++j) {
                        const int c = 4 * (lane + 64 * j);
#pragma unroll
                        for (int i = 0; i < 4; ++i) {
                            const f32x4 r0 = rw[4 * j + i][0], r1 = rw[4 * j + i][1];
                            const float xv = v[j][i];
                            lg[0] += xv * r0.x; lg[1] += xv * r0.y; lg[2] += xv * r0.z; lg[3] += xv * r0.w;
                            lg[4] += xv * r1.x; lg[5] += xv * r1.y; lg[6] += xv * r1.z; lg[7] += xv * r1.w;
                        }
                    }
#pragma unroll
                    for (int e = 0; e < NE; ++e) lg[e] = wave_sum(lg[e]);
                    if (lane == 0) {
                        int i0 = 0; float b0 = lg[0];
#pragma unroll
                        for (int e = 1; e < NE; ++e) if (lg[e] > b0) { b0 = lg[e]; i0 = e; }
                        int i1 = 0; float b1 = -3.4e38f;
#pragma unroll
                        for (int e = 0; e < NE; ++e) if (e != i0 && lg[e] > b1) { b1 = lg[e]; i1 = e; }
                        const float e1 = __expf(b1 - b0); const float w0 = 1.f / (1.f + e1), w1 = e1 / (1.f + e1);
                        topw[2 * m] = w0; topw[2 * m + 1] = w1;
                        const unsigned q0 = __hip_atomic_fetch_add((LAS unsigned*)(rbc + i0), 1u, __ATOMIC_RELAXED, __HIP_MEMORY_SCOPE_WORKGROUP);
                        const unsigned q1 = __hip_atomic_fetch_add((LAS unsigned*)(rbc + i1), 1u, __ATOMIC_RELAXED, __HIP_MEMORY_SCOPE_WORKGROUP);
                        if (nrow < 16) { rinfo[(pw * 16 + nrow) * 2] = (i0 << 20) | (int)q0; rinfo[(pw * 16 + nrow) * 2 + 1] = (i1 << 20) | (int)q1; }
                    }
                    ++nrow;
                }
                __syncthreads();
                if (tid < NE) rbc[8 + tid] = atomicAdd(&cnt[tid], rbc[tid]);
                __syncthreads();
                { int k = 0;
                  for (int m = gw; m < M; m += NGW, ++k) if (lane == 0 && k < 16) {
#pragma unroll
                    for (int s2 = 0; s2 < 2; ++s2) { const int q = rinfo[(pw * 16 + k) * 2 + s2]; const int e = q >> 20; const int p = (int)rbc[8 + e] + (q & 0xfffff);
                        list[e * M + p] = 2 * m + s2; pairrow[2 * m + s2] = (e << 20) | p; }
                  } }
            }
        }
        SEAM(pb + 7);
        if (IN(pb + 9) && P_ON(9)) { PHASE_BEGIN;
            if (l == 0) {
                pg8::Gemm g{XN, (const bf16_t*)(ws + WS_WD13), D, D, SAq, (const float*)(cmx + 2 * NPROJ)}; pg8::StaticOrder S; S.init(M, 2 * D_FF, pG, pbx);
                pg8::EpiSwiGLU E{HB, D_FF, (!I8_DUP && DENSE_UP_FP8) ? 1.f / W8_SCALE : 1.f, DENSE_DN_FP8 ? H8_SCALE : 0.f};
                pg8::gemm_phase<pg8::EpiSwiGLU, pg8::StaticOrder, true, I8_DUP ? 2 : (DENSE_UP_FP8 ? 1 : 0)>(F.lds + RING_OFF, g, S, E, pw);
            } else {
                pg8::Gemm g{XN, (const bf16_t*)ap->out, D, D}; pg8::MoeGatherOrder S; S.init(cnt, list, 2 * DFE, pG, F.vcu, 7 * MiB / 2, D);
                pg8::EpiSwiGLU E{Hm, DFE, 1.f / W8_SCALE, H8_SCALE};
                pg8::gemm_phase<pg8::EpiSwiGLU, pg8::MoeGatherOrder, true, true>(F.lds + RING_OFF, g, S, E, pw);
            }
        }
        SEAM(pb + 9);
        if (IN(pb + 10) && P_ON(10)) { PHASE_BEGIN;
            if (l == 0) {
                pg8::Gemm g{HB, (const bf16_t*)(ws + WS_WD2), D_FF, D_FF}; pg8::StaticOrder S; S.init(M, D, pG, pbx);
                pg8::EpiResidB<false> E{XB, XB, DENSE_DN_FP8 ? 1.f / (W8_SCALE * H8_SCALE) : 1.f};
                pg8::gemm_phase<pg8::EpiResidB<false>, pg8::StaticOrder, false, DENSE_DN_FP8 != 0>(F.lds + RING_OFF, g, S, E, pw);
            } else {
                pg8::Gemm g{Hm, (const bf16_t*)(ws + WS_WM2), DFE, DFE}; pg8::MoeOrder S; S.init(cnt, D, pG, F.vcu, 7 * MiB / 4);
                pg8::EpiStore E{Yb, D, 1.f / (W8_SCALE * H8_SCALE)};
                pg8::gemm_phase<pg8::EpiStore, pg8::MoeOrder, true, true>(F.lds + RING_OFF, g, S, E, pw);
            }
        }
        SEAM(pb + 10);
        if (IN(pb + 11) && P_ON(11)) { PHASE_BEGIN;
            if (l == 0) { if (I8_INPROJ) norm_rows_bi8(gw, NGW, lane, XB, mix_norm + D, XN, SAq); else norm_rows_b(gw, NGW, lane, XB, mix_norm + D, XN); }
            else {
                int oo[NE]; { int a = 0; int cn8[8]; pg8::load_counts8(cnt, cn8);
#pragma unroll
                    for (int e = 0; e < NE; ++e) { oo[e] = a; a += (cn8[e] + 255) & ~255; } }
                const int nrow = (M - gw + NGW - 1) / NGW;
                int mq0 = 0, mq1 = 0; float mw0 = 0.f, mw1 = 0.f;
                if (lane < nrow) { const int mk = gw + lane * NGW; mq0 = pairrow[2 * mk]; mq1 = pairrow[2 * mk + 1]; mw0 = topw[2 * mk]; mw1 = topw[2 * mk + 1]; }
                f32x4 gfin[4]; { const GAS f32x4* gr = (const GAS f32x4*)final_norm + lane;
#pragma unroll
                    for (int j = 0; j < 4; ++j) gfin[j] = gr[64 * j]; }
#define FIN_ISSUE(k, YA, YB, XW) do { const int m_ = gw + (k) * NGW; const int q0_ = __builtin_amdgcn_readlane(mq0, (k)), q1_ = __builtin_amdgcn_readlane(mq1, (k)); int r0_ = q0_ & 0xfffff, r1_ = q1_ & 0xfffff; \
                    _Pragma("unroll") for (int e = 0; e < NE; ++e) { if ((q0_ >> 20) == e) r0_ += oo[e]; if ((q1_ >> 20) == e) r1_ += oo[e]; } \
                    const GAS u32x2* xb_ = (const GAS u32x2*)(XB + (size_t)m_ * D) + lane; const GAS u32x2* y0_ = (const GAS u32x2*)(Yb + (size_t)r0_ * D) + lane; const GAS u32x2* y1_ = (const GAS u32x2*)(Yb + (size_t)r1_ * D) + lane; \
                    _Pragma("unroll") for (int j = 0; j < 4; ++j) { YA[j] = y0_[64 * j]; YB[j] = y1_[64 * j]; XW[j] = xb_[64 * j]; } } while (0)
#define FIN_DO(k, YA, YB, XW) do { const int m_ = gw + (k) * NGW; const float w0 = __builtin_bit_cast(float, __builtin_amdgcn_readlane(__builtin_bit_cast(int, mw0), (k))), w1 = __builtin_bit_cast(float, __builtin_amdgcn_readlane(__builtin_bit_cast(int, mw1), (k))); \
                    GAS f32x4* xr = (GAS f32x4*)(X + (size_t)m_ * D) + lane;                 \
                    f32x4 v[4]; float ss = 0.f; \
                    _Pragma("unroll") for (int j = 0; j < 4; ++j) { const u32x2 a = YA[j], b = YB[j], xw = XW[j]; f32x4 t = (f32x4){bflo(xw.x), bfhi(xw.x), bflo(xw.y), bfhi(xw.y)}; \
                        t.x += w0 * bflo(a.x) + w1 * bflo(b.x); t.y += w0 * bfhi(a.x) + w1 * bfhi(b.x); t.z += w0 * bflo(a.y) + w1 * bflo(b.y); t.w += w0 * bfhi(a.y) + w1 * bfhi(b.y); \
                        v[j] = t; ss += (t.x * t.x + t.y * t.y) + (t.z * t.z + t.w * t.w); } \
                    ss = wave_sum(ss); const float rstd = rsqrtf(ss * (1.f / D) + EPS); \
                    _Pragma("unroll") for (int j = 0; j < 4; ++j) xr[64 * j] = v[j] * gfin[j] * rstd; } while (0)
                u32x2 yan[4], ybn[4], xwn[4];
#pragma unroll
                for (int j = 0; j < 4; ++j) { yan[j] = (u32x2){0u, 0u}; ybn[j] = yan[j]; xwn[j] = yan[j]; }
                if (nrow > 0) FIN_ISSUE(0, yan, ybn, xwn);
#pragma unroll 1
                for (int k = 0; k < nrow; ++k) {
                    u32x2 yac[4], ybc[4], xwc[4];
#pragma unroll
                    for (int j = 0; j < 4; ++j) { yac[j] = yan[j]; ybc[j] = ybn[j]; xwc[j] = xwn[j]; }
                    asm volatile("" : "+v"(yac[0]), "+v"(yac[1]), "+v"(yac[2]), "+v"(yac[3]), "+v"(ybc[0]), "+v"(ybc[1]), "+v"(ybc[2]), "+v"(ybc[3]), "+v"(xwc[0]), "+v"(xwc[1]), "+v"(xwc[2]), "+v"(xwc[3]));
                    if (k + 1 < nrow) FIN_ISSUE(k + 1, yan, ybn, xwn);
                    FIN_DO(k, yac, ybc, xwc);
                }
#undef FIN_ISSUE
#undef FIN_DO
            }
        }
        SEAM(pb + 11);
    }
#undef IN
#undef SEAM
}
#ifndef MEGA_MASK
#define MEGA_MASK 0xFFF
#endif
#ifndef ONE_LAUNCH
#define ONE_LAUNCH 0
#endif
static void launch_mega(hipStream_t st, Args a, int lo, int hi, int grid) {
    a.ph_lo = lo; a.ph_hi = hi;
    hipLaunchKernelGGL(mega_fwd, dim3(grid), dim3(NWAVES * 64), LDS_BYTES, st, a);
}

extern "C" void kernel_launch(void* const* d_in, const int* in_sizes, int n_in, void* d_out, int out_size, void* d_ws, size_t ws_size, hipStream_t stream) {
    static int grid = 0;
    if (grid == 0) {
        int dev = 0, cus = 0, per_cu = 0;
        if (n_in != 25 || out_size != M * D || ws_size < WS_END) { grid = -1; return; }
        if (hipGetDevice(&dev) != hipSuccess || hipDeviceGetAttribute(&cus, hipDeviceAttributeMultiprocessorCount, dev) != hipSuccess) { grid = -1; return; }
        if (hipFuncSetAttribute((const void*)mega_fwd, hipFuncAttributeMaxDynamicSharedMemorySize, LDS_BYTES) != hipSuccess) { grid = -1; return; }
        if (hipOccupancyMaxActiveBlocksPerMultiprocessor(&per_cu, (const void*)mega_fwd, NWAVES * 64, LDS_BYTES) != hipSuccess || per_cu < 1) { (void)hipGetLastError(); }
        (void)hipGetLastError();
        grid = cus;
    }
    if (grid < 0) return;
    (void)hipMemsetAsync((char*)d_ws + WS_CTL, 0, CTL_ZERO_BYTES, stream);
    Args a{};
    for (int i = 0; i < 25; ++i) a.in[i] = (const float*)d_in[i];
    a.out = (float*)d_out; a.ws = (unsigned char*)d_ws; a.flags = 0; a.pad = 0;
#if ONE_LAUNCH
    launch_mega(stream, a, 0, 25, grid);
#else
    const float* x = (const float*)d_in[0]; const int* pos = (const int*)d_in[1];
    const float* mix_norm = (const float*)d_in[2]; const float* w_in = (const float*)d_in[3]; const float* gate_bias = (const float*)d_in[4];
    const float* conv_w = (const float*)d_in[5]; const float* a_log = (const float*)d_in[6]; const float* dt_bias = (const float*)d_in[7];
    const float* gdn_out_norm = (const float*)d_in[8]; const float* w_gdn_o = (const float*)d_in[9]; const float* q_a_norm = (const float*)d_in[10];
    const float* w_q_b = (const float*)d_in[11]; const float* kv_a_norm = (const float*)d_in[12]; const float* w_kv_b = (const float*)d_in[13];
    const float* w_mla_o = (const float*)d_in[14]; const float* w_out = (const float*)d_in[15]; const float* ffn_norm = (const float*)d_in[16];
    const float* dense_w1 = (const float*)d_in[17]; const float* dense_w3 = (const float*)d_in[18]; const float* dense_w2 = (const float*)d_in[19];
    const float* router_w = (const float*)d_in[20]; const float* moe_w1 = (const float*)d_in[21]; const float* moe_w3 = (const float*)d_in[22];
    const float* moe_w2 = (const float*)d_in[23]; const float* final_norm = (const float*)d_in[24];
    float* X = (float*)d_out;
    unsigned char* ws = (unsigned char*)d_ws;
    unsigned* ctl = (unsigned*)(ws + WS_CTL);
    bf16_t* GATE = (bf16_t*)(ws + WS_GATE); bf16_t* Zb = (bf16_t*)(ws + WS_Z); bf16_t* MISC = (bf16_t*)(ws + WS_MISC); bf16_t* QKV = (bf16_t*)(ws + WS_QKV);
    bf16_t* Qb = (bf16_t*)(ws + WS_Q); bf16_t* Kb = (bf16_t*)(ws + WS_K); bf16_t* Vb = (bf16_t*)(ws + WS_V); bf16_t* AO = (bf16_t*)(ws + WS_AO); bf16_t* GO = (bf16_t*)(ws + WS_GO);
    bf16_t* XN = (bf16_t*)(ws + WS_XN); bf16_t* MERGED = (bf16_t*)(ws + WS_MERGED);
    bf16_t* HB = (bf16_t*)(ws + WS_HB); bf16_t* XG = (bf16_t*)(ws + WS_XG); bf16_t* Hm = (bf16_t*)(ws + WS_H); bf16_t* Yb = (bf16_t*)(ws + WS_Y);
    bf16_t* QN = (bf16_t*)(ws + WS_QN); bf16_t* KN = (bf16_t*)(ws + WS_KN); bf16_t* VN = (bf16_t*)(ws + WS_VN); bf16_t* QRAW = (bf16_t*)(ws + WS_QRAW);
    float* ORAW = (float*)(ws + WS_ORAW);
    float* rstdq = (float*)(ws + WS_RSTD); float* rstdkv = rstdq + M;
    float* gbuf = (float*)(ws + WS_GB); float* bbuf = gbuf + M * 4;
    int* topi = (int*)(ws + WS_MOE); float* topw = (float*)(topi + 2 * M); int* pairrow = (int*)(topw + 2 * M); int* list = pairrow + 2 * M; int* offs = list + NE * M;
    unsigned* cnt = ctl + CW_CNT;
    const int mask = MEGA_MASK;
#define USE_MEGA(s) ((mask >> (s)) & 1)
    launch_mega(stream, a, 0, 1, grid);
    for (int l = 0; l < 2; ++l) {
        const int pb = 1 + 12 * l;
        const float* xin = (l == 0) ? x : X;
        const float* wi = w_in + (size_t)l * D * IN_COLS;
        if (USE_MEGA(0)) launch_mega(stream, a, pb + 0, pb + 1, grid);
        else {
            EpiArgs e0{}; e0.mode = 0;
            e0.ob = QKV; e0.ldo = QKV_LD; e0.col0 = 0;      gemm(stream, false, XN, D, wi, nullptr, IN_COLS, WC_Q, M, 1536, D, e0);
            e0.ob = Zb; e0.ldo = Z_LD; e0.col0 = 0;         gemm(stream, false, XN, D, wi, nullptr, IN_COLS, WC_Z, M, 512, D, e0);
            e0.ob = MISC; e0.ldo = MISC_LD; e0.col0 = MC_A; gemm(stream, false, XN, D, wi, nullptr, IN_COLS, WC_A, M, 8, D, e0);
            e0.col0 = MC_CQ;  gemm(stream, false, XN, D, wi, nullptr, IN_COLS, WC_CQ, M, 384, D, e0);
            e0.col0 = MC_CKV; gemm(stream, false, XN, D, wi, nullptr, IN_COLS, WC_CKV, M, 256, D, e0);
            e0.col0 = MC_KR;  gemm(stream, false, XN, D, wi, nullptr, IN_COLS, WC_KR, M, 32, D, e0);
            EpiArgs e1{}; e1.mode = 1; e1.ob = GATE; e1.ldo = GATE_LD; e1.col0 = 0; e1.bias = gate_bias + l * 2048;
            gemm(stream, false, XN, D, wi, nullptr, IN_COLS, WC_GATE, M, 2048, D, e1);
        }
        if (USE_MEGA(1)) { launch_mega(stream, a, pb + 1, pb + 2, grid); launch_mega(stream, a, pb + 2, pb + 3, grid); }
        else {
            hipLaunchKernelGGL(k_gdn_prep, dim3(M), dim3(256), 0, stream, (const bf16_t*)QKV, (const bf16_t*)MISC, conv_w + l * 4 * 1536, a_log + l * 4, dt_bias + l * 4, QN, KN, VN, gbuf, bbuf);
            hipLaunchKernelGGL(k_gdn_rec, dim3(32, 16), dim3(1024), 0, stream, (const bf16_t*)QN, (const bf16_t*)KN, (const bf16_t*)VN, (const float*)gbuf, (const float*)bbuf, ORAW);
            hipLaunchKernelGGL(k_mla_prep, dim3(M / 4), dim3(256), 0, stream, (const bf16_t*)MISC, pos, rstdq, rstdkv, Kb);
        }
        if (USE_MEGA(3)) launch_mega(stream, a, pb + 3, pb + 4, grid);
        else {
            EpiArgs eq{}; eq.mode = 0; eq.ob = QRAW; eq.ldo = 768; eq.col0 = 0; eq.kgain = q_a_norm + l * 384; eq.rowscale = rstdq;
            gemm(stream, false, MISC + MC_CQ, MISC_LD, w_q_b + (size_t)l * 384 * 768, nullptr, 768, 0, M, 768, 384, eq);
            hipLaunchKernelGGL(k_q_rope, dim3(M * 768 / 256), dim3(256), 0, stream, (const bf16_t*)QRAW, pos, Qb);
            EpiArgs ekv{}; ekv.mode = 6; ekv.ob = Kb; ekv.ob2 = Vb; ekv.kgain = kv_a_norm + l * 256; ekv.rowscale = rstdkv;
            gemm(stream, false, MISC + MC_CKV, MISC_LD, w_kv_b + (size_t)l * 256 * 1024, nullptr, 1024, 0, M, 1024, 256, ekv);
        }
        if (USE_MEGA(4)) launch_mega(stream, a, pb + 4, pb + 5, grid);
        else {
            hipLaunchKernelGGL(k_attn, dim3(M * 8 / 4), dim3(256), 0, stream, (const bf16_t*)Qb, (const bf16_t*)Kb, (const bf16_t*)Vb, AO);
            hipLaunchKernelGGL(k_gdn_gate, dim3(M / 4), dim3(256), 0, stream, (const float*)ORAW, (const bf16_t*)Zb, gdn_out_norm + l * 128, GO);
        }
        if (USE_MEGA(5)) launch_mega(stream, a, pb + 5, pb + 6, grid);
        else {
            EpiArgs em{}; em.mode = 2; em.ob = MERGED; em.ldo = D; em.gate = GATE; em.ldg = GATE_LD; em.gcol0 = 0;
            gemm(stream, false, GO, 512, w_gdn_o + (size_t)l * 512 * D, nullptr, D, 0, M, D, 512, em);
            em.mode = 3; em.gcol0 = D;
            gemm(stream, false, AO, 512, w_mla_o + (size_t)l * 512 * D, nullptr, D, 0, M, D, 512, em);
        }
        if (USE_MEGA(6)) launch_mega(stream, a, pb + 6, pb + 7, grid);
        else { EpiArgs eo{}; eo.mode = 4; eo.res = xin; eo.of = X; gemm(stream, false, MERGED, D, w_out + (size_t)l * D * D, nullptr, D, 0, M, D, D, eo); }
        if (USE_MEGA(7)) launch_mega(stream, a, pb + 7, pb + 8, grid);
        else hipLaunchKernelGGL(k_rmsnorm, dim3(M / 4), dim3(256), 0, stream, (const float*)X, ffn_norm + l * D, XN, (float*)nullptr, l, router_w, topi, topw, cnt, list);
        if (l == 1) {
            if (USE_MEGA(8)) launch_mega(stream, a, pb + 8, pb + 9, grid);
            else {
                hipLaunchKernelGGL(k_moe_offsets, dim3(1), dim3(64), 0, stream, (const unsigned*)cnt, offs);
                hipLaunchKernelGGL(k_moe_gather, dim3(MOE_ROWS / 4), dim3(256), 0, stream, (const bf16_t*)XN, (const unsigned*)cnt, (const int*)offs, (const int*)list, XG, pairrow);
            }
        }
        if (USE_MEGA(9)) launch_mega(stream, a, pb + 9, pb + 10, grid);
        else if (l == 0) { EpiArgs eu{}; eu.mode = 5; eu.ob = HB; eu.ldo = D_FF; gemm(stream, true, XN, D, dense_w1, dense_w3, D_FF, 0, M, D_FF, D, eu); }
        else { EpiArgs eu{}; eu.mode = 5; eu.ob = Hm; eu.ldo = DFE; gemm(stream, true, XG, D, moe_w1, moe_w3, DFE, 0, MOE_ROWS, DFE, D, eu, offs, (size_t)D * DFE); }
        if (USE_MEGA(10)) launch_mega(stream, a, pb + 10, pb + 11, grid);
        else if (l == 0) { EpiArgs ed{}; ed.mode = 4; ed.res = X; ed.of = X; gemm(stream, false, HB, D_FF, dense_w2, nullptr, D, 0, M, D, D_FF, ed); }
        else { EpiArgs ed{}; ed.mode = 0; ed.ob = Yb; ed.ldo = D; ed.col0 = 0; gemm(stream, false, Hm, DFE, moe_w2, nullptr, D, 0, MOE_ROWS, D, DFE, ed, offs, (size_t)DFE * D); }
        if (USE_MEGA(11)) launch_mega(stream, a, pb + 11, pb + 12, grid);
        else if (l == 0) hipLaunchKernelGGL(k_rmsnorm, dim3(M / 4), dim3(256), 0, stream, (const float*)X, mix_norm + D, XN, (float*)nullptr, 0, (const float*)nullptr, (int*)nullptr, (float*)nullptr, (unsigned*)nullptr, (int*)nullptr);
        else {
            hipLaunchKernelGGL(k_moe_combine, dim3(M / 4), dim3(256), 0, stream, X, (const bf16_t*)Yb, (const int*)pairrow, (const float*)topw);
            hipLaunchKernelGGL(k_rmsnorm, dim3(M / 4), dim3(256), 0, stream, (const float*)X, final_norm, (bf16_t*)nullptr, X, 2, (const float*)nullptr, (int*)nullptr, (float*)nullptr, (unsigned*)nullptr, (int*)nullptr);
        }
    }
#undef USE_MEGA
#endif
}
```

```cpp
#define MEGA_MASK 0xFFF
#define ONE_LAUNCH 1
#include <hip/hip_runtime.h>
#include <stdint.h>

typedef unsigned short bf16_t;
#define DI __device__ __forceinline__
#define GAS __attribute__((address_space(1)))
#define LAS __attribute__((address_space(3)))
typedef short bf16x8 __attribute__((ext_vector_type(8)));
typedef short s16x4 __attribute__((ext_vector_type(4)));
typedef float f32x2 __attribute__((ext_vector_type(2)));
typedef float f32x4 __attribute__((ext_vector_type(4)));
typedef float f32x16 __attribute__((ext_vector_type(16)));
typedef unsigned u32x2 __attribute__((ext_vector_type(2)));
typedef unsigned u32x4 __attribute__((ext_vector_type(4)));
typedef GAS unsigned gu32;
#define RLX_AGENT __ATOMIC_RELAXED, __HIP_MEMORY_SCOPE_AGENT
#define LDS_WAIT() asm volatile("s_waitcnt lgkmcnt(0)" ::: "memory")
#define VM_WAIT() asm volatile("s_waitcnt vmcnt(0)" ::: "memory")

DI float bf2f(bf16_t v) { return __uint_as_float(((unsigned)v) << 16); }
DI unsigned f2bf(float f) { unsigned u = __float_as_uint(f); return (u + 0x7fffu + ((u >> 16) & 1u)) >> 16; }
DI unsigned pk2(float lo, float hi) { return f2bf(lo) | (f2bf(hi) << 16); }
DI float bflo(unsigned w) { return __uint_as_float(w << 16); }
DI float bfhi(unsigned w) { return __uint_as_float(w & 0xffff0000u); }
DI float siluf(float x) { return x * __builtin_amdgcn_rcpf(1.f + __expf(-x)); }
DI float sigmf(float x) { return __builtin_amdgcn_rcpf(1.f + __expf(-x)); }
DI void lds_barrier() { asm volatile("s_waitcnt lgkmcnt(0)" ::: "memory"); __builtin_amdgcn_s_barrier(); asm volatile("" ::: "memory"); }
DI int lane_id_asm() { int l; asm volatile("v_mbcnt_lo_u32_b32 %0, -1, 0\n\tv_mbcnt_hi_u32_b32 %0, -1, %0" : "=v"(l)); return l; }
template <int K> DI float swz_xor(float v) { return __int_as_float(__builtin_amdgcn_ds_swizzle(__float_as_int(v), (K << 10) | 0x1F)); }
DI float xor32_sum(float v) { const auto rr = __builtin_amdgcn_permlane32_swap(__float_as_uint(v), __float_as_uint(v), false, false); return __uint_as_float(rr[0]) + __uint_as_float(rr[1]); }
DI float wave_sum(float v) {
    v += swz_xor<1>(v); v += swz_xor<2>(v); v += swz_xor<4>(v); v += swz_xor<8>(v); v += swz_xor<16>(v);
    return xor32_sum(v);
}

constexpr int M = 16384, D = 1024, SEQ = 2048, NBATCH = 8;
constexpr int IN_COLS = 4776;
constexpr int NPROJ = 4864;
constexpr int MC_CQ = 0, MC_CKV = 384, MC_KR = 640, MC_A = 672, MC_B = 676, MISC_LD = 768;
constexpr int QKV_LD = 1536, Z_LD = 512, GATE_LD = 2048;
constexpr int WC_Q = 0, WC_Z = 1536, WC_A = 2048, WC_B = 2052, WC_CQ = 2056, WC_CKV = 2440, WC_KR = 2696, WC_GATE = 2728;
constexpr int D_FF = 3584, NE = 8, DFE = 1792;
constexpr int MOE_ROWS = 34816;
constexpr float EPS = 1e-6f;
constexpr float QSCALE = 0.10206207261596575f * 1.4426950408889634f;
constexpr int NCHUNK = 32;

constexpr size_t MiB = 1u << 20, KiB = 1u << 10;
constexpr size_t WS_CTL = 0, CTL_ZERO_BYTES = 256 * KiB;
constexpr size_t WS_WIN = 1 * MiB;
constexpr size_t WIN_STRIDE = (size_t)NPROJ * 1024 * 2;
constexpr size_t WS_WGDNO = 20 * MiB;
constexpr size_t WS_WMLAO = 22 * MiB;
constexpr size_t WS_WOUT = 24 * MiB;
constexpr size_t WS_WQB = 28 * MiB;
constexpr size_t WS_WKVB = 29 * MiB + 512 * KiB;
constexpr size_t WS_WD13 = 31 * MiB;
constexpr size_t WS_WD2 = 45 * MiB;
constexpr size_t WS_WM2 = 1 * MiB;
constexpr size_t WS_GATE = 53 * MiB;
constexpr size_t WS_Z = 117 * MiB;
constexpr size_t WS_MISC = 133 * MiB;
constexpr size_t WS_QKV = 157 * MiB;
constexpr size_t WS_Q = 157 * MiB;
constexpr size_t WS_K = 181 * MiB;
constexpr size_t WS_GDNL = 205 * MiB;
constexpr size_t WS_UT = 205 * MiB, WS_W = 221 * MiB, WS_QD = 237 * MiB, WS_KDT = 253 * MiB, WS_AT = 269 * MiB;
constexpr size_t WS_V = 205 * MiB;
constexpr size_t WS_AO = 221 * MiB;
constexpr size_t WS_GO = 237 * MiB;
constexpr size_t WS_QN = 205 * MiB, WS_KN = 221 * MiB, WS_VN = 237 * MiB, WS_QRAW = 253 * MiB;
constexpr size_t WS_XB = 277 * MiB;
constexpr float W8_SCALE = 32.f, H8_SCALE = 4.f;
#ifndef DENSE_UP_FP8
#define DENSE_UP_FP8 0
#endif
#ifndef DENSE_DN_FP8
#define DENSE_DN_FP8 0
#endif
constexpr float W8S_UNUSED = 32.f;
constexpr size_t OUT_XN = 32 * MiB;
constexpr size_t WS_XN_UNUSED = 277 * MiB;
constexpr size_t WS_ORAW = 277 * MiB;
constexpr size_t WS_MERGED = 277 * MiB;
constexpr size_t WS_HB = 53 * MiB;
constexpr size_t WS_XG = 85 * MiB;
constexpr size_t WS_Y = 85 * MiB;
constexpr size_t WS_H = 153 * MiB;
constexpr size_t WS_MOE = 309 * MiB;
constexpr size_t WS_COS = 311 * MiB, WS_SIN = 312 * MiB;
constexpr size_t WS_RSTD = 313 * MiB;
constexpr size_t WS_CD = 313 * MiB + 256 * KiB;
constexpr size_t WS_GB = 313 * MiB + 512 * KiB;
constexpr size_t WS_END = 314 * MiB;
constexpr int CW_CNT = 64;
constexpr int CW_BAR = 4096;
constexpr int CW_CMAX = 32768;
constexpr size_t WS_SA = 314 * MiB;
#ifndef I8_INPROJ
#define I8_INPROJ 1
#endif
#ifndef I8_DUP
#define I8_DUP 1
#endif
namespace pg8 {
constexpr int BM = 256, BK = 64, HALF = 128, HTB = HALF * BK * 2  , STAGE_BYTES = 8 * HTB, NXCD = 8, WGM = 8;

__host__ __device__ __forceinline__ int lds_byte(int r, int c) { const int st = (r >> 4) * 2 + (c >> 5), rr = r & 15, cc = c & 31, ob = rr * 64 + cc * 2; return st * 1024 + (ob ^ (((ob >> 9) & 1) << 5)); }
__host__ __device__ __forceinline__ void stage_rc(int b, int& R, int& C) { const int st = b / 1024, sb = b % 1024, swz = sb ^ (((sb >> 9) & 1) << 5); R = (st >> 1) * 16 + swz / 64; C = (st & 1) * 32 + (swz % 64) / 2; }
__host__ __device__ __forceinline__ int perm32(int rho) { const int n = rho >> 4, i = rho & 15; return 8 * (i >> 2) + 4 * n + (i & 3); }

struct Unit { int pm, pn; size_t boff; size_t aoff; int kind; };
struct Gemm { const bf16_t* A; const bf16_t* Bt; int lda, K; const float* sA; const float* sB; };

struct StaticOrder {
    static constexpr bool GATHER = false;
    int nM, nN, nwg, G, c;
    __device__ void init(int Mr, int N, int G_, int c_) { nM = Mr / BM; nN = N / BM; nwg = nM * nN; G = G_; c = c_; }
    __device__ bool next(int i, Unit& u) const {
        const long L = (long)i * G + c; if (L >= nwg) return false;
        int wgid = (int)L; { const int q = nwg / NXCD, r = nwg % NXCD, xcd = wgid % NXCD, off = wgid / NXCD; wgid = (xcd < r ? xcd * (q + 1) : r * (q + 1) + (xcd - r) * q) + off; }
        const int nig = WGM * nN, gid = wgid / nig, fm = gid * WGM, gsz = (nM - fm) < WGM ? (nM - fm) : WGM;
        u.pm = fm + ((wgid % nig) % gsz); u.pn = (wgid % nig) / gsz; u.boff = 0; u.aoff = 0; u.kind = 0; return true;
    }
    __device__ __forceinline__ void a_ready(const Unit&) const {}
    __device__ __forceinline__ void done(const Unit&) const {}
};
struct TwoSegOrder {
    static constexpr bool GATHER = false;
    StaticOrder so; size_t aoff1, boff1;
    __device__ void init(int Mr, int N, int G_, int c_, size_t aoff1_, size_t boff1_) { so.init(Mr, N, G_, c_); aoff1 = aoff1_; boff1 = boff1_; }
    __device__ bool next(int i, Unit& u) const {
        if (!so.next(i >> 1, u)) return false;
        const int sgm = i & 1; u.kind = sgm; u.aoff = sgm ? aoff1 : 0; u.boff = sgm ? 0 : boff1; return true;
    }
    __device__ __forceinline__ void a_ready(const Unit&) const {}
    __device__ __forceinline__ void done(const Unit&) const {}
};
DI void load_counts8(const unsigned* cnt, int (&cn)[8]) {
    const int l = lane_id_asm();
    const int v = (int)__hip_atomic_load(cnt + (l & 7), __ATOMIC_RELAXED, __HIP_MEMORY_SCOPE_AGENT);
#pragma unroll
    for (int e = 0; e < 8; ++e) cn[e] = __builtin_amdgcn_readlane(v, e);
}
struct MoeOrder {
    static constexpr bool GATHER = false;
    int nN, G, c, nunits; int o1, o2, o3, o4, o5, o6, o7; size_t estride;
    __device__ void init(const unsigned* cnt, int N, int G_, int c_, size_t estride_) {
        nN = N / BM; G = G_; c = c_; estride = estride_;
        int o[9]; int a = 0; int cn8[8]; load_counts8(cnt, cn8);
#pragma unroll
        for (int e = 0; e < 8; ++e) { o[e] = a; a += (cn8[e] + 255) & ~255; }
        o[8] = a;
        o1 = o[1]; o2 = o[2]; o3 = o[3]; o4 = o[4]; o5 = o[5]; o6 = o[6]; o7 = o[7];
        nunits = (a / BM) * nN;
    }
    __device__ bool next(int i, Unit& u) const {
        const long L = (long)i * G + c; if (L >= nunits) return false;
        const int rt = (int)L / nN, pn = (int)L % nN, r0 = rt * BM;
        const int e = (r0 >= o1) + (r0 >= o2) + (r0 >= o3) + (r0 >= o4) + (r0 >= o5) + (r0 >= o6) + (r0 >= o7);
        u.pm = rt; u.pn = pn; u.boff = (size_t)e * estride; u.aoff = 0; u.kind = e; return true;
    }
    __device__ __forceinline__ void a_ready(const Unit&) const {}
    __device__ __forceinline__ void done(const Unit&) const {}
};

struct MoeGatherOrder {
    static constexpr bool GATHER = true;
    int nN, G, c, nunits; int o[9]; int cn[8]; size_t estride; const int* list; int rowbytes;
    __device__ void init(const unsigned* cnt, const int* list_, int N, int G_, int c_, size_t estride_, int rowbytes_) {
        nN = N / BM; G = G_; c = c_; estride = estride_; list = list_; rowbytes = rowbytes_;
        int a = 0; load_counts8(cnt, cn);
#pragma unroll
        for (int e = 0; e < 8; ++e) { o[e] = a; a += (cn[e] + 255) & ~255; }
        o[8] = a; nunits = (a / BM) * nN;
    }
    __device__ bool next(int i, Unit& u) const {
        const long L = (long)i * G + c; if (L >= nunits) return false;
        const int rt = (int)L / nN, pn = (int)L % nN, r0 = rt * BM;
        int e = 0;
#pragma unroll
        for (int k = 1; k < 8; ++k) e += (r0 >= o[k]);
        u.pm = rt; u.pn = pn; u.boff = (size_t)e * estride; u.aoff = 0; u.kind = e; return true;
    }
    __device__ __forceinline__ unsigned row_off(const Unit& u, int R) const {
        int oe = 0, ce = 0;
#pragma unroll
        for (int k = 0; k < 8; ++k) if (u.kind == k) { oe = o[k]; ce = cn[k]; }
        const int p = u.pm * BM + R - oe;
        const int tok = (p < ce) ? (list[(size_t)u.kind * 16384 + p] >> 1) : 0;
        return (unsigned)tok * (unsigned)rowbytes;
    }
    __device__ __forceinline__ void a_ready(const Unit&) const {}
    __device__ __forceinline__ void done(const Unit&) const {}
};

DI unsigned cvt_pk_bf16(float lo, float hi) { unsigned r; asm volatile("v_cvt_pk_bf16_f32 %0, %1, %2" : "=v"(r) : "v"(lo), "v"(hi)); return r; }
DI u32x4 pack8(const f32x4 v0, const f32x4 v1) { u32x4 w; w.x = cvt_pk_bf16(v0[0], v0[1]); w.y = cvt_pk_bf16(v0[2], v0[3]); w.z = cvt_pk_bf16(v1[0], v1[1]); w.w = cvt_pk_bf16(v1[2], v1[3]); return w; }
DI f32x4 sig4(f32x4 v) { f32x4 r; r[0] = sigmf(v[0]); r[1] = sigmf(v[1]); r[2] = sigmf(v[2]); r[3] = sigmf(v[3]); return r; }
DI f32x4 silu4(f32x4 v) { f32x4 r; r[0] = siluf(v[0]); r[1] = siluf(v[1]); r[2] = siluf(v[2]); r[3] = siluf(v[3]); return r; }

typedef const f32x4 (&AccRef)[2][2][4][2];
typedef int i32x4_t __attribute__((ext_vector_type(4)));

struct EpiInProj {
    static constexpr bool AFTER_DRAIN = false; static constexpr bool TWOSEG = false; static constexpr bool PERM = true;
    bf16_t *QKV, *Z, *MISC, *GATE; const float* bias;
    DI void operator()(AccRef acc, const Unit& u, int wr, int wc, int fr, int fq) const {
        const int pn = u.pn; const int row0 = u.pm * BM + wr * 64 + fr;
        if (pn >= 11) {
            const int j = pn - 11, c0 = j * HALF + wc * 32 + 8 * fq;
            f32x4 ba[2], bb[2];
#pragma unroll
            for (int n = 0; n < 2; ++n) { ba[n] = *(const f32x4*)(bias + c0 + 4 * n); bb[n] = *(const f32x4*)(bias + 1024 + c0 + 4 * n); }
#pragma unroll
            for (int ai = 0; ai < 2; ++ai)
#pragma unroll
                for (int m = 0; m < 4; ++m) { bf16_t* rowp = GATE + (size_t)(row0 + ai * HALF + m * 16) * GATE_LD + c0;
                    f32x4 ga0 = sig4(acc[ai][0][m][0] + ba[0]), ga1 = sig4(acc[ai][0][m][1] + ba[1]);
                    f32x4 gb0 = sig4(acc[ai][1][m][0] + bb[0]), gb1 = sig4(acc[ai][1][m][1] + bb[1]);
                    const u32x4 wa = pack8(ga0, ga1);
                    f32x4 ra0, ra1; ra0[0] = bflo(wa.x); ra0[1] = bfhi(wa.x); ra0[2] = bflo(wa.y); ra0[3] = bfhi(wa.y); ra1[0] = bflo(wa.z); ra1[1] = bfhi(wa.z); ra1[2] = bflo(wa.w); ra1[3] = bfhi(wa.w);
#pragma unroll
                    for (int i = 0; i < 4; ++i) { gb0[i] *= __builtin_amdgcn_rcpf(ra0[i]); gb1[i] *= __builtin_amdgcn_rcpf(ra1[i]); }
                    __builtin_nontemporal_store(wa, (u32x4*)rowp); __builtin_nontemporal_store(pack8(gb0, gb1), (u32x4*)(rowp + 1024));
                    asm volatile("" ::: "memory"); }
            return;
        }
        bf16_t* base; int ld, colt;
        if (pn < 6) { base = QKV; ld = QKV_LD; colt = pn * 256; }
        else if (pn < 8) { base = Z; ld = Z_LD; colt = (pn - 6) * 256; }
        else { base = MISC; ld = MISC_LD; colt = (pn - 8) * 256; }
        const int col0 = colt + wc * 32 + 8 * fq;
#pragma unroll
        for (int ai = 0; ai < 2; ++ai)
#pragma unroll
            for (int m = 0; m < 4; ++m) { bf16_t* rowp = base + (size_t)(row0 + ai * HALF + m * 16) * ld + col0;
#pragma unroll
                for (int bj = 0; bj < 2; ++bj) { const u32x4 w = pack8(acc[ai][bj][m][0], acc[ai][bj][m][1]);
                    if (pn == 6 || pn == 7) __builtin_nontemporal_store(w, (u32x4*)(rowp + bj * HALF)); else *(u32x4*)(rowp + bj * HALF) = w; }
                asm volatile("" ::: "memory"); }
    }
};
struct EpiQRope {
    static constexpr bool AFTER_DRAIN = false; static constexpr bool TWOSEG = false; static constexpr bool PERM = false;
    bf16_t* Q; const float* rstd; const float* COS; const float* SIN;
    DI void operator()(AccRef acc, const Unit& u, int wr, int wc, int fr, int fq) const {
        const int row0 = u.pm * BM + wr * 64 + fr;
#pragma unroll
        for (int ai = 0; ai < 2; ++ai) {
            float scv[4]; f32x4 csv[4], snv[4];
#pragma unroll
            for (int m = 0; m < 4; ++m) { const int row = row0 + ai * HALF + m * 16; scv[m] = rstd[row]; csv[m] = *(const f32x4*)(COS + (size_t)row * 16 + 4 * fq); snv[m] = *(const f32x4*)(SIN + (size_t)row * 16 + 4 * fq); }
#pragma unroll
            for (int m = 0; m < 4; ++m) {
                const int row = row0 + ai * HALF + m * 16;
                const float sc = scv[m] * QSCALE;
                const f32x4 cs = csv[m], sn = snv[m];
#pragma unroll
                for (int bj = 0; bj < 2; ++bj) {
                    const int gi = 8 * u.pn + 4 * bj + wc;
                    f32x4 v0 = acc[ai][bj][m][0] * sc, v1 = acc[ai][bj][m][1] * sc;
                    if (gi % 3 == 2) { const f32x4 o0 = v0 * cs - v1 * sn, o1 = v1 * cs + v0 * sn; v0 = o0; v1 = o1; }
                    bf16_t* p = Q + (size_t)row * 768 + gi * 32 + 4 * fq;
                    u32x2 w0, w1; w0.x = cvt_pk_bf16(v0[0], v0[1]); w0.y = cvt_pk_bf16(v0[2], v0[3]); w1.x = cvt_pk_bf16(v1[0], v1[1]); w1.y = cvt_pk_bf16(v1[2], v1[3]);
                    *(u32x2*)p = w0; *(u32x2*)(p + 16) = w1;
                }
            }
            asm volatile("" ::: "memory");
        }
    }
};
struct EpiKV {
    static constexpr bool AFTER_DRAIN = true; static constexpr bool TWOSEG = false; static constexpr bool PERM = true;
    bf16_t* K; bf16_t* V; const float* rstd;
    DI void operator()(AccRef, const Unit&, int, int, int, int) const {}
    DI void after(AccRef acc, const Unit& u, int wr, int wc, int fr, int fq, LAS unsigned char* lds, int tid) const {
#pragma unroll
        for (int ai = 0; ai < 2; ++ai)
#pragma unroll
            for (int m = 0; m < 4; ++m) { const int r = wr * 64 + ai * HALF + m * 16 + fr; const float sc = rstd[u.pm * BM + r];
#pragma unroll
                for (int bj = 0; bj < 2; ++bj) *(LAS u32x4*)(lds + r * 528 + (bj * HALF + wc * 32 + 8 * fq) * 2) = pack8(acc[ai][bj][m][0] * sc, acc[ai][bj][m][1] * sc); }
        asm volatile("s_waitcnt lgkmcnt(0)" ::: "memory"); __builtin_amdgcn_s_barrier(); asm volatile("" ::: "memory");
        const int ch = tid & 31, r0 = tid >> 5;
#pragma unroll 4
        for (int i = 0; i < 16; ++i) {
            const int r = r0 + 16 * i;
            const u32x4 a = *(const LAS u32x4*)(lds + r * 528 + ch * 16);
            const size_t row = (size_t)(u.pm * BM + r); const int c = (u.pn & 1) * 256 + ch * 8;
            bf16_t* p = (u.pn < 2) ? K + row * 768 + (c >> 6) * 96 + (c & 63) : V + row * 512 + c;
            *(u32x4*)p = a;
        }
    }
};
template <int MODE> struct EpiMerge {
    static constexpr bool AFTER_DRAIN = false; static constexpr bool TWOSEG = false; static constexpr bool PERM = true;
    bf16_t* MG; const bf16_t* GATE;
    DI void operator()(AccRef acc, const Unit& u, int wr, int wc, int fr, int fq) const {
        const int row0 = u.pm * BM + wr * 64 + fr, col0 = u.pn * BM + wc * 32 + 8 * fq;
#pragma unroll
        for (int ai = 0; ai < 2; ++ai)
#pragma unroll
            for (int m = 0; m < 4; ++m) { const size_t row = (size_t)(row0 + ai * HALF + m * 16);
#pragma unroll
                for (int bj = 0; bj < 2; ++bj) {
                    const u32x4 g = *(const u32x4*)(GATE + row * GATE_LD + MODE * 1024 + col0 + bj * HALF);
                    bf16_t* p = MG + row * 1024 + col0 + bj * HALF;
                    f32x4 v0 = acc[ai][bj][m][0], v1 = acc[ai][bj][m][1];
                    v0[0] *= bflo(g.x); v0[1] *= bfhi(g.x); v0[2] *= bflo(g.y); v0[3] *= bfhi(g.y);
                    v1[0] *= bflo(g.z); v1[1] *= bfhi(g.z); v1[2] *= bflo(g.w); v1[3] *= bfhi(g.w);
                    if (MODE == 1) { const u32x4 o = *(const u32x4*)p;
                        v0[0] += bflo(o.x); v0[1] += bfhi(o.x); v0[2] += bflo(o.y); v0[3] += bfhi(o.y);
                        v1[0] += bflo(o.z); v1[1] += bfhi(o.z); v1[2] += bflo(o.w); v1[3] += bfhi(o.w); }
                    *(u32x4*)p = pack8(v0, v1);
                }
                asm volatile("" ::: "memory");
            }
    }
};
struct EpiMerge2 {
    static constexpr bool AFTER_DRAIN = true; static constexpr bool TWOSEG = true; static constexpr bool PERM = true;
    bf16_t* MG; const bf16_t* GATE;
    DI void mid(f32x4 (&acc)[2][2][4][2], const Unit& u, int wr, int wc, int fr, int fq) const {
        const int row0 = u.pm * BM + wr * 64 + fr, col0 = u.pn * BM + wc * 32 + 8 * fq;
#pragma unroll
        for (int ai = 0; ai < 2; ++ai) {
            u32x4 rr[4][2];
#pragma unroll
            for (int m = 0; m < 4; ++m)
#pragma unroll
                for (int bj = 0; bj < 2; ++bj) rr[m][bj] = __builtin_nontemporal_load((const u32x4*)(GATE + (size_t)(row0 + ai * HALF + m * 16) * GATE_LD + 1024 + col0 + bj * HALF));
#pragma unroll
            for (int m = 0; m < 4; ++m)
#pragma unroll
                for (int bj = 0; bj < 2; ++bj) { const u32x4 r = rr[m][bj];
                    f32x4& v0 = acc[ai][bj][m][0]; f32x4& v1 = acc[ai][bj][m][1];
                    v0[0] *= bflo(r.x); v0[1] *= bfhi(r.x); v0[2] *= bflo(r.y); v0[3] *= bfhi(r.y);
                    v1[0] *= bflo(r.z); v1[1] *= bfhi(r.z); v1[2] *= bflo(r.w); v1[3] *= bfhi(r.w); }
            asm volatile("" ::: "memory"); }
    }
    DI void operator()(AccRef, const Unit&, int, int, int, int) const {}
    DI void after(AccRef acc, const Unit& u, int wr, int wc, int fr, int fq, LAS unsigned char* lds, int tid) const {
#pragma unroll
        for (int ai = 0; ai < 2; ++ai)
#pragma unroll
            for (int m = 0; m < 4; ++m) { const int r = wr * 64 + ai * HALF + m * 16 + fr;
#pragma unroll
                for (int bj = 0; bj < 2; ++bj) *(LAS u32x4*)(lds + r * 528 + (bj * HALF + wc * 32 + 8 * fq) * 2) = pack8(acc[ai][bj][m][0], acc[ai][bj][m][1]); }
        asm volatile("s_waitcnt lgkmcnt(0)" ::: "memory"); __builtin_amdgcn_s_barrier(); asm volatile("" ::: "memory");
        const int ch = tid & 31, r0 = tid >> 5;
        u32x4 gg[16];
#pragma unroll
        for (int i = 0; i < 16; ++i) gg[i] = __builtin_nontemporal_load((const u32x4*)(GATE + (size_t)(u.pm * BM + r0 + 16 * i) * GATE_LD + u.pn * BM + ch * 8));
#pragma unroll
        for (int i = 0; i < 16; ++i) {
            const int r = r0 + 16 * i;
            const u32x4 a = *(const LAS u32x4*)(lds + r * 528 + ch * 16);
            const size_t row = (size_t)(u.pm * BM + r); const int col = u.pn * BM + ch * 8;
            const u32x4 g = gg[i];
            f32x4 v0, v1; v0[0] = bflo(a.x) * bflo(g.x); v0[1] = bfhi(a.x) * bfhi(g.x); v0[2] = bflo(a.y) * bflo(g.y); v0[3] = bfhi(a.y) * bfhi(g.y);
            v1[0] = bflo(a.z) * bflo(g.z); v1[1] = bfhi(a.z) * bfhi(g.z); v1[2] = bflo(a.w) * bflo(g.w); v1[3] = bfhi(a.w) * bfhi(g.w);
            *(u32x4*)(MG + row * 1024 + col) = pack8(v0, v1);
        }
    }
};
struct EpiResid {
    static constexpr bool AFTER_DRAIN = false; static constexpr bool TWOSEG = false; static constexpr bool PERM = false;
    const float* res; float* out;
    DI void operator()(AccRef acc, const Unit& u, int wr, int wc, int fr, int fq) const {
        const int row0 = u.pm * BM + wr * 64 + fr, col0 = u.pn * BM + wc * 32 + 4 * fq;
#pragma unroll
        for (int ai = 0; ai < 2; ++ai)
#pragma unroll
            for (int m = 0; m < 4; ++m) { const size_t off = (size_t)(row0 + ai * HALF + m * 16) * D + col0;
#pragma unroll
                for (int bj = 0; bj < 2; ++bj)
#pragma unroll
                    for (int n = 0; n < 2; ++n) { const f32x4 r = *(const f32x4*)(res + off + bj * HALF + n * 16); *(f32x4*)(out + off + bj * HALF + n * 16) = r + acc[ai][bj][m][n]; }
                asm volatile("" ::: "memory"); }
    }
};
template <bool RES_F32> struct EpiResidB {
    static constexpr bool AFTER_DRAIN = true; static constexpr bool TWOSEG = false; static constexpr bool PERM = true;
    const void* res; bf16_t* out; float scale;
    DI void operator()(AccRef, const Unit&, int, int, int, int) const {}
    DI void after(AccRef acc, const Unit& u, int wr, int wc, int fr, int fq, LAS unsigned char* lds, int tid) const {
#pragma unroll
        for (int ai = 0; ai < 2; ++ai)
#pragma unroll
            for (int m = 0; m < 4; ++m) { const int r = wr * 64 + ai * HALF + m * 16 + fr;
#pragma unroll
                for (int bj = 0; bj < 2; ++bj) *(LAS u32x4*)(lds + r * 528 + (bj * HALF + wc * 32 + 8 * fq) * 2) = pack8(acc[ai][bj][m][0] * scale, acc[ai][bj][m][1] * scale); }
        asm volatile("s_waitcnt lgkmcnt(0)" ::: "memory"); __builtin_amdgcn_s_barrier(); asm volatile("" ::: "memory");
        const int ch = tid & 31, r0 = tid >> 5;
#pragma unroll
        for (int i0 = 0; i0 < 16; i0 += 8) {
        f32x4 rf[RES_F32 ? 8 : 1][2]; u32x4 rb[RES_F32 ? 1 : 8];
#pragma unroll
        for (int i = 0; i < 8; ++i) { const size_t off = (size_t)(u.pm * BM + r0 + 16 * (i0 + i)) * D + u.pn * BM + ch * 8;
            if (RES_F32) { const float* rp = (const float*)res + off; rf[RES_F32 ? i : 0][0] = __builtin_nontemporal_load((const f32x4*)rp); rf[RES_F32 ? i : 0][1] = __builtin_nontemporal_load((const f32x4*)(rp + 4)); }
            else rb[RES_F32 ? 0 : i] = *(const u32x4*)((const bf16_t*)res + off); }
#pragma unroll
        for (int i = 0; i < 8; ++i) {
            const int r = r0 + 16 * (i0 + i);
            const u32x4 a = *(const LAS u32x4*)(lds + r * 528 + ch * 16);
            const size_t off = (size_t)(u.pm * BM + r) * D + u.pn * BM + ch * 8;
            f32x4 v0, v1; v0[0] = bflo(a.x); v0[1] = bfhi(a.x); v0[2] = bflo(a.y); v0[3] = bfhi(a.y); v1[0] = bflo(a.z); v1[1] = bfhi(a.z); v1[2] = bflo(a.w); v1[3] = bfhi(a.w);
            if (RES_F32) { v0 = v0 + rf[RES_F32 ? i : 0][0]; v1 = v1 + rf[RES_F32 ? i : 0][1]; }
            else { const u32x4 rr = rb[RES_F32 ? 0 : i];
                v0[0] += bflo(rr.x); v0[1] += bfhi(rr.x); v0[2] += bflo(rr.y); v0[3] += bfhi(rr.y); v1[0] += bflo(rr.z); v1[1] += bfhi(rr.z); v1[2] += bflo(rr.w); v1[3] += bfhi(rr.w); }
            *(u32x4*)(out + off) = pack8(v0, v1);
        }
        }
    }
};
struct EpiSwiGLU {
    static constexpr bool AFTER_DRAIN = false; static constexpr bool TWOSEG = false; static constexpr bool PERM = true;
    bf16_t* H; int ldh; float scale; float oscale;
    DI void operator()(AccRef acc, const Unit& u, int wr, int wc, int fr, int fq) const {
        const int row0 = u.pm * BM + wr * 64 + fr, col0 = u.pn * HALF + wc * 32 + 8 * fq;
#pragma unroll
        for (int ai = 0; ai < 2; ++ai)
#pragma unroll
            for (int m = 0; m < 4; ++m) {
                const f32x4 v0 = silu4(acc[ai][0][m][0] * scale) * (acc[ai][1][m][0] * scale), v1 = silu4(acc[ai][0][m][1] * scale) * (acc[ai][1][m][1] * scale);
                if (oscale != 0.f) { f32x4 w0 = v0 * oscale, w1 = v1 * oscale; u32x2 o;
#pragma unroll
                    for (int i = 0; i < 4; ++i) { w0[i] = __builtin_amdgcn_fmed3f(w0[i], -448.f, 448.f); w1[i] = __builtin_amdgcn_fmed3f(w1[i], -448.f, 448.f); }
                    o.x = __builtin_amdgcn_cvt_pk_fp8_f32(w0[0], w0[1], 0, false); o.x = __builtin_amdgcn_cvt_pk_fp8_f32(w0[2], w0[3], o.x, true);
                    o.y = __builtin_amdgcn_cvt_pk_fp8_f32(w1[0], w1[1], 0, false); o.y = __builtin_amdgcn_cvt_pk_fp8_f32(w1[2], w1[3], o.y, true);
                    __builtin_nontemporal_store(o, (u32x2*)((unsigned char*)H + (size_t)(row0 + ai * HALF + m * 16) * ldh + col0)); }
                else __builtin_nontemporal_store(pack8(v0, v1), (u32x4*)(H + (size_t)(row0 + ai * HALF + m * 16) * ldh + col0));
                asm volatile("" ::: "memory");
            }
    }
};
struct EpiStore {
    static constexpr bool AFTER_DRAIN = false; static constexpr bool TWOSEG = false; static constexpr bool PERM = true;
    bf16_t* O; int ldc; float scale;
    DI void operator()(AccRef acc, const Unit& u, int wr, int wc, int fr, int fq) const {
        const int row0 = u.pm * BM + wr * 64 + fr, col0 = u.pn * BM + wc * 32 + 8 * fq;
#pragma unroll
        for (int ai = 0; ai < 2; ++ai)
#pragma unroll
            for (int m = 0; m < 4; ++m) { bf16_t* rowp = O + (size_t)(row0 + ai * HALF + m * 16) * ldc + col0;
#pragma unroll
                for (int bj = 0; bj < 2; ++bj) *(u32x4*)(rowp + bj * HALF) = pack8(acc[ai][bj][m][0] * scale, acc[ai][bj][m][1] * scale);
                asm volatile("" ::: "memory"); }
    }
};

template <class Epi, class Sched, bool ALIGN_EPI, int QM = 0>
DI void gemm_phase(LAS unsigned char* lds, const Gemm g, const Sched& S, const Epi& E, int tid_in) {
    constexpr bool FP8 = (QM == 1); constexpr bool I8 = (QM == 2);
    int tid_ = tid_in * 64 + lane_id_asm();
    const int tid = tid_, wid = tid_in, lane = tid & 63, wr = wid >> 2, wc = wid & 3, fr = lane & 15, fq = lane >> 4;
    constexpr int EB = QM ? 1 : 2;
    const int K = g.K, lda = g.lda, nt = K * EB / (BK * 2);
    const char* gA = (const char*)g.A; const char* gB = (const char*)g.Bt;
    asm volatile("" : "+s"(gA), "+s"(gB));
    const __amdgpu_buffer_rsrc_t rsA = __builtin_amdgcn_make_buffer_rsrc((void*)gA, 0, 0x7ffff000, 0x00020000), rsB = __builtin_amdgcn_make_buffer_rsrc((void*)gB, 0, 0x7ffff000, 0x00020000);
    unsigned voffA[2], voffB[2];
#pragma unroll
    for (int i = 0; i < 2; ++i) { int R, C; stage_rc(tid * 16 + i * 8192, R, C); const int Rb = Epi::PERM ? ((R & ~31) + perm32(R & 31)) : R;
        voffA[i] = (unsigned)(R * lda * EB + C * 2); voffB[i] = (unsigned)(Rb * K * EB + C * 2); }
    constexpr bool GATHER = Sched::GATHER;
    const unsigned kstep = (unsigned)(BK * 2);
    const unsigned hstepA = GATHER ? 0u : (unsigned)(HALF * lda * EB), hstepB = (unsigned)(HALF * K * EB);
    const unsigned tstepA = GATHER ? 0u : 2u * hstepA, tstepB = 2u * hstepB;
    unsigned va[2][2] = {{0u, 0u}, {0u, 0u}}, vaN[2][2] = {{0u, 0u}, {0u, 0u}};
    const unsigned ldsw = (unsigned)wid * 1024u;
    const int aoff = lds_byte(wr * 64 + fr, fq * 8), boff = lds_byte(wc * 32 + fr, fq * 8);
#define PG8_SA(b, h) (((b) * 2 + (h)) * HTB)
#define PG8_SB(b, h) ((4 + (b) * 2 + (h)) * HTB)
#define PG8_STAGE(bufoff, goff, voff) do { _Pragma("unroll") for (int _i = 0; _i < 2; ++_i) \
        __builtin_amdgcn_raw_ptr_buffer_load_lds(rsB, (LAS unsigned*)(lds + (bufoff) + ldsw + _i * 8192), 16, (voff)[_i], (goff), 0, 0); } while (0)
#define PG8_STAGE_A(bufoff, goff, NX, h) do { _Pragma("unroll") for (int _i = 0; _i < 2; ++_i) \
        __builtin_amdgcn_raw_ptr_buffer_load_lds(rsA, (LAS unsigned*)(lds + (bufoff) + ldsw + _i * 8192), 16, GATHER ? ((NX) ? vaN[h][_i] : va[h][_i]) : voffA[_i], (goff), 0, 0); } while (0)
#define PG8_GOFFS(dst, u) do { int gR0_, gC_; stage_rc((wid * 64 + lane_id_asm()) * 16, gR0_, gC_);     \
        _Pragma("unroll") for (int _h = 0; _h < 2; ++_h) _Pragma("unroll") for (int _i = 0; _i < 2; ++_i) dst[_h][_i] = S.row_off(u, _h * HALF + gR0_ + 64 * _i) + (unsigned)(gC_ * 2); } while (0)
#define PG8_LD32(base) ({ typedef int v4i_t __attribute__((ext_vector_type(4))); const v4i_t lo_ = *(const LAS v4i_t*)(base), hi_ = *(const LAS v4i_t*)((base) + 1024); __builtin_shufflevector(lo_, hi_, 0, 1, 2, 3, 4, 5, 6, 7); })
#define PG8_LDA(dst, b, h) do { if constexpr (FP8) { _Pragma("unroll") for (int m = 0; m < 4; ++m) A8[m] = PG8_LD32(lds + PG8_SA(b, h) + aoff + m * 2048); } \
        else { _Pragma("unroll") for (int m = 0; m < 4; ++m) _Pragma("unroll") for (int k = 0; k < 2; ++k) dst[m][k] = *(const LAS bf16x8*)(lds + PG8_SA(b, h) + aoff + m * 2048 + k * 1024); } } while (0)
#define PG8_LDB(dst, b, h) do { if constexpr (FP8) { _Pragma("unroll") for (int n = 0; n < 2; ++n) dst##8[n] = PG8_LD32(lds + PG8_SB(b, h) + boff + n * 2048); } \
        else { _Pragma("unroll") for (int n = 0; n < 2; ++n) _Pragma("unroll") for (int k = 0; k < 2; ++k) dst[n][k] = *(const LAS bf16x8*)(lds + PG8_SB(b, h) + boff + n * 2048 + k * 1024); } } while (0)
#define PG8_MMA(ai, bj, At, Bt) do { __builtin_amdgcn_s_setprio(1); _Pragma("unroll") for (int m = 0; m < 4; ++m) _Pragma("unroll") for (int n = 0; n < 2; ++n) { \
        if constexpr (FP8) acc[ai][bj][m][n] = __builtin_amdgcn_mfma_scale_f32_16x16x128_f8f6f4(Bt##8[n], A8[m], acc[ai][bj][m][n], 0, 0, 0, 0, 0, 0); \
        else if constexpr (I8) { _Pragma("unroll") for (int k = 0; k < 2; ++k) acc[ai][bj][m][n] = __builtin_bit_cast(f32x4, __builtin_amdgcn_mfma_i32_16x16x64_i8(__builtin_bit_cast(i32x4_t, Bt[n][k]), __builtin_bit_cast(i32x4_t, At[m][k]), __builtin_bit_cast(i32x4_t, acc[ai][bj][m][n]), 0, 0, 0)); } \
        else { _Pragma("unroll") for (int k = 0; k < 2; ++k) acc[ai][bj][m][n] = __builtin_amdgcn_mfma_f32_16x16x32_bf16(Bt[n][k], At[m][k], acc[ai][bj][m][n], 0, 0, 0); } } \
        __builtin_amdgcn_s_setprio(0); } while (0)
#define PG8_WAIT_V(n) asm volatile("s_waitcnt vmcnt(" #n ")" ::: "memory")
#define PG8_WAIT_L(n) asm volatile("s_waitcnt lgkmcnt(" #n ")" ::: "memory")
#define PG8_BAR __builtin_amdgcn_s_barrier()
#define PG8_SCHED __builtin_amdgcn_sched_barrier(0)
    Unit cur, nxt; int ui = 0;
    if (!S.next(0, cur)) return;
    f32x4 acc[2][2][4][2];
#pragma unroll
    for (int a = 0; a < 2; ++a)
#pragma unroll
        for (int b = 0; b < 2; ++b)
#pragma unroll
            for (int m = 0; m < 4; ++m)
#pragma unroll
                for (int n = 0; n < 2; ++n) acc[a][b][m][n] = (f32x4){0.f, 0.f, 0.f, 0.f};
    typedef int v8i_t __attribute__((ext_vector_type(8)));
    bf16x8 At[FP8 ? 1 : 4][2], B0[2][FP8 ? 1 : 2], B1[2][FP8 ? 1 : 2];
    v8i_t A8[FP8 ? 4 : 1], B08[FP8 ? 2 : 1], B18[FP8 ? 2 : 1];
    unsigned cA = (unsigned)cur.aoff + (unsigned)cur.pm * tstepA, cB = (unsigned)cur.boff + (unsigned)cur.pn * tstepB;
    S.a_ready(cur);
    if constexpr (GATHER) PG8_GOFFS(va, cur);
    PG8_STAGE(PG8_SB(0, 0), cB, voffB); PG8_STAGE(PG8_SB(0, 1), cB + hstepB, voffB); PG8_STAGE_A(PG8_SA(0, 0), cA, false, 0); PG8_STAGE_A(PG8_SA(0, 1), cA + hstepA, false, 1);
    if (wr == 1) PG8_BAR;
    PG8_WAIT_V(2); PG8_BAR;
    PG8_STAGE(PG8_SB(1, 0), cB + kstep, voffB); PG8_STAGE_A(PG8_SA(1, 0), cA + kstep, false, 0); PG8_STAGE(PG8_SB(1, 1), cB + hstepB + kstep, voffB);
    PG8_WAIT_V(6); PG8_BAR;
    for (;;) {
        const bool has_next = S.next(ui + 1, nxt);
        if constexpr (GATHER) { if (has_next) PG8_GOFFS(vaN, nxt); else { _Pragma("unroll") for (int _h = 0; _h < 2; ++_h) _Pragma("unroll") for (int _i = 0; _i < 2; ++_i) vaN[_h][_i] = va[_h][_i]; } }
        const unsigned nA = has_next ? (unsigned)nxt.aoff + (unsigned)nxt.pm * tstepA : cA, nB = has_next ? (unsigned)nxt.boff + (unsigned)nxt.pn * tstepB : cB;
#pragma unroll 1
        for (int t = 0; t < nt; t += 2) {
            const bool last = (t == nt - 2);
            const unsigned a1 = cA + (unsigned)(t + 1) * kstep;
            const unsigned a2 = last ? nA : cA + (unsigned)(t + 2) * kstep, b2 = last ? nB : cB + (unsigned)(t + 2) * kstep;
            const unsigned a3 = a2 + kstep, b3 = b2 + kstep;
            if (last && has_next) S.a_ready(nxt);
            PG8_LDB(B0, 0, 0); PG8_LDB(B1, 0, 1); PG8_SCHED; PG8_LDA(At, 0, 0); PG8_STAGE_A(PG8_SA(1, 1), a1 + hstepA, false, 1);
            PG8_WAIT_V(8); PG8_WAIT_L(0); PG8_BAR; PG8_MMA(0, 0, At, B0); PG8_MMA(0, 1, At, B1); PG8_BAR; PG8_SCHED;
            PG8_LDA(At, 0, 1); PG8_STAGE(PG8_SB(0, 0), b2, voffB); PG8_STAGE(PG8_SB(0, 1), b2 + hstepB, voffB); PG8_STAGE_A(PG8_SA(0, 0), a2, last, 0);
            PG8_WAIT_V(8); PG8_WAIT_L(0); PG8_BAR; PG8_MMA(1, 0, At, B0); PG8_MMA(1, 1, At, B1); PG8_BAR; PG8_SCHED;
            PG8_LDB(B0, 1, 0); PG8_LDB(B1, 1, 1); PG8_SCHED; PG8_LDA(At, 1, 0); PG8_STAGE_A(PG8_SA(0, 1), a2 + hstepA, last, 1);
            PG8_WAIT_V(8); PG8_WAIT_L(0); PG8_BAR; PG8_MMA(0, 0, At, B0); PG8_MMA(0, 1, At, B1); PG8_BAR; PG8_SCHED;
            PG8_LDA(At, 1, 1); PG8_STAGE(PG8_SB(1, 0), b3, voffB); PG8_STAGE(PG8_SB(1, 1), b3 + hstepB, voffB); PG8_STAGE_A(PG8_SA(1, 0), a3, last, 0);
            PG8_WAIT_V(8); PG8_WAIT_L(0); PG8_BAR; PG8_MMA(1, 0, At, B0); PG8_MMA(1, 1, At, B1); PG8_BAR; PG8_SCHED;
        }
        if constexpr (ALIGN_EPI) { if (wr == 0) PG8_BAR; }
        if constexpr (I8) { const int l2 = lane_id_asm();
            const float* sAp = g.sA + cur.pm * BM + wr * 64 + (l2 & 15); const float* sBp = g.sB + cur.pn * BM + wc * 32 + 8 * (l2 >> 4);
            float rs[2][4]; f32x4 cs[2][2];
#pragma unroll
            for (int ai = 0; ai < 2; ++ai)
#pragma unroll
                for (int m = 0; m < 4; ++m) rs[ai][m] = sAp[ai * HALF + m * 16];
#pragma unroll
            for (int bj = 0; bj < 2; ++bj)
#pragma unroll
                for (int n = 0; n < 2; ++n) cs[bj][n] = *(const f32x4*)(sBp + bj * HALF + 4 * n);
#pragma unroll
            for (int bj = 0; bj < 2; ++bj)
#pragma unroll
                for (int n = 0; n < 2; ++n) cs[bj][n] = cs[bj][n] * (1.f / 127.f);
#pragma unroll
            for (int ai = 0; ai < 2; ++ai)
#pragma unroll
                for (int m = 0; m < 4; ++m)
#pragma unroll
                    for (int bj = 0; bj < 2; ++bj)
#pragma unroll
                        for (int n = 0; n < 2; ++n) { const i32x4_t iv = __builtin_bit_cast(i32x4_t, acc[ai][bj][m][n]);
                            acc[ai][bj][m][n] = (f32x4){(float)iv[0], (float)iv[1], (float)iv[2], (float)iv[3]} * (cs[bj][n] * rs[ai][m]); }
        }
        { const int l2 = lane_id_asm();
          if constexpr (Epi::TWOSEG) { if (cur.kind == 0) E.mid(acc, cur, wr, wc, l2 & 15, l2 >> 4); else E(acc, cur, wr, wc, l2 & 15, l2 >> 4); }
          else E(acc, cur, wr, wc, l2 & 15, l2 >> 4); } S.done(cur);
        if (!has_next) break;
        if (!(Epi::TWOSEG && cur.kind == 0))
#pragma unroll
        for (int a = 0; a < 2; ++a)
#pragma unroll
            for (int b = 0; b < 2; ++b)
#pragma unroll
                for (int m = 0; m < 4; ++m)
#pragma unroll
                    for (int n = 0; n < 2; ++n) acc[a][b][m][n] = (f32x4){0.f, 0.f, 0.f, 0.f};
        cur = nxt; cA = nA; cB = nB; ++ui;
        if constexpr (GATHER) { _Pragma("unroll") for (int _h = 0; _h < 2; ++_h) _Pragma("unroll") for (int _i = 0; _i < 2; ++_i) va[_h][_i] = vaN[_h][_i]; }
        if constexpr (ALIGN_EPI) { if (wr == 1) PG8_BAR; }
    }
    PG8_WAIT_V(0);
    if constexpr (!ALIGN_EPI) { if (wr == 0) PG8_BAR; }
    PG8_BAR;
    if constexpr (Epi::AFTER_DRAIN) { const int l2 = lane_id_asm(); E.after(acc, cur, wr, wc, l2 & 15, l2 >> 4, lds, wid * 64 + l2); }
#undef PG8_SA
#undef PG8_SB
#undef PG8_STAGE
#undef PG8_STAGE_A
#undef PG8_GOFFS
#undef PG8_LD32
#undef PG8_LDA
#undef PG8_LDB
#undef PG8_MMA
#undef PG8_WAIT_V
#undef PG8_WAIT_L
#undef PG8_BAR
#undef PG8_SCHED
}
}
#define XB_TMO      128
#define XB_XCNT(j)  (256  + 64 * (j))
#define XB_XSUB(j)  (1280 + 64 * (j))
#define XB_XGEN(j)  (2304 + 64 * (j))
#define XB_TOP      3328
#define XB_TOPGEN   3392
#define XCD_BAR_WORDS 3456
#define XB_SPIN_CAP (1u << 18)

__device__ __forceinline__ unsigned xb_ld(unsigned* p)              { return __hip_atomic_load(p, __ATOMIC_RELAXED, __HIP_MEMORY_SCOPE_AGENT); }
__device__ __forceinline__ unsigned xb_add(unsigned* p, unsigned v) { return __hip_atomic_fetch_add(p, v, __ATOMIC_RELAXED, __HIP_MEMORY_SCOPE_AGENT); }
__device__ __forceinline__ unsigned xb_xcc_id() { return (unsigned)__builtin_amdgcn_s_getreg((3 << 11) | 20) & 0xFu; }
#define XB_SPIN(cond, bar) do { unsigned _sp = 0; while (cond) { __builtin_amdgcn_s_sleep(1); \
    if ((++_sp & 255u) == 0u) { if (xb_ld(&(bar)[XB_TMO])) break; if (_sp > XB_SPIN_CAP) { atomicAdd(&(bar)[XB_TMO], 1u); break; } } } } while (0)

struct XcdBarrier {
    unsigned* bar; unsigned x; int wave;
    volatile LAS unsigned* st;
};

__device__ __forceinline__ XcdBarrier xcd_barrier_post(unsigned* bar, volatile LAS unsigned* st) {
    XcdBarrier b; b.bar = bar; b.x = xb_xcc_id(); b.st = st;
    if (threadIdx.x == 0) (void)xb_add(&bar[XB_XCNT(b.x)], 1u);
    return b;
}
__device__ __forceinline__ void xcd_barrier_complete(unsigned* bar, unsigned x, unsigned& nloc, unsigned& nx) {
    const unsigned G = gridDim.x * gridDim.y * gridDim.z;
    unsigned sum, cnt, mine, sp = 0u;
    for (;;) {
        sum = 0u; cnt = 0u; mine = 0u;
#pragma unroll
        for (unsigned j = 0; j < 16; ++j) { const unsigned c = xb_ld(&bar[XB_XCNT(j)]); sum += c; cnt += (c > 0u) ? 1u : 0u; mine = (j == x) ? c : mine; }
        if (sum == G) break;
        __builtin_amdgcn_s_sleep(1);
        if ((++sp & 255u) == 0u) { if (xb_ld(&bar[XB_TMO])) break; if (sp > XB_SPIN_CAP) { atomicAdd(&bar[XB_TMO], 1u); break; } }
    }
    nloc = mine > 0u ? mine : 1u; nx = cnt > 0u ? cnt : 1u;
}

__device__ __noinline__ void xcd_barrier(const XcdBarrier b) {
    asm volatile("s_waitcnt vmcnt(0)" ::: "memory");
    __syncthreads();
    if (b.wave == 0 && lane_id_asm() == 0) {
        unsigned* bar = b.bar;
        __builtin_amdgcn_s_waitcnt(0);
        unsigned nloc = b.st[0], nx = b.st[1];
        if (nloc == 0u) { xcd_barrier_complete(bar, b.x, nloc, nx); b.st[0] = nloc; b.st[1] = nx; }
        const unsigned old = xb_add(&bar[XB_XSUB(b.x)], 1u);
        const unsigned gen = old / nloc;
        if (old + 1u == (gen + 1u) * nloc) {
            __builtin_amdgcn_fence(__ATOMIC_RELEASE, "agent");
            asm volatile("s_waitcnt vmcnt(0)" ::: "memory");
            const unsigned og = xb_add(&bar[XB_TOP], 1u);
            const unsigned tg = og / nx;
            if (og + 1u == (tg + 1u) * nx) xb_add(&bar[XB_TOPGEN], 1u);
            else XB_SPIN(xb_ld(&bar[XB_TOPGEN]) == tg, bar);
            __builtin_amdgcn_fence(__ATOMIC_ACQUIRE, "agent");
            xb_add(&bar[XB_XGEN(b.x)], 1u);
            asm volatile("s_waitcnt vmcnt(0)" ::: "memory");
        } else {
            XB_SPIN(xb_ld(&bar[XB_XGEN(b.x)]) == gen, bar);
            __builtin_amdgcn_fence(__ATOMIC_ACQUIRE, "agent");
            asm volatile("s_waitcnt vmcnt(0)" ::: "memory");
        }
    }
    __syncthreads();
}
namespace att {
constexpr float ATT_THR = 8.f;
constexpr int KROW = 208;
constexpr int KBUF = 64 * KROW;
constexpr int VBUF = 8192;
constexpr int BUF = KBUF + VBUF;
constexpr int WSF_OFF = 3 * BUF;
constexpr int LDS_NEED = WSF_OFF + 8 * 256;
typedef short v4i16_t __attribute__((ext_vector_type(4)));
DI s16x4 vtr(const LAS unsigned char* p) { return __builtin_bit_cast(s16x4, __builtin_amdgcn_ds_read_tr16_b64_v4i16((LAS v4i16_t*)p)); }
DI float xor32_max(float v) { const auto rr = __builtin_amdgcn_permlane32_swap(__float_as_uint(v), __float_as_uint(v), false, false); return fmaxf(__uint_as_float(rr[0]), __uint_as_float(rr[1])); }
DI bf16x8 pack_p(const f32x16& x, int s) {
    u32x4 p;
    p.x = pg8::cvt_pk_bf16(x[8 * s + 0], x[8 * s + 1]); p.y = pg8::cvt_pk_bf16(x[8 * s + 2], x[8 * s + 3]);
    p.z = pg8::cvt_pk_bf16(x[8 * s + 4], x[8 * s + 5]); p.w = pg8::cvt_pk_bf16(x[8 * s + 6], x[8 * s + 7]);
    return __builtin_bit_cast(bf16x8, p);
}

DI void qk_tile(f32x16& s0, f32x16& s1, const LAS unsigned char* buf, int koff, const bf16x8 (&qf)[6], const f32x16& negv) {
    s0 = negv; s1 = negv;
    __builtin_amdgcn_s_setprio(1);
#pragma unroll
    for (int ks = 0; ks < 6; ++ks) {
        const bf16x8 a0 = *(const LAS bf16x8*)(buf + koff + ks * 32);
        const bf16x8 a1 = *(const LAS bf16x8*)(buf + koff + 32 * KROW + ks * 32);
        s0 = __builtin_amdgcn_mfma_f32_32x32x16_bf16(a0, qf[ks], s0, 0, 0, 0);
        s1 = __builtin_amdgcn_mfma_f32_32x32x16_bf16(a1, qf[ks], s1, 0, 0, 0);
    }
    __builtin_amdgcn_s_setprio(0);
}
DI void attn_unit(LAS unsigned char* lds, const bf16_t* Q, const bf16_t* K, const bf16_t* V, bf16_t* AO, int b, int h, int qb, int tid_, int wave, int lane_) {
    const int lane = lane_id_asm(), tid = wave * 64 + lane; (void)tid_; (void)lane_;
    const int r32 = lane & 31, hi = lane >> 5;
    const int NT = 4 * (qb + 1);
    const size_t rowbase = (size_t)b * SEQ;
    const int q0 = qb * 256 + wave * 32;
    const int cw = q0 >> 6;
    bf16x8 qf[6];
    { const bf16_t* qp = Q + (rowbase + q0 + r32) * 768 + h * 96 + hi * 8;
#pragma unroll
      for (int ks = 0; ks < 6; ++ks) qf[ks] = *(const bf16x8*)(qp + ks * 16); }
    f32x16 o0, o1;
#pragma unroll
    for (int r = 0; r < 16; ++r) { o0[r] = 0.f; o1[r] = 0.f; }
    float mref = 0.f, lrun = 0.f, pend = 0.f;
    f32x16 negv;
#pragma unroll
    for (int r = 0; r < 16; ++r) negv[r] = 0.f;
    const int vkey = tid >> 3, vc = tid & 7;
    const bf16_t* vsrc = V + (rowbase + vkey) * 512 + h * 64 + vc * 8;
    const int vdst = KBUF + (vc >> 2) * 4096 + vkey * 64 + (vc & 3) * 16;
    const int ka = tid / 12, kac = tid - ka * 12;
    const bf16_t* ksrc0 = K + (rowbase + ka) * 768 + h * 96 + kac * 8;
    const int kdst0 = ka * KROW + kac * 16;
    const int i1 = tid + 512, kb = i1 / 12, kbc = i1 - kb * 12;
    const bf16_t* ksrc1 = K + (rowbase + kb) * 768 + h * 96 + kbc * 8;
    const int kdst1 = kb * KROW + kbc * 16;
    const bool has1 = tid < 256;
    u32x4 rk0, rk1 = (u32x4){0u, 0u, 0u, 0u}, rv;
#pragma unroll
    for (int t0 = 0; t0 < 2; ++t0) {
        const size_t adv = (size_t)t0 * 64;
        rk0 = *(const u32x4*)(ksrc0 + adv * 768); if (has1) rk1 = *(const u32x4*)(ksrc1 + adv * 768); rv = *(const u32x4*)(vsrc + adv * 512);
        LAS unsigned char* d = lds + t0 * BUF;
        *(LAS u32x4*)(d + kdst0) = rk0; if (has1) *(LAS u32x4*)(d + kdst1) = rk1; *(LAS u32x4*)(d + vdst) = rv;
    }
    { const size_t adv = (size_t)2 * 64; rk0 = *(const u32x4*)(ksrc0 + adv * 768); if (has1) rk1 = *(const u32x4*)(ksrc1 + adv * 768); rv = *(const u32x4*)(vsrc + adv * 512); }
    lds_barrier();
    LAS float* wsf = (LAS float*)(lds + WSF_OFF + wave * 256);
    const int koff = r32 * KROW + hi * 16;
    const int voff = KBUF + (((lane >> 4) & 1) * 16 + (lane & 3) * 4) * 2 + (4 * hi + ((lane & 15) >> 2)) * 64;
    f32x16 sa0, sa1, sb0, sb1;
    qk_tile(sa0, sa1, lds, koff, qf, negv);
    int scur = 0, snxt = BUF, sfree = 2 * BUF;
#define ATT_STEP(SA0, SA1, SB0, SB1) do { \
        if (t + 2 < NT) { LAS unsigned char* d = lds + sfree; *(LAS u32x4*)(d + kdst0) = rk0; if (has1) *(LAS u32x4*)(d + kdst1) = rk1; *(LAS u32x4*)(d + vdst) = rv; }     \
        if (t + 3 < NT) { const size_t adv = (size_t)(t + 3) * 64; rk0 = *(const u32x4*)(ksrc0 + adv * 768); if (has1) rk1 = *(const u32x4*)(ksrc1 + adv * 768); rv = *(const u32x4*)(vsrc + adv * 512); } \
        const bool act = (t <= cw), actn = (t + 1 <= cw) && (t + 1 < NT); \
        if (actn) qk_tile(SB0, SB1, lds + snxt, koff, qf, negv);         \
        if (act) { \
            if (__any(pend != 0.f)) {                                        \
                _Pragma("unroll") for (int r = 0; r < 16; ++r) { SA0[r] -= pend; SA1[r] -= pend; } \
            } \
            float mx = SA0[0]; \
            _Pragma("unroll") for (int r = 0; r < 16; ++r) mx = __builtin_fmaxf(__builtin_fmaxf(mx, SA0[r]), SA1[r]); \
            mx = xor32_max(mx); \
            pend = 0.f; \
            if (t == 0 || __any(mx > ATT_THR)) {                             \
                const float dl = (t == 0) ? mx : __builtin_fmaxf(mx, 0.f); \
                mref += dl; pend = dl; \
                _Pragma("unroll") for (int r = 0; r < 16; ++r) { SA0[r] -= dl; SA1[r] -= dl; negv[r] = -mref; } \
                if (t != 0) {                                                   \
                    const float f = __builtin_amdgcn_exp2f(-dl); \
                    lrun *= f; \
                    if (hi == 0) wsf[r32] = f; \
                    LDS_WAIT(); \
                    _Pragma("unroll") for (int g = 0; g < 4; ++g) { const f32x4 fv = *(const LAS f32x4*)(wsf + 8 * g + 4 * hi); \
                        _Pragma("unroll") for (int j = 0; j < 4; ++j) { o0[4 * g + j] *= fv[j]; o1[4 * g + j] *= fv[j]; } } \
                } \
            } \
            float ps = 0.f; \
            _Pragma("unroll") for (int r = 0; r < 16; ++r) { SA0[r] = __builtin_amdgcn_exp2f(SA0[r]); SA1[r] = __builtin_amdgcn_exp2f(SA1[r]); ps += SA0[r] + SA1[r]; } \
            lrun += ps; \
            const LAS unsigned char* cur = lds + scur; \
            _Pragma("unroll") for (int s = 0; s < 4; ++s) { \
                const bf16x8 pa = pack_p((s < 2) ? SA0 : SA1, s & 1); \
                const LAS unsigned char* vp = cur + voff + s * 16 * 64; \
                const s16x4 l0 = vtr(vp), h0 = vtr(vp + 8 * 64), l1 = vtr(vp + 4096), h1 = vtr(vp + 4096 + 8 * 64); \
                const bf16x8 vb0 = (bf16x8){l0[0], l0[1], l0[2], l0[3], h0[0], h0[1], h0[2], h0[3]}; \
                const bf16x8 vb1 = (bf16x8){l1[0], l1[1], l1[2], l1[3], h1[0], h1[1], h1[2], h1[3]}; \
                o0 = __builtin_amdgcn_mfma_f32_32x32x16_bf16(pa, vb0, o0, 0, 0, 0); \
                o1 = __builtin_amdgcn_mfma_f32_32x32x16_bf16(pa, vb1, o1, 0, 0, 0); \
            } \
        } \
        lds_barrier(); \
        { const int tmp = scur; scur = snxt; snxt = sfree; sfree = tmp; } \
    } while (0)
#pragma unroll 1
    for (int t2 = 0; t2 < NT; t2 += 2) {
        { const int t = t2; ATT_STEP(sa0, sa1, sb0, sb1); }
        { const int t = t2 + 1; ATT_STEP(sb0, sb1, sa0, sa1); }
    }
#undef ATT_STEP
    lrun = xor32_sum(lrun);
    if (hi == 0) wsf[r32] = __builtin_amdgcn_rcpf(lrun);
    LDS_WAIT();
    bf16_t* op = AO + (rowbase + q0) * 512 + h * 64 + r32;
#pragma unroll
    for (int g = 0; g < 4; ++g) { const f32x4 fv = *(const LAS f32x4*)(wsf + 8 * g + 4 * hi);
#pragma unroll
        for (int j = 0; j < 4; ++j) { const int q = 8 * g + 4 * hi + j;
            op[(size_t)q * 512] = (bf16_t)f2bf(o0[4 * g + j] * fv[j]); op[(size_t)q * 512 + 32] = (bf16_t)f2bf(o1[4 * g + j] * fv[j]); } }
    LDS_WAIT();
    __syncthreads();
}
}

DI void gdn_gate_rows(int gw, int NGW, int lane, const float* ORAW, const bf16_t* Zb, const float* out_norm, bf16_t* GO) {
    const int c0 = lane * 8, e0 = c0 & 127;
    const f32x4 n0 = *(const f32x4*)(out_norm + e0), n1 = *(const f32x4*)(out_norm + e0 + 4);
    f32x4 na = (f32x4){0.f, 0.f, 0.f, 0.f}, nb = na; u32x4 nz = (u32x4){0u, 0u, 0u, 0u};
    if (gw < M) { const GAS f32x4* o4 = (const GAS f32x4*)(ORAW + (size_t)gw * 512 + c0); na = o4[0]; nb = o4[1]; nz = *(const GAS u32x4*)(Zb + (size_t)gw * Z_LD + c0); }
    for (int m = gw; m < M; m += NGW) {
        f32x4 a = na, b = nb; u32x4 zz = nz;
        asm volatile("" : "+v"(a), "+v"(b), "+v"(zz));
        if (m + NGW < M) { const GAS f32x4* o4 = (const GAS f32x4*)(ORAW + (size_t)(m + NGW) * 512 + c0); na = o4[0]; nb = o4[1]; nz = *(const GAS u32x4*)(Zb + (size_t)(m + NGW) * Z_LD + c0); }
        float ss = (a.x * a.x + a.y * a.y) + (a.z * a.z + a.w * a.w) + (b.x * b.x + b.y * b.y) + (b.z * b.z + b.w * b.w);
        ss += swz_xor<1>(ss); ss += swz_xor<2>(ss); ss += swz_xor<4>(ss); ss += swz_xor<8>(ss);
        const float r = rsqrtf(ss * (1.f / 128.f) + EPS);
        u32x4 o;
        o.x = pk2(a.x * r * n0.x * siluf(bflo(zz.x)), a.y * r * n0.y * siluf(bfhi(zz.x)));
        o.y = pk2(a.z * r * n0.z * siluf(bflo(zz.y)), a.w * r * n0.w * siluf(bfhi(zz.y)));
        o.z = pk2(b.x * r * n1.x * siluf(bflo(zz.z)), b.y * r * n1.y * siluf(bfhi(zz.z)));
        o.w = pk2(b.z * r * n1.z * siluf(bflo(zz.w)), b.w * r * n1.w * siluf(bfhi(zz.w)));
        *(GAS u32x4*)(GO + (size_t)m * 512 + c0) = o;
    }
}

DI void mla_prep_rows(int gw, int NGW, int lane, const bf16_t* MISC, float* rstdq, float* rstdkv) {
    unsigned nq[3] = {0u, 0u, 0u}, nk[2] = {0u, 0u};
#define MLA_ISSUE(mm) do { const bf16_t* pr_ = MISC + (size_t)(mm) * MISC_LD; \
        _Pragma("unroll") for (int i = 0; i < 3; ++i) nq[i] = *(const GAS unsigned*)(pr_ + MC_CQ + 2 * lane + 128 * i); \
        _Pragma("unroll") for (int i = 0; i < 2; ++i) nk[i] = *(const GAS unsigned*)(pr_ + MC_CKV + 2 * lane + 128 * i); } while (0)
    if (gw < M) MLA_ISSUE(gw);
    for (int m = gw; m < M; m += NGW) {
        unsigned q0 = nq[0], q1 = nq[1], q2 = nq[2], k0 = nk[0], k1 = nk[1];
        asm volatile("" : "+v"(q0), "+v"(q1), "+v"(q2), "+v"(k0), "+v"(k1));
        if (m + NGW < M) MLA_ISSUE(m + NGW);
        float ss = (bflo(q0) * bflo(q0) + bfhi(q0) * bfhi(q0)) + (bflo(q1) * bflo(q1) + bfhi(q1) * bfhi(q1)) + (bflo(q2) * bflo(q2) + bfhi(q2) * bfhi(q2));
        ss = wave_sum(ss);
        const float rq = rsqrtf(ss * (1.f / 384.f) + EPS);
        ss = (bflo(k0) * bflo(k0) + bfhi(k0) * bfhi(k0)) + (bflo(k1) * bflo(k1) + bfhi(k1) * bfhi(k1));
        ss = wave_sum(ss);
        const float rkv = rsqrtf(ss * (1.f / 256.f) + EPS);
        if (lane == 0) { rstdq[m] = rq; rstdkv[m] = rkv; }
    }
#undef MLA_ISSUE
}
DI void mla_kpe_rows(int gw, int NGW, int lane, const bf16_t* MISC, const float* COS, const float* SIN, bf16_t* Kb) {
    const int sub = lane >> 4, j = lane & 15;
    for (int m = 4 * gw + sub; m < M; m += 4 * NGW) {
        const bf16_t* pr = MISC + (size_t)m * MISC_LD;
        const float c = COS[(size_t)m * 16 + j], s = SIN[(size_t)m * 16 + j];
        const float t1 = bf2f(pr[MC_KR + j]), t2 = bf2f(pr[MC_KR + 16 + j]);
        const bf16_t o1 = (bf16_t)f2bf(t1 * c - t2 * s), o2 = (bf16_t)f2bf(t2 * c + t1 * s);
#pragma unroll
        for (int h = 0; h < 8; ++h) { Kb[(size_t)m * 768 + h * 96 + 64 + j] = o1; Kb[(size_t)m * 768 + h * 96 + 80 + j] = o2; }
    }
}

namespace gdn {
constexpr int ROWB = 272;
constexpr int GV = 0, LS = 1024, PART = 18432, QS = 26624, KS = 44032, VS = 61440;
constexpr int LDS_NEED = VS + 17408;


constexpr int T_GV = 0, T_LS = 1024, T_PART = 1024  , T_QS = 18432, T_KS = 35840, T_VS = 53248, TEAM_LDS = 70656;
DI void conv8(float (&y)[8][8], float (&ps)[8], const bf16_t* QKV, const float* conv_w, size_t m0, int c, int ch, int rg) {
    f32x4 cw[4][2];
#pragma unroll
    for (int j = 0; j < 4; ++j) { cw[j][0] = *(const f32x4*)(conv_w + j * 1536 + ch); cw[j][1] = *(const f32x4*)(conv_w + j * 1536 + ch + 4); }
    u32x4 xw[11];
#pragma unroll
    for (int i = 0; i < 11; ++i) {
        const int row = 8 * rg - 3 + i;
        xw[i] = (u32x4){0u, 0u, 0u, 0u};
        if (row >= 0 || c > 0) xw[i] = *(const GAS u32x4*)((const GAS char*)(QKV + (m0 - 3) * QKV_LD) + (unsigned)(((row + 3) * QKV_LD + ch) * 2));
    }
#pragma unroll
    for (int r = 0; r < 8; ++r) {
        float p = 0.f;
#pragma unroll
        for (int i = 0; i < 8; ++i) {
            float a = 0.f;
#pragma unroll
            for (int j = 0; j < 4; ++j) { const unsigned w = xw[r + j][i >> 1]; a += cw[j][i >> 2][i & 3] * ((i & 1) ? bfhi(w) : bflo(w)); }
            a = siluf(a); y[r][i] = a; p += a * a;
        }
        ps[r] = p;
    }
}
DI void local_pair(LAS unsigned char* lds_, const bf16_t* QKV, const bf16_t* MISC, const float* conv_w, const float* a_log, const float* dt_bias,
                   bf16_t* UT, bf16_t* Wb, bf16_t* QD, bf16_t* KDT, bf16_t* AT, float* CD, int up, int wave8) {
    const int lane = lane_id_asm();
    const int team = wave8 >> 2, w4 = wave8 & 3, un = 2 * up + team;
    LAS unsigned char* lds = lds_ + team * TEAM_LDS;
    const int bh = un >> 5, c = un & 31, b = bh >> 2, h = bh & 3;
    const size_t m0 = (size_t)b * SEQ + (size_t)c * 64;
    unsigned vz = 0u; asm volatile("" : "+v"(vz));
    LAS unsigned char* ldv = lds + vz;
    LAS float* Gs = (LAS float*)(ldv + T_GV); LAS float* Bs = Gs + 64; LAS float* EGs = Gs + 128; LAS float* ELs = Gs + 192;
    const int cg = lane & 15, rg = 4 * (w4 & 1) + (lane >> 4);
    if (w4 < 2) {
        float y[8][8], ps[8];
        conv8(y, ps, QKV, conv_w, m0, c, 1024 + h * 128 + cg * 8, rg);
#pragma unroll
        for (int r = 0; r < 8; ++r) { u32x4 w; w.x = pk2(y[r][0], y[r][1]); w.y = pk2(y[r][2], y[r][3]); w.z = pk2(y[r][4], y[r][5]); w.w = pk2(y[r][6], y[r][7]);
            *(LAS u32x4*)(lds + T_VS + (8 * rg + r) * ROWB + cg * 16) = w; }
    } else if (w4 == 2) {
        const size_t m = m0 + lane;
        const float a = bf2f(MISC[m * MISC_LD + MC_A + h]) + dt_bias[h];
        const float ea = __expf(a);
        const float sp = a > 20.f ? a : (ea < 0.015625f ? ea * (1.f - ea * (0.5f - ea * (1.f / 3.f - 0.25f * ea))) : __logf(1.f + ea));
        const float g = -__expf(a_log[h]) * sp;
        Bs[lane] = sigmf(bf2f(MISC[m * MISC_LD + MC_B + h]));
        Gs[lane] = g;
        LDS_WAIT();
        float G = 0.f;
#pragma unroll
        for (int j4 = 0; j4 < 16; ++j4) { const f32x4 gv = *(const LAS f32x4*)(Gs + 4 * j4);
#pragma unroll
            for (int jj = 0; jj < 4; ++jj) G += (4 * j4 + jj <= lane) ? gv[jj] : 0.f; }
        const float GL = __int_as_float(__builtin_amdgcn_readlane(__float_as_int(G), 63));
        LDS_WAIT();
        Gs[lane] = G; EGs[lane] = __expf(G); ELs[lane] = __expf(GL - G);
        if (lane == 63) CD[un] = __expf(GL);
    }
    const int mat = w4 >> 1;
    float y[8][8];
    {
        float ps[8];
        conv8(y, ps, QKV, conv_w, m0, c, mat * 512 + h * 128 + cg * 8, rg);
#pragma unroll
        for (int r = 0; r < 8; ++r) ((LAS float*)(lds + T_PART))[(mat * 64 + 8 * rg + r) * 16 + cg] = ps[r];
    }
    lds_barrier();
    {
        LAS unsigned char* tile = lds + (mat == 0 ? T_QS : T_KS);
#pragma unroll
        for (int r = 0; r < 8; ++r) {
            const LAS f32x4* pp = (const LAS f32x4*)(ldv + T_PART) + (mat * 64 + 8 * rg + r) * 4;
            const f32x4 p0 = pp[0], p1 = pp[1], p2 = pp[2], p3 = pp[3];
            const float ss = ((p0.x + p0.y) + (p0.z + p0.w)) + ((p1.x + p1.y) + (p1.z + p1.w)) + ((p2.x + p2.y) + (p2.z + p2.w)) + ((p3.x + p3.y) + (p3.z + p3.w));
            const float rn = rsqrtf(ss + EPS) * (mat == 0 ? 0.08838834764831845f : 1.f);
            const int row = 8 * rg + r;
            u32x4 w; w.x = pk2(y[r][0] * rn, y[r][1] * rn); w.y = pk2(y[r][2] * rn, y[r][3] * rn); w.z = pk2(y[r][4] * rn, y[r][5] * rn); w.w = pk2(y[r][6] * rn, y[r][7] * rn);
            *(LAS u32x4*)(tile + row * ROWB + cg * 16) = w;
            if (mat == 0) {
                const float eg = EGs[row];
                u32x4 d; d.x = pk2(bflo(w.x) * eg, bfhi(w.x) * eg); d.y = pk2(bflo(w.y) * eg, bfhi(w.y) * eg); d.z = pk2(bflo(w.z) * eg, bfhi(w.z) * eg); d.w = pk2(bflo(w.w) * eg, bfhi(w.w) * eg);
                *(GAS u32x4*)(QD + (((size_t)un * 16 + (row >> 4) * 4 + (cg >> 2)) * 64 + (row & 15) + 16 * (cg & 3)) * 8) = d;
            }
        }
    }
    lds_barrier();
    {
        const int r32 = lane & 31, hi = lane >> 5, bi = w4 >> 1, bj = w4 & 1;
        const int j = 32 * bj + r32; const float Gj = Gs[j];
#pragma unroll
        for (int pass = 0; pass < 2; ++pass) {
            const bool qk = pass == 1;
            f32x16 acc;
#pragma unroll
            for (int r = 0; r < 16; ++r) acc[r] = 0.f;
            if (w4 != 1) {
                const LAS unsigned char* At = lds + (qk ? T_QS : T_KS) + (32 * bi + r32) * ROWB + hi * 16;
                const LAS unsigned char* Bt = lds + T_KS + (32 * bj + r32) * ROWB + hi * 16;
#pragma unroll
                for (int ks = 0; ks < 8; ++ks) acc = __builtin_amdgcn_mfma_f32_32x32x16_bf16(*(const LAS bf16x8*)(At + ks * 32), *(const LAS bf16x8*)(Bt + ks * 32), acc, 0, 0, 0);
            }
#pragma unroll
            for (int g4 = 0; g4 < 4; ++g4) {
                const int ib = 32 * bi + 8 * g4 + 4 * hi;
                const f32x4 Gi = *(const LAS f32x4*)(Gs + ib), Bi = *(const LAS f32x4*)(Bs + ib);
#pragma unroll
                for (int jj = 0; jj < 4; ++jj) {
                    const int i = ib + jj; const float d = __expf(Gi[jj] - Gj); const float cv = acc[4 * g4 + jj];
                    if (!qk) ((LAS float*)(lds + T_LS))[i * 68 + j] = (i > j) ? Bi[jj] * cv * d : 0.f;
                    else AT[(((size_t)un * 8 + (i >> 4) * 2 + (j >> 5)) * 64 + (i & 15) + 16 * ((j & 31) >> 3)) * 8 + (j & 7)] = (bf16_t)f2bf((i >= j) ? cv * d : 0.f);
                }
            }
        }
    }
    lds_barrier();
    {
        const int col = 64 * w4 + lane;
        const bool isk = w4 >= 2;
        const LAS unsigned char* src = lds + (isk ? T_KS : T_VS) + (col & 127) * 2;
        f32x2 sol[32];
#pragma unroll
        for (int t = 0; t < 32; ++t) { sol[t].x = bf2f(*(const LAS bf16_t*)(src + (2 * t) * ROWB)); sol[t].y = bf2f(*(const LAS bf16_t*)(src + (2 * t + 1) * ROWB)); }
        if (isk) {
            const int dkk = col & 127;
#pragma unroll
            for (int t8 = 0; t8 < 8; ++t8) { const f32x4 e0 = *(const LAS f32x4*)(ELs + 8 * t8), e1 = *(const LAS f32x4*)(ELs + 8 * t8 + 4);
                u32x4 w; w.x = pk2(sol[4 * t8].x * e0.x, sol[4 * t8].y * e0.y); w.y = pk2(sol[4 * t8 + 1].x * e0.z, sol[4 * t8 + 1].y * e0.w);
                w.z = pk2(sol[4 * t8 + 2].x * e1.x, sol[4 * t8 + 2].y * e1.y); w.w = pk2(sol[4 * t8 + 3].x * e1.z, sol[4 * t8 + 3].y * e1.w);
                *(GAS u32x4*)(KDT + (((size_t)un * 16 + (dkk >> 4) * 2 + (t8 >> 2)) * 64 + (dkk & 15) + 16 * (t8 & 3)) * 8) = w; }
        }
#pragma unroll
        for (int t4 = 0; t4 < 16; ++t4) { const f32x4 bb = *(const LAS f32x4*)(Bs + 4 * t4); f32x4 ee = (f32x4){1.f, 1.f, 1.f, 1.f}; if (isk) ee = *(const LAS f32x4*)(EGs + 4 * t4);
            sol[2 * t4].x *= bb[0] * ee[0]; sol[2 * t4].y *= bb[1] * ee[1]; sol[2 * t4 + 1].x *= bb[2] * ee[2]; sol[2 * t4 + 1].y *= bb[3] * ee[3]; }
        const LAS float* Lm = (const LAS float*)(ldv + T_LS);
        f32x4 La[8], Lb[8]; f32x2 acc = (f32x2){0.f, 0.f};
#define GL_INFO(sx) const int i_ = (sx) < 32 ? (sx) + 1 : 33 + (((sx) - 32) >> 1); const int tot_ = (i_ + 3) / 4; const int q0_ = ((sx) >= 32 && (((sx) - 32) & 1)) ? 8 : 0; const int nq_ = (sx) < 32 ? tot_ : ((((sx) - 32) & 1) ? tot_ - 8 : 8)
#define GL_LOAD(buf, sx) do { GL_INFO(sx); _Pragma("unroll") for (int q_ = 0; q_ < nq_; ++q_) buf[q_] = *(const LAS f32x4*)(Lm + i_ * 68 + 4 * (q0_ + q_)); } while (0)
#define GL_APPLY(buf, sx) do { GL_INFO(sx); if (q0_ == 0) acc = (f32x2){(i_ & 1) ? sol[i_ >> 1].y : sol[i_ >> 1].x, 0.f}; \
            _Pragma("unroll") for (int q_ = 0; q_ < nq_; ++q_) { acc = acc - (f32x2){buf[q_].x, buf[q_].y} * sol[2 * (q0_ + q_)]; acc = acc - (f32x2){buf[q_].z, buf[q_].w} * sol[2 * (q0_ + q_) + 1]; } \
            if (q0_ + nq_ == tot_) { if (i_ & 1) sol[i_ >> 1].y = acc.x + acc.y; else sol[i_ >> 1].x = acc.x + acc.y; } } while (0)
        GL_LOAD(La, 0);
#pragma unroll
        for (int sx = 0; sx < 94; sx += 2) {
            GL_LOAD(Lb, sx + 1);
            __builtin_amdgcn_sched_barrier(0);
            GL_APPLY(La, sx);
            if (sx + 2 < 94) GL_LOAD(La, sx + 2);
            __builtin_amdgcn_sched_barrier(0);
            GL_APPLY(Lb, sx + 1);
        }
#undef GL_INFO
#undef GL_LOAD
#undef GL_APPLY
        if (!isk) {
            GAS u32x4* upp = (GAS u32x4*)(UT + ((size_t)un * 128 + col) * 64);
#pragma unroll
            for (int t8 = 0; t8 < 8; ++t8) { u32x4 w; w.x = pk2(sol[4 * t8].x, sol[4 * t8].y); w.y = pk2(sol[4 * t8 + 1].x, sol[4 * t8 + 1].y); w.z = pk2(sol[4 * t8 + 2].x, sol[4 * t8 + 2].y); w.w = pk2(sol[4 * t8 + 3].x, sol[4 * t8 + 3].y); upp[t8] = w; }
        } else {
            const int dk = col & 127;
            bf16_t* wp = Wb + (((size_t)un * 16 + (dk >> 5)) * 64 + 16 * ((dk & 31) >> 3)) * 8 + (dk & 7);
#pragma unroll
            for (int t = 0; t < 64; ++t) wp[(((t >> 4) * 4) * 64 + (t & 15)) * 8] = (bf16_t)f2bf((t & 1) ? sol[t >> 1].y : sol[t >> 1].x);
        }
    }
    lds_barrier();
}

constexpr int ST_OFF = 0, ST_ROWB = 272, VN_OFF = 4352, VN_ROWB = 144, SCAN_LDS = VN_OFF + 16 * VN_ROWB;
struct Frag { bf16x8 w[4], qd[4], at[2], kd[2][2]; u32x2 u; float cd; };
struct ScanRs { __amdgpu_buffer_rsrc_t w, qd, kdt, at, ut; const float* CD; };
DI ScanRs scan_rs(const bf16_t* UT, const bf16_t* Wb, const bf16_t* QD, const bf16_t* KDT, const bf16_t* AT, const float* CD) {
    ScanRs r; r.w = __builtin_amdgcn_make_buffer_rsrc((void*)Wb, 0, 0x7ffff000, 0x00020000); r.qd = __builtin_amdgcn_make_buffer_rsrc((void*)QD, 0, 0x7ffff000, 0x00020000);
    r.kdt = __builtin_amdgcn_make_buffer_rsrc((void*)KDT, 0, 0x7ffff000, 0x00020000); r.at = __builtin_amdgcn_make_buffer_rsrc((void*)AT, 0, 0x7ffff000, 0x00020000);
    r.ut = __builtin_amdgcn_make_buffer_rsrc((void*)UT, 0, 0x7ffff000, 0x00020000); r.CD = CD; return r;
}
DI bf16x8 ld128(__amdgpu_buffer_rsrc_t rs, unsigned voff, unsigned soff) { return __builtin_bit_cast(bf16x8, __builtin_amdgcn_raw_buffer_load_b128(rs, voff, soff, 0)); }
DI void load_frag(Frag& f, const ScanRs& R, int un, int sl, int wave, unsigned vl16, unsigned vut) {
    const unsigned sw = (unsigned)((un * 16 + wave * 4) * 1024);
#pragma unroll
    for (int ks = 0; ks < 4; ++ks) { f.w[ks] = ld128(R.w, vl16, sw + ks * 1024); f.qd[ks] = ld128(R.qd, vl16, sw + ks * 1024); }
    const unsigned sa = (unsigned)((un * 8 + wave * 2) * 1024);
#pragma unroll
    for (int ks = 0; ks < 2; ++ks) f.at[ks] = ld128(R.at, vl16, sa + ks * 1024);
#pragma unroll
    for (int rb = 0; rb < 2; ++rb) { const unsigned sk = (unsigned)((un * 16 + (2 * wave + rb) * 2) * 1024);
#pragma unroll
        for (int ks = 0; ks < 2; ++ks) f.kd[rb][ks] = ld128(R.kdt, vl16, sk + ks * 1024); }
    f.u = __builtin_bit_cast(u32x2, __builtin_amdgcn_raw_buffer_load_b64(R.ut, vut, (unsigned)(((un * 128 + 16 * sl) * 64 + 16 * wave) * 2), 0));
    f.cd = R.CD[un];
}
DI void scan_step(LAS unsigned char* lds, const Frag& cur, f32x4& S0, f32x4& S1, __amdgpu_buffer_rsrc_t ro, unsigned vo, int n, int b, int h, int sl, int wave, int e, int kc) {
    f32x4 oq = (f32x4){0.f, 0.f, 0.f, 0.f};
    {
        f32x4 ws = (f32x4){0.f, 0.f, 0.f, 0.f};
#pragma unroll
        for (int ks = 0; ks < 4; ++ks) { const bf16x8 sb = *(const LAS bf16x8*)(lds + ST_OFF + e * ST_ROWB + (32 * ks + 8 * kc) * 2);
            ws = __builtin_amdgcn_mfma_f32_16x16x32_bf16(cur.w[ks], sb, ws, 0, 0, 0);
            oq = __builtin_amdgcn_mfma_f32_16x16x32_bf16(cur.qd[ks], sb, oq, 0, 0, 0); }
        const float v0 = bflo(cur.u.x) - ws[0], v1 = bfhi(cur.u.x) - ws[1], v2 = bflo(cur.u.y) - ws[2], v3 = bfhi(cur.u.y) - ws[3];
        u32x2 vw; vw.x = pk2(v0, v1); vw.y = pk2(v2, v3);
        *(LAS u32x2*)(lds + VN_OFF + e * VN_ROWB + (16 * wave + 4 * kc) * 2) = vw;
    }
    lds_barrier();
    {
        bf16x8 vb[2];
#pragma unroll
        for (int ks = 0; ks < 2; ++ks) vb[ks] = *(const LAS bf16x8*)(lds + VN_OFF + e * VN_ROWB + (32 * ks + 8 * kc) * 2);
#pragma unroll
        for (int ks = 0; ks < 2; ++ks) oq = __builtin_amdgcn_mfma_f32_16x16x32_bf16(cur.at[ks], vb[ks], oq, 0, 0, 0);
        const unsigned so = (unsigned)((((b * SEQ + 64 * n + 16 * wave) * 512) + h * 128 + 16 * sl) * 4);
#pragma unroll
        for (int i = 0; i < 4; ++i) __builtin_amdgcn_raw_buffer_store_b32(__float_as_uint(oq[i]), ro, vo + i * 2048, so, 0);
        S0 = S0 * cur.cd; S1 = S1 * cur.cd;
#pragma unroll
        for (int ks = 0; ks < 2; ++ks) { S0 = __builtin_amdgcn_mfma_f32_16x16x32_bf16(cur.kd[0][ks], vb[ks], S0, 0, 0, 0); S1 = __builtin_amdgcn_mfma_f32_16x16x32_bf16(cur.kd[1][ks], vb[ks], S1, 0, 0, 0); }
        u32x2 s0w, s1w; s0w.x = pk2(S0[0], S0[1]); s0w.y = pk2(S0[2], S0[3]); s1w.x = pk2(S1[0], S1[1]); s1w.y = pk2(S1[2], S1[3]);
        *(LAS u32x2*)(lds + ST_OFF + e * ST_ROWB + (32 * wave + 4 * kc) * 2) = s0w;
        *(LAS u32x2*)(lds + ST_OFF + e * ST_ROWB + (32 * wave + 16 + 4 * kc) * 2) = s1w;
    }
    lds_barrier();
}
DI void scan_unit(LAS unsigned char* lds, const bf16_t* UT, const bf16_t* Wb, const bf16_t* QD, const bf16_t* KDT, const bf16_t* AT, const float* CD, float* ORAW,
                  int bh, int sl, int tid, int wave, int lane) {
    static_assert(NCHUNK == 32, "the trip structure below is 10 x 3 + 2 steps");
    const int e = lane & 15, kc = lane >> 4, b = bh >> 2, h = bh & 3;
    for (int i = tid; i < SCAN_LDS / 4; i += 256) ((LAS unsigned*)lds)[i] = 0u;
    f32x4 S0 = (f32x4){0.f, 0.f, 0.f, 0.f}, S1 = S0;
    const ScanRs R = scan_rs(UT, Wb, QD, KDT, AT, CD);
    const __amdgpu_buffer_rsrc_t ro = __builtin_amdgcn_make_buffer_rsrc((void*)ORAW, 0, 0x7ffff000, 0x00020000);
    const unsigned vl16 = (unsigned)lane * 16u, vut = (unsigned)((e * 64 + 4 * kc) * 2), vo = (unsigned)((4 * kc * 512 + e) * 4);
    Frag f0, f1, f2;
    load_frag(f0, R, bh * 32, sl, wave, vl16, vut); load_frag(f1, R, bh * 32 + 1, sl, wave, vl16, vut);
    lds_barrier();
#pragma unroll 1
    for (int n = 0; n < 30; n += 3) {
        load_frag(f2, R, bh * 32 + n + 2, sl, wave, vl16, vut);
        scan_step(lds, f0, S0, S1, ro, vo, n, b, h, sl, wave, e, kc);
        load_frag(f0, R, bh * 32 + n + 3, sl, wave, vl16, vut);
        scan_step(lds, f1, S0, S1, ro, vo, n + 1, b, h, sl, wave, e, kc);
        load_frag(f1, R, bh * 32 + n + 4, sl, wave, vl16, vut);
        scan_step(lds, f2, S0, S1, ro, vo, n + 2, b, h, sl, wave, e, kc);
    }
    scan_step(lds, f0, S0, S1, ro, vo, 30, b, h, sl, wave, e, kc);
    scan_step(lds, f1, S0, S1, ro, vo, 31, b, h, sl, wave, e, kc);
}
}
constexpr int NWAVES = 8;
constexpr int RING_OFF = 0, RING_BYTES = 155648;
constexpr int LDSCTL_OFF = RING_BYTES, MISC_OFF = LDSCTL_OFF + 320;
constexpr int LDS_BYTES = 163840;

struct Frame {
    LAS unsigned char* lds;
    int tid, lane, wave;
    int vcu, G;
};

struct Args {
    const float* in[25]; float* out; unsigned char* ws;
    int ph_lo, ph_hi, flags, pad;
};
typedef const __attribute__((address_space(4))) Args* KArgs;

enum { WJ_PLAIN = 0, WJ_IN = 1, WJ_KV = 2, WJ_GLU = 3 };
struct WJob { const float* W; const float* W2; const float* gain; bf16_t* dst; int ldw, K, type, nblk; int fp8; unsigned* cmax; };
DI void wjob_src(const WJob& J, int db, const float*& src, int& scol, int& nvalid) {
    src = J.W; scol = 32 * db; nvalid = 32;
    if (J.type == WJ_IN) {
        if (db < 64) scol = 32 * db;
        else if (db < 76) scol = WC_CQ + 32 * (db - 64);
        else if (db < 84) scol = WC_CKV + 32 * (db - 76);
        else if (db == 84) scol = WC_KR;
        else if (db == 85) { scol = WC_A; nvalid = 8; }
        else if (db < 88) { scol = 0; nvalid = 0; }
        else { const int d2 = db - 88, j = d2 >> 3, w = d2 & 7;
               scol = WC_GATE + (w < 4 ? 0 : 1024) + j * 128 + 32 * (w & 3); }
    } else if (J.type == WJ_KV) {
        if (db < 16) scol = (db >> 1) * 128 + 32 * (db & 1);
        else scol = ((db - 16) >> 1) * 128 + 64 + 32 * (db & 1);
    } else if (J.type == WJ_GLU) {
        const int j = db >> 3, w = db & 7;
        if (w < 4) scol = j * 128 + 32 * w; else { src = J.W2; scol = j * 128 + 32 * (w - 4); }
    }
}
DI void wjob_absmax_item(const WJob& J, int item, int lane) {
    const int nkb = J.K >> 6; const int db = item / nkb, kb = item - db * nkb, k0 = kb << 6;
    const float* src; int scol, nvalid; wjob_src(J, db, src, scol, nvalid);
    const int n4 = (lane & 7) * 4, kr = lane >> 3;
    if (nvalid == 0) return;
    f32x4 mx = (f32x4){0.f, 0.f, 0.f, 0.f};
    if (n4 < nvalid) {
#pragma unroll
        for (int i = 0; i < 8; ++i) { const f32x4 v = *(const GAS f32x4*)(src + (size_t)(k0 + kr + 8 * i) * J.ldw + scol + n4);
            mx.x = fmaxf(mx.x, fabsf(v.x)); mx.y = fmaxf(mx.y, fabsf(v.y)); mx.z = fmaxf(mx.z, fabsf(v.z)); mx.w = fmaxf(mx.w, fabsf(v.w)); }
    }
#pragma unroll
    for (int e = 0; e < 4; ++e) { float t = mx[e]; t = fmaxf(t, swz_xor<8>(t)); t = fmaxf(t, swz_xor<16>(t));
        const auto rr = __builtin_amdgcn_permlane32_swap(__float_as_uint(t), __float_as_uint(t), false, false); mx[e] = fmaxf(__uint_as_float(rr[0]), __uint_as_float(rr[1])); }
    if (lane < 8) {
#pragma unroll
        for (int e = 0; e < 4; ++e) __hip_atomic_fetch_max(J.cmax + 32 * db + n4 + e, __float_as_uint(mx[e]), RLX_AGENT);
    }
}
DI void wjob_absmax_run(const WJob& J, int& base, int gw, int NGW, int lane) {
    const int nitems = J.nblk * (J.K >> 6);
    int it = gw - (base % NGW); if (it < 0) it += NGW;
    for (; it < nitems; it += NGW) wjob_absmax_item(J, it, lane);
    base += nitems;
}
DI void wjob_load(const WJob& J, int item, int lane, f32x4 (&v)[8]) {
    const int nkb = J.K >> 6; const int db = item / nkb, kb = item - db * nkb, k0 = kb << 6;
    const float* src; int scol, nvalid; wjob_src(J, db, src, scol, nvalid);
    const int n4 = (lane & 7) * 4, kr = lane >> 3;
    const bool nin = n4 < nvalid;
#pragma unroll
    for (int i = 0; i < 8; ++i) { v[i] = (f32x4){0.f, 0.f, 0.f, 0.f}; if (nin) v[i] = __builtin_nontemporal_load((const GAS f32x4*)(src + (size_t)(k0 + kr + 8 * i) * J.ldw + scol + n4)); }
}
DI void wjob_fin1(const WJob& J, int item, LAS float* scr, int lane, const f32x4 (&v)[8]) {
    const int nkb = J.K >> 6; const int db = item / nkb, kb = item - db * nkb, k0 = kb << 6;
    const int n4 = (lane & 7) * 4, kr = lane >> 3;
#pragma unroll
    for (int i = 0; i < 8; ++i) { const int kk = kr + 8 * i; f32x4 t = v[i];
        if (J.gain) t = t * J.gain[k0 + kk];
        LAS float* d = scr + kk * 33 + n4;
        d[0] = t.x; d[1] = t.y; d[2] = t.z; d[3] = t.w; }
}
DI void wjob_fin2(const WJob& J, int item, LAS float* scr, int lane, const float (&inv)[4]) {
    const int nkb = J.K >> 6; const int db = item / nkb, kb = item - db * nkb, k0 = kb << 6;
    const int c = lane & 7;
#pragma unroll
    for (int j = 0; j < 4; ++j) { const int nn = (lane >> 3) + 8 * j; const LAS float* s = scr + (8 * c) * 33 + nn;
        if (J.fp8 == 2) {
            unsigned w0 = 0u, w1 = 0u;
#pragma unroll
            for (int i = 0; i < 4; ++i) { w0 = __builtin_amdgcn_cvt_pk_u8_f32(__builtin_rintf(s[i * 33] * inv[j]) + 128.f, i, w0); w1 = __builtin_amdgcn_cvt_pk_u8_f32(__builtin_rintf(s[(i + 4) * 33] * inv[j]) + 128.f, i, w1); }
            u32x2 o; o.x = w0 ^ 0x80808080u; o.y = w1 ^ 0x80808080u;
            *(GAS u32x2*)((unsigned char*)J.dst + (size_t)(32 * db + nn) * J.K + k0 + 8 * c) = o;
        } else if (J.fp8) {
            float q[8];
#pragma unroll
            for (int i = 0; i < 8; ++i) q[i] = __builtin_amdgcn_fmed3f(s[i * 33] * W8_SCALE, -448.f, 448.f);
            unsigned w0 = __builtin_amdgcn_cvt_pk_fp8_f32(q[0], q[1], 0, false); w0 = __builtin_amdgcn_cvt_pk_fp8_f32(q[2], q[3], w0, true);
            unsigned w1 = __builtin_amdgcn_cvt_pk_fp8_f32(q[4], q[5], 0, false); w1 = __builtin_amdgcn_cvt_pk_fp8_f32(q[6], q[7], w1, true);
            u32x2 o; o.x = w0; o.y = w1;
            *(GAS u32x2*)((unsigned char*)J.dst + (size_t)(32 * db + nn) * J.K + k0 + 8 * c) = o;
        } else {
        u32x4 o; o.x = pk2(s[0 * 33], s[1 * 33]); o.y = pk2(s[2 * 33], s[3 * 33]); o.z = pk2(s[4 * 33], s[5 * 33]); o.w = pk2(s[6 * 33], s[7 * 33]);
        *(GAS u32x4*)(J.dst + (size_t)(32 * db + nn) * J.K + k0 + 8 * c) = o; } }
}
DI void wjob_item(const WJob& J, int item, LAS float* scr, int lane) {
    f32x4 v[8]; wjob_load(J, item, lane, v);
    float inv[4] = {0.f, 0.f, 0.f, 0.f};
    if (J.fp8 == 2) { const int db = item / (J.K >> 6);
#pragma unroll
        for (int j = 0; j < 4; ++j) { const float cm = __uint_as_float(__hip_atomic_load(J.cmax + 32 * db + (lane >> 3) + 8 * j, RLX_AGENT)); inv[j] = cm > 0.f ? 127.f / cm : 0.f; } }
    wjob_fin1(J, item, scr, lane, v);
    LDS_WAIT(); asm volatile("" ::: "memory");
    wjob_fin2(J, item, scr, lane, inv);
    LDS_WAIT(); asm volatile("" ::: "memory");
}
DI void wjob_run(const WJob& J, int& base, int gw, int NGW, LAS float* scr, int lane) {
    const int nitems = J.nblk * (J.K >> 6);
    int it = gw - (base % NGW); if (it < 0) it += NGW;
    for (; it < nitems; it += NGW) wjob_item(J, it, scr, lane);
    base += nitems;
}

DI void dec_proj(KArgs ap, unsigned char* ws, int l, int idx, WJob& J, int& item) {
    if (idx < 256) { J = WJob{ap->in[9] + (size_t)l * 512 * D, nullptr, nullptr, (bf16_t*)(ws + WS_WGDNO + l * MiB), D, 512, WJ_PLAIN, 32, 0, nullptr}; item = idx; }
    else if (idx < 512) { J = WJob{ap->in[14] + (size_t)l * 512 * D, nullptr, nullptr, (bf16_t*)(ws + WS_WMLAO + l * MiB), D, 512, WJ_PLAIN, 32, 0, nullptr}; item = idx - 256; }
    else { J = WJob{ap->in[15] + (size_t)l * D * D, nullptr, nullptr, (bf16_t*)(ws + WS_WOUT + l * 2 * MiB), D, 1024, WJ_PLAIN, 32, 0, nullptr}; item = idx - 512; }
}
DI void dec_qkv(KArgs ap, unsigned char* ws, int l, int idx, WJob& J, int& item) {
    if (idx < 144) { J = WJob{ap->in[11] + (size_t)l * 384 * 768, nullptr, ap->in[10] + l * 384, (bf16_t*)(ws + WS_WQB + l * 768 * KiB), 768, 384, WJ_PLAIN, 24, 0, nullptr}; item = idx; }
    else { J = WJob{ap->in[13] + (size_t)l * 256 * 1024, nullptr, ap->in[12] + l * 256, (bf16_t*)(ws + WS_WKVB + l * 512 * KiB), 1024, 256, WJ_KV, 32, 0, nullptr}; item = idx - 144; }
}
constexpr int NPROJ_ITEMS = 1024, NQKV_ITEMS = 272, NCONV_L0 = NPROJ_ITEMS + 32 * (D_FF / 64);
constexpr int MOE_ITEMS_E = (2 * DFE / 32) * 16 + 32 * (DFE / 64), MOE_ITEMS = NE * MOE_ITEMS_E;
DI void dec_moe(KArgs ap, unsigned char* ws, int idx, WJob& J, int& item) {
    const int e = idx / MOE_ITEMS_E, r = idx - e * MOE_ITEMS_E;
    if (r < (2 * DFE / 32) * 16) { J = WJob{ap->in[21] + (size_t)e * D * DFE, ap->in[22] + (size_t)e * D * DFE, nullptr, (bf16_t*)((unsigned char*)ap->out + e * (7 * MiB / 2)), DFE, 1024, WJ_GLU, 2 * DFE / 32, 1, nullptr}; item = r; }
    else { J = WJob{ap->in[23] + (size_t)e * DFE * D, nullptr, nullptr, (bf16_t*)(ws + WS_WM2 + e * (7 * MiB / 4)), D, DFE, WJ_PLAIN, 32, 1, nullptr}; item = r - (2 * DFE / 32) * 16; }
}
DI void conv_dec(KArgs ap, unsigned char* ws, int mode, int idx, WJob& J, int& item) {
    if (mode == 2) dec_moe(ap, ws, idx, J, item);
    else if (idx < NPROJ_ITEMS) dec_proj(ap, ws, 1, idx, J, item);
    else { J = WJob{ap->in[19], nullptr, nullptr, (bf16_t*)(ws + WS_WD2), D, D_FF, WJ_PLAIN, 32, DENSE_DN_FP8, nullptr}; item = idx - NPROJ_ITEMS; }
}
#define CONV_BAR0() do { asm volatile("s_waitcnt lgkmcnt(0)" ::: "memory"); __builtin_amdgcn_s_barrier(); asm volatile("" ::: "memory"); } while (0)
constexpr unsigned OOB = 0x80000000u;
DI void cjob_load(const WJob& J, int item, bool valid, int lane, f32x4 (&v)[8]) {
    const int nkb = J.K >> 6; const int db = item / nkb, kb = item - db * nkb, k0 = kb << 6;
    const float* src; int scol, nvalid; wjob_src(J, db, src, scol, nvalid);
    const __amdgpu_buffer_rsrc_t rs = __builtin_amdgcn_make_buffer_rsrc((void*)src, 0, 0x7ffff000, 0x00020000);
    const int n4 = (lane & 7) * 4, kr = lane >> 3;
    const unsigned bad = (valid && n4 < nvalid) ? 0u : OOB;
#pragma unroll
    for (int i = 0; i < 8; ++i) v[i] = __builtin_bit_cast(f32x4, __builtin_amdgcn_raw_buffer_load_b128(rs, (unsigned)(((k0 + kr + 8 * i) * J.ldw + scol + n4) * 4) | bad, 0, 2));
}
DI void cjob_fin1(LAS float* scr, int lane, const f32x4 (&v)[8]) {
    const int n4 = (lane & 7) * 4, kr = lane >> 3;
#pragma unroll
    for (int i = 0; i < 8; ++i) { LAS float* d = scr + (kr + 8 * i) * 33 + n4; d[0] = v[i].x; d[1] = v[i].y; d[2] = v[i].z; d[3] = v[i].w; }
}
DI void cjob_fin2(const WJob& J, int item, bool valid, LAS float* scr, int lane, const float (&inv)[4]) {
    const int nkb = J.K >> 6; const int db = item / nkb, kb = item - db * nkb, k0 = kb << 6;
    const int c = lane & 7;
    const __amdgpu_buffer_rsrc_t rd = __builtin_amdgcn_make_buffer_rsrc((void*)J.dst, 0, 0x7ffff000, 0x00020000);
    const unsigned bad = valid ? 0u : OOB;
#pragma unroll
    for (int j = 0; j < 4; ++j) { const int nn = (lane >> 3) + 8 * j; const LAS float* s = scr + (8 * c) * 33 + nn;
        if (J.fp8 == 2) {
            unsigned w0 = 0u, w1 = 0u;
#pragma unroll
            for (int i = 0; i < 4; ++i) { w0 = __builtin_amdgcn_cvt_pk_u8_f32(__builtin_rintf(s[i * 33] * inv[j]) + 128.f, i, w0); w1 = __builtin_amdgcn_cvt_pk_u8_f32(__builtin_rintf(s[(i + 4) * 33] * inv[j]) + 128.f, i, w1); }
            u32x2 o; o.x = w0 ^ 0x80808080u; o.y = w1 ^ 0x80808080u;
            __builtin_amdgcn_raw_buffer_store_b64(o, rd, (unsigned)((32 * db + nn) * J.K + k0 + 8 * c) | bad, 0, 2);
        } else if (J.fp8) {
            float q[8];
#pragma unroll
            for (int i = 0; i < 8; ++i) q[i] = __builtin_amdgcn_fmed3f(s[i * 33] * W8_SCALE, -448.f, 448.f);
            unsigned w0 = __builtin_amdgcn_cvt_pk_fp8_f32(q[0], q[1], 0, false); w0 = __builtin_amdgcn_cvt_pk_fp8_f32(q[2], q[3], w0, true);
            unsigned w1 = __builtin_amdgcn_cvt_pk_fp8_f32(q[4], q[5], 0, false); w1 = __builtin_amdgcn_cvt_pk_fp8_f32(q[6], q[7], w1, true);
            u32x2 o; o.x = w0; o.y = w1;
            __builtin_amdgcn_raw_buffer_store_b64(o, rd, (unsigned)((32 * db + nn) * J.K + k0 + 8 * c) | bad, 0, 2);
        } else {
            u32x4 o; o.x = pk2(s[0 * 33], s[1 * 33]); o.y = pk2(s[2 * 33], s[3 * 33]); o.z = pk2(s[4 * 33], s[5 * 33]); o.w = pk2(s[6 * 33], s[7 * 33]);
            __builtin_amdgcn_raw_buffer_store_b128(o, rd, (unsigned)(((32 * db + nn) * J.K + k0 + 8 * c) * 2) | bad, 0, 2); } }
}
DI void cjob_pad_stores(unsigned char* ws, int lane) {
    const __amdgpu_buffer_rsrc_t rd = __builtin_amdgcn_make_buffer_rsrc((void*)ws, 0, 0x7ffff000, 0x00020000);
    u32x2 z; z.x = (unsigned)lane; z.y = (unsigned)lane;
#pragma unroll
    for (int j = 0; j < 4; ++j) __builtin_amdgcn_raw_buffer_store_b64(z, rd, OOB, 0, 0);
}
DI void conv_stream(KArgs ap, unsigned char* ws, int mode, int first, int stride, int total, int nbar, LAS float* scr, int lane) {
    f32x4 va[8], vb[8]; WJob J; int item; const float inv0[4] = {0.f, 0.f, 0.f, 0.f};
    int pa = first, pb2 = first + stride, nxt = first + 2 * stride;
    conv_dec(ap, ws, mode, pa < total ? pa : 0, J, item); cjob_load(J, item, pa < total, lane, va); cjob_pad_stores(ws, lane);
    conv_dec(ap, ws, mode, pb2 < total ? pb2 : 0, J, item); cjob_load(J, item, pb2 < total, lane, vb); cjob_pad_stores(ws, lane);
    int step = 0;
    if (nbar > 0) CONV_BAR0();
#pragma unroll 1
    for (;;) {
        const bool paced = nbar > 0 && step < NCHUNK;
        if (!paced && pa >= total) break;
        { const int pc = pa; WJob Jc; int ic;
          conv_dec(ap, ws, mode, pc < total ? pc : 0, Jc, ic); cjob_fin1(scr, lane, va);
          pa = nxt; nxt += stride; conv_dec(ap, ws, mode, pa < total ? pa : 0, J, item); cjob_load(J, item, pa < total, lane, va);
          if (paced) lds_barrier(); else { LDS_WAIT(); asm volatile("" ::: "memory"); }
          cjob_fin2(Jc, ic, pc < total, scr, lane, inv0);
          if (paced) lds_barrier(); else { LDS_WAIT(); asm volatile("" ::: "memory"); } }
        { const int pc = pb2; WJob Jc; int ic;
          conv_dec(ap, ws, mode, pc < total ? pc : 0, Jc, ic); cjob_fin1(scr, lane, vb);
          pb2 = nxt; nxt += stride; conv_dec(ap, ws, mode, pb2 < total ? pb2 : 0, J, item); cjob_load(J, item, pb2 < total, lane, vb);
          if (paced) lds_barrier(); else { LDS_WAIT(); asm volatile("" ::: "memory"); }
          cjob_fin2(Jc, ic, pc < total, scr, lane, inv0);
          if (paced) lds_barrier(); else { LDS_WAIT(); asm volatile("" ::: "memory"); } }
        step += 2;
    }
#pragma unroll 1
    for (int u = 1; u < nbar; ++u) { CONV_BAR0();
#pragma unroll 1
        for (int n = 0; n < 2 * NCHUNK; ++n) lds_barrier(); }
}
DI void absmax_acc(f32x4& mx, const f32x4 (&v)[8]) {
#pragma unroll
    for (int i = 0; i < 8; ++i) { mx.x = fmaxf(mx.x, fabsf(v[i].x)); mx.y = fmaxf(mx.y, fabsf(v[i].y)); mx.z = fmaxf(mx.z, fabsf(v[i].z)); mx.w = fmaxf(mx.w, fabsf(v[i].w)); }
}
DI void conv_i8_block(const WJob& J, int db, bool bars, LAS float* scr, int lane) {
    f32x4 va[8], vb[8]; f32x4 mx = (f32x4){0.f, 0.f, 0.f, 0.f};
    cjob_load(J, db * 16, true, lane, va); cjob_load(J, db * 16 + 1, true, lane, vb);
    if (bars) CONV_BAR0();
#pragma unroll 1
    for (int kb = 0; kb < 16; kb += 2) {
        absmax_acc(mx, va); cjob_load(J, db * 16 + ((kb + 2) & 15), true, lane, va);
        if (bars) { lds_barrier(); lds_barrier(); }
        absmax_acc(mx, vb); cjob_load(J, db * 16 + ((kb + 3) & 15), true, lane, vb);
        if (bars) { lds_barrier(); lds_barrier(); }
    }
#pragma unroll
    for (int e = 0; e < 4; ++e) { float t = mx[e]; t = fmaxf(t, swz_xor<8>(t)); t = fmaxf(t, swz_xor<16>(t));
        const auto rr = __builtin_amdgcn_permlane32_swap(__float_as_uint(t), __float_as_uint(t), false, false); mx[e] = fmaxf(__uint_as_float(rr[0]), __uint_as_float(rr[1])); }
    if (lane < 8) {
#pragma unroll
        for (int e = 0; e < 4; ++e) { J.cmax[32 * db + 4 * lane + e] = __float_as_uint(mx[e]); scr[2112 + 4 * lane + e] = mx[e]; } }
    LDS_WAIT(); asm volatile("" ::: "memory");
    float inv[4];
#pragma unroll
    for (int j = 0; j < 4; ++j) { const float cm = scr[2112 + (lane >> 3) + 8 * j]; inv[j] = cm > 0.f ? 127.f / cm : 0.f; }
#pragma unroll 1
    for (int kb = 0; kb < 16; kb += 2) {
        cjob_fin1(scr, lane, va); cjob_load(J, db * 16 + ((kb + 2) & 15), kb + 2 < 16, lane, va);
        if (bars) lds_barrier(); else { LDS_WAIT(); asm volatile("" ::: "memory"); }
        cjob_fin2(J, db * 16 + kb, true, scr, lane, inv);
        if (bars) lds_barrier(); else { LDS_WAIT(); asm volatile("" ::: "memory"); }
        cjob_fin1(scr, lane, vb); cjob_load(J, db * 16 + ((kb + 3) & 15), kb + 3 < 16, lane, vb);
        if (bars) lds_barrier(); else { LDS_WAIT(); asm volatile("" ::: "memory"); }
        cjob_fin2(J, db * 16 + kb + 1, true, scr, lane, inv);
        if (bars) lds_barrier(); else { LDS_WAIT(); asm volatile("" ::: "memory"); }
    }
}
constexpr int NI8_L1 = NPROJ / 32, NI8_BLOCKS = NPROJ / 32 + 2 * D_FF / 32;
DI void conv_i8_job(KArgs ap, unsigned char* ws, int b, WJob& J, int& db) {
    unsigned* cmx = (unsigned*)(ws + WS_CTL) + CW_CMAX;
    if (b < NI8_L1) { J = WJob{ap->in[3] + (size_t)D * IN_COLS, nullptr, nullptr, (bf16_t*)(ws + WS_WIN + WIN_STRIDE), IN_COLS, 1024, WJ_IN, NPROJ / 32, 2, cmx + NPROJ}; db = b; }
    else { J = WJob{ap->in[17], ap->in[18], nullptr, (bf16_t*)(ws + WS_WD13), D_FF, 1024, WJ_GLU, 2 * D_FF / 32, 2, cmx + 2 * NPROJ}; db = b - NI8_L1; }
}
DI void scan_converter(KArgs ap, unsigned char* ws, int l, int cw, int NCW, int nun, LAS float* scr, int lane) {
    int nb = nun;
    if (l == 0) {
        const bool split = NCW >= NI8_BLOCKS + 64;
#pragma unroll 1
        for (int b = cw; b < NI8_BLOCKS; b += NCW) { WJob J; int db; conv_i8_job(ap, ws, b, J, db); conv_i8_block(J, db, nb > 0, scr, lane); if (nb > 0) --nb; }
        if (split) { if (cw >= NI8_BLOCKS) conv_stream(ap, ws, 1, cw - NI8_BLOCKS, NCW - NI8_BLOCKS, NCONV_L0, nb, scr, lane); else conv_stream(ap, ws, 1, 0, 1, 0, nb, scr, lane); }
        else conv_stream(ap, ws, 1, cw, NCW, NCONV_L0, nb, scr, lane);
    } else conv_stream(ap, ws, 2, cw, NCW, MOE_ITEMS, nb, scr, lane);
}

DI float rms_row_load(const float* xrow, const float* gain, int lane, f32x4 (&v)[4]) {
    const GAS f32x4* xr = (const GAS f32x4*)xrow + lane;
    float ss = 0.f;
#pragma unroll
    for (int j = 0; j < 4; ++j) { v[j] = xr[64 * j]; ss += (v[j].x * v[j].x + v[j].y * v[j].y) + (v[j].z * v[j].z + v[j].w * v[j].w); }
    ss = wave_sum(ss);
    const float rstd = rsqrtf(ss * (1.f / D) + EPS);
    const GAS f32x4* gr = (const GAS f32x4*)gain + lane;
#pragma unroll
    for (int j = 0; j < 4; ++j) v[j] = v[j] * gr[64 * j] * rstd;
    return rstd;
}
DI float rms_row_load_b(const bf16_t* xrow, const float* gain, int lane, f32x4 (&v)[4]) {
    const GAS u32x2* xr = (const GAS u32x2*)xrow + lane;
    float ss = 0.f;
#pragma unroll
    for (int j = 0; j < 4; ++j) { const u32x2 w = xr[64 * j]; v[j] = (f32x4){bflo(w.x), bfhi(w.x), bflo(w.y), bfhi(w.y)}; ss += (v[j].x * v[j].x + v[j].y * v[j].y) + (v[j].z * v[j].z + v[j].w * v[j].w); }
    ss = wave_sum(ss);
    const float rstd = rsqrtf(ss * (1.f / D) + EPS);
    const GAS f32x4* gr = (const GAS f32x4*)gain + lane;
#pragma unroll
    for (int j = 0; j < 4; ++j) v[j] = v[j] * gr[64 * j] * rstd;
    return rstd;
}
DI void row_store_bf16(bf16_t* orow, int lane, const f32x4 (&v)[4]) {
    GAS u32x2* o8 = (GAS u32x2*)orow + lane;
#pragma unroll
    for (int j = 0; j < 4; ++j) { u32x2 w; w.x = pk2(v[j].x, v[j].y); w.y = pk2(v[j].z, v[j].w); o8[64 * j] = w; }
}
DI float wave_max(float v) {
    v = fmaxf(v, swz_xor<1>(v)); v = fmaxf(v, swz_xor<2>(v)); v = fmaxf(v, swz_xor<4>(v)); v = fmaxf(v, swz_xor<8>(v)); v = fmaxf(v, swz_xor<16>(v));
    const auto rr = __builtin_amdgcn_permlane32_swap(__float_as_uint(v), __float_as_uint(v), false, false); return fmaxf(__uint_as_float(rr[0]), __uint_as_float(rr[1]));
}
DI void row_store_i8(unsigned char* orow, float* srow, int lane, const f32x4 (&v)[4]) {
    float am = 0.f;
#pragma unroll
    for (int j = 0; j < 4; ++j) am = fmaxf(fmaxf(am, fmaxf(fabsf(v[j].x), fabsf(v[j].y))), fmaxf(fabsf(v[j].z), fabsf(v[j].w)));
    am = wave_max(am);
    const float inv = am > 0.f ? 127.f / am : 0.f;
    GAS unsigned* o = (GAS unsigned*)orow + lane;
#pragma unroll
    for (int j = 0; j < 4; ++j) { unsigned w = 0u;
        w = __builtin_amdgcn_cvt_pk_u8_f32(__builtin_rintf(v[j].x * inv) + 128.f, 0, w); w = __builtin_amdgcn_cvt_pk_u8_f32(__builtin_rintf(v[j].y * inv) + 128.f, 1, w);
        w = __builtin_amdgcn_cvt_pk_u8_f32(__builtin_rintf(v[j].z * inv) + 128.f, 2, w); w = __builtin_amdgcn_cvt_pk_u8_f32(__builtin_rintf(v[j].w * inv) + 128.f, 3, w);
        o[64 * j] = w ^ 0x80808080u; }
    if (lane == 0) *srow = am * (1.f / 127.f);
}
DI void row_issue_b(const bf16_t* xrow, int lane, u32x2 (&w)[4]) { const GAS u32x2* xr = (const GAS u32x2*)xrow + lane;
#pragma unroll
    for (int j = 0; j < 4; ++j) w[j] = xr[64 * j]; }
DI void row_issue_f(const float* xrow, int lane, f32x4 (&w)[4]) { const GAS f32x4* xr = (const GAS f32x4*)xrow + lane;
#pragma unroll
    for (int j = 0; j < 4; ++j) w[j] = __builtin_nontemporal_load(xr + 64 * j); }
DI void row_norm_b(const u32x2 (&w)[4], const f32x4 (&g)[4], f32x4 (&v)[4]) {
    float ss = 0.f;
#pragma unroll
    for (int j = 0; j < 4; ++j) { v[j] = (f32x4){bflo(w[j].x), bfhi(w[j].x), bflo(w[j].y), bfhi(w[j].y)}; ss += (v[j].x * v[j].x + v[j].y * v[j].y) + (v[j].z * v[j].z + v[j].w * v[j].w); }
    ss = wave_sum(ss); const float rstd = rsqrtf(ss * (1.f / D) + EPS);
#pragma unroll
    for (int j = 0; j < 4; ++j) v[j] = v[j] * g[j] * rstd;
}
DI void row_norm_f(const f32x4 (&w)[4], const f32x4 (&g)[4], f32x4 (&v)[4]) {
    float ss = 0.f;
#pragma unroll
    for (int j = 0; j < 4; ++j) { v[j] = w[j]; ss += (v[j].x * v[j].x + v[j].y * v[j].y) + (v[j].z * v[j].z + v[j].w * v[j].w); }
    ss = wave_sum(ss); const float rstd = rsqrtf(ss * (1.f / D) + EPS);
#pragma unroll
    for (int j = 0; j < 4; ++j) v[j] = v[j] * g[j] * rstd;
}
DI void norm_rows_i8(int gw, int NGW, int lane, const float* X, const float* gain, bf16_t* XN8, float* sA) {
    f32x4 g[4]; { const GAS f32x4* gr = (const GAS f32x4*)gain + lane;
#pragma unroll
        for (int j = 0; j < 4; ++j) g[j] = gr[64 * j]; }
    f32x4 wn[4];
#pragma unroll
    for (int j = 0; j < 4; ++j) wn[j] = (f32x4){0.f, 0.f, 0.f, 0.f};
    if (gw < M) row_issue_f(X + (size_t)gw * D, lane, wn);
#pragma unroll 1
    for (int m = gw; m < M; m += NGW) {
        f32x4 wc[4];
#pragma unroll
        for (int j = 0; j < 4; ++j) wc[j] = wn[j];
        asm volatile("" : "+v"(wc[0]), "+v"(wc[1]), "+v"(wc[2]), "+v"(wc[3]));
        if (m + NGW < M) row_issue_f(X + (size_t)(m + NGW) * D, lane, wn);
        f32x4 v[4]; row_norm_f(wc, g, v); row_store_i8((unsigned char*)XN8 + (size_t)m * D, sA + m, lane, v);
    }
}
DI void norm_rows_bi8(int gw, int NGW, int lane, const bf16_t* X, const float* gain, bf16_t* XN8, float* sA) {
    f32x4 g[4]; { const GAS f32x4* gr = (const GAS f32x4*)gain + lane;
#pragma unroll
        for (int j = 0; j < 4; ++j) g[j] = gr[64 * j]; }
    u32x2 wn[4];
#pragma unroll
    for (int j = 0; j < 4; ++j) wn[j] = (u32x2){0u, 0u};
    if (gw < M) row_issue_b(X + (size_t)gw * D, lane, wn);
#pragma unroll 1
    for (int m = gw; m < M; m += NGW) {
        u32x2 wc[4];
#pragma unroll
        for (int j = 0; j < 4; ++j) wc[j] = wn[j];
        asm volatile("" : "+v"(wc[0]), "+v"(wc[1]), "+v"(wc[2]), "+v"(wc[3]));
        if (m + NGW < M) row_issue_b(X + (size_t)(m + NGW) * D, lane, wn);
        f32x4 v[4]; row_norm_b(wc, g, v); row_store_i8((unsigned char*)XN8 + (size_t)m * D, sA + m, lane, v);
    }
}
DI void norm_rows_b8(int gw, int NGW, int lane, const bf16_t* X, const float* gain, bf16_t* XN8) {
    for (int m = gw; m < M; m += NGW) { f32x4 v[4]; rms_row_load_b(X + (size_t)m * D, gain, lane, v);
        GAS unsigned* o8 = (GAS unsigned*)((unsigned char*)XN8 + (size_t)m * D) + lane;
#pragma unroll
        for (int j = 0; j < 4; ++j) { const float c0 = __builtin_amdgcn_fmed3f(v[j].x, -448.f, 448.f), c1 = __builtin_amdgcn_fmed3f(v[j].y, -448.f, 448.f), c2 = __builtin_amdgcn_fmed3f(v[j].z, -448.f, 448.f), c3 = __builtin_amdgcn_fmed3f(v[j].w, -448.f, 448.f);
            unsigned w = __builtin_amdgcn_cvt_pk_fp8_f32(c0, c1, 0, false); w = __builtin_amdgcn_cvt_pk_fp8_f32(c2, c3, w, true); o8[64 * j] = w; } }
}
DI void norm_rows_b(int gw, int NGW, int lane, const bf16_t* X, const float* gain, bf16_t* XN) {
    for (int m = gw; m < M; m += NGW) { f32x4 v[4]; rms_row_load_b(X + (size_t)m * D, gain, lane, v); row_store_bf16(XN + (size_t)m * D, lane, v); }
}
DI void norm_rows(int gw, int NGW, int lane, const float* X, const float* gain, bf16_t* XN) {
    for (int m = gw; m < M; m += NGW) { f32x4 v[4]; rms_row_load(X + (size_t)m * D, gain, lane, v); row_store_bf16(XN + (size_t)m * D, lane, v); }
}

#ifdef PROBE_MFMA
typedef int i32x4 __attribute__((ext_vector_type(4)));
__device__ __noinline__ void mfma_rate_probe(unsigned* sink, int iters) {
    const int l = lane_id_asm();
    i32x4 a = (i32x4){l, l * 3, l * 5, l * 7}, b = (i32x4){l * 11, l * 13, l * 17, l * 19};
#if PROBE_MFMA == 2
    i32x4 acc[8];
#pragma unroll
    for (int i = 0; i < 8; ++i) acc[i] = (i32x4){0, 0, 0, 0};
#pragma unroll 1
    for (int it = 0; it < iters; ++it) {
#pragma unroll
        for (int i = 0; i < 8; ++i) acc[i] = __builtin_amdgcn_mfma_i32_16x16x64_i8(a, b, acc[i], 0, 0, 0);
        asm volatile("" : "+v"(a), "+v"(b));
    }
    int s = 0;
#pragma unroll
    for (int i = 0; i < 8; ++i) s += acc[i][0] + acc[i][1] + acc[i][2] + acc[i][3];
    if (s == 0x12345678) sink[l] = (unsigned)s;
#else
    f32x4 acc[8];
#pragma unroll
    for (int i = 0; i < 8; ++i) acc[i] = (f32x4){0.f, 0.f, 0.f, 0.f};
    bf16x8 a8 = __builtin_bit_cast(bf16x8, a), b8 = __builtin_bit_cast(bf16x8, b);
#pragma unroll 1
    for (int it = 0; it < iters; ++it) {
#pragma unroll
        for (int i = 0; i < 8; ++i) acc[i] = __builtin_amdgcn_mfma_f32_16x16x32_bf16(a8, b8, acc[i], 0, 0, 0);
        asm volatile("" : "+v"(a8), "+v"(b8));
    }
    float s = 0.f;
#pragma unroll
    for (int i = 0; i < 8; ++i) s += acc[i][0] + acc[i][1] + acc[i][2] + acc[i][3];
    if (s == 123.456f) sink[l] = __float_as_uint(s);
#endif
}
#endif
#define PHASE_BUFS \
    const float* x = ap->in[0]; const int* pos = (const int*)ap->in[1]; \
    const float* mix_norm = ap->in[2]; const float* w_in = ap->in[3]; const float* gate_bias = ap->in[4]; \
    const float* conv_w = ap->in[5]; const float* a_log = ap->in[6]; const float* dt_bias = ap->in[7]; const float* gdn_out_norm = ap->in[8]; \
    const float* w_gdn_o = ap->in[9]; const float* q_a_norm = ap->in[10]; \
    const float* w_q_b = ap->in[11]; const float* kv_a_norm = ap->in[12]; const float* w_kv_b = ap->in[13]; \
    const float* w_mla_o = ap->in[14]; const float* w_out = ap->in[15]; const float* ffn_norm = ap->in[16]; \
    const float* dense_w1 = ap->in[17]; const float* dense_w3 = ap->in[18]; const float* dense_w2 = ap->in[19]; \
    const float* router_w = ap->in[20]; const float* moe_w1 = ap->in[21]; const float* moe_w3 = ap->in[22]; \
    const float* moe_w2 = ap->in[23]; const float* final_norm = ap->in[24]; \
    float* X = ap->out; \
    bf16_t* GATE = (bf16_t*)(ws + WS_GATE); bf16_t* Zb = (bf16_t*)(ws + WS_Z); bf16_t* MISC = (bf16_t*)(ws + WS_MISC); bf16_t* QKV = (bf16_t*)(ws + WS_QKV); \
    bf16_t* Qb = (bf16_t*)(ws + WS_Q); bf16_t* Kb = (bf16_t*)(ws + WS_K); bf16_t* Vb = (bf16_t*)(ws + WS_V); bf16_t* AO = (bf16_t*)(ws + WS_AO); bf16_t* GO = (bf16_t*)(ws + WS_GO); \
    bf16_t* XN = (bf16_t*)((unsigned char*)ap->out + OUT_XN); bf16_t* MERGED = XN; bf16_t* XB = (bf16_t*)(ws + WS_XB); \
    bf16_t* HB = (bf16_t*)(ws + WS_HB); bf16_t* XG = (bf16_t*)(ws + WS_XG); bf16_t* Hm = (bf16_t*)(ws + WS_H); bf16_t* Yb = (bf16_t*)(ws + WS_Y); \
    float* ORAW = (float*)((unsigned char*)ap->out + OUT_XN); float* COS = (float*)(ws + WS_COS); float* SIN = (float*)(ws + WS_SIN); float* rstdq = (float*)(ws + WS_RSTD); float* rstdkv = rstdq + M; \
    int* topi = (int*)(ws + WS_MOE); float* topw = (float*)(topi + 2 * M); int* pairrow = (int*)(topw + 2 * M); int* list = pairrow + 2 * M; int* offs = list + NE * M; \
    unsigned* cnt = (unsigned*)(ws + WS_CTL) + CW_CNT; unsigned* cmx = (unsigned*)(ws + WS_CTL) + CW_CMAX; float* SAq = (float*)(ws + WS_SA);
__global__ void __launch_bounds__(NWAVES * 64, 2) mega_fwd(Args args) {
    extern __shared__ __attribute__((aligned(16))) unsigned char lds_raw[];
    Frame F;
    F.lds = (LAS unsigned char*)lds_raw;
    volatile LAS unsigned* MISCW = (volatile LAS unsigned*)(F.lds + MISC_OFF);
    F.tid = threadIdx.x; F.lane = F.tid & 63; F.wave = __builtin_amdgcn_readfirstlane(F.tid >> 6);
    F.G = gridDim.x; { const int bx = blockIdx.x; F.vcu = (F.G % 8 == 0) ? (bx % 8) * (F.G / 8) + bx / 8 : bx; }
    unsigned* ctl = (unsigned*)(args.ws + WS_CTL);
    for (int u = F.tid; u < (LDS_BYTES - LDSCTL_OFF) / 4; u += NWAVES * 64) ((LAS unsigned*)(F.lds + LDSCTL_OFF))[u] = 0u;
    __syncthreads();
    XcdBarrier bar = xcd_barrier_post(ctl + CW_BAR, MISCW + 8); bar.wave = F.wave;
    const int lo = args.ph_lo, hi = args.ph_hi;
#ifndef PROBE_LOCAL_X
#define PROBE_LOCAL_X 1
#endif
#ifndef PHASE_ENABLE
#define PHASE_ENABLE 0xFFFFFFF
#endif
#define P_ON(k) (((PHASE_ENABLE) >> (k)) & 1)
#define IN(k) (lo <= (k) && (k) < hi)
#define PHASE_BEGIN int pw = F.wave, pbx = (int)blockIdx.x, pG = F.G; asm volatile("" : "+s"(pw), "+s"(pbx), "+s"(pG)); int lane_ = lane_id_asm(); const int lane = lane_, tid = pw * 64 + lane_; (void)tid; const int gw = F.vcu * NWAVES + pw, NGW = F.G * NWAVES; (void)gw; (void)NGW; LAS float* scr = (LAS float*)(F.lds + RING_OFF + pw * 16384); (void)scr; KArgs ap = (KArgs)__builtin_amdgcn_kernarg_segment_ptr(); asm volatile("" : "+s"(ap)); unsigned char* ws = ap->ws; PHASE_BUFS
#define SEAM(k) do { if (IN(k) && IN((k) + 1)) xcd_barrier(bar); } while (0)


#ifdef PROBE_MFMA
    mfma_rate_probe((unsigned*)(args.ws + WS_END), 2000);
#endif
    if (IN(0) && P_ON(12)) { PHASE_BEGIN;
        WJob Jin{w_in, nullptr, nullptr, (bf16_t*)(ws + WS_WIN), IN_COLS, 1024, WJ_IN, NPROJ / 32, 2, cmx};
        const int nin = (NPROJ / 32) * 16;
        for (int i = gw; i < nin + NPROJ_ITEMS + 2 * NQKV_ITEMS; i += NGW) {
            if (i < nin) wjob_absmax_item(Jin, i, lane);
            else { WJob J; int item; const int r = i - nin;
                if (r < NPROJ_ITEMS) dec_proj(ap, ws, 0, r, J, item); else if (r < NPROJ_ITEMS + NQKV_ITEMS) dec_qkv(ap, ws, 0, r - NPROJ_ITEMS, J, item); else dec_qkv(ap, ws, 1, r - NPROJ_ITEMS - NQKV_ITEMS, J, item);
                wjob_item(J, item, scr, lane); }
        }
        for (int i = pbx * (NWAVES * 64) + tid; i < M * 16; i += pG * NWAVES * 64) {
            const int m = i >> 4, j = i & 15;
            const float ang = (float)pos[m] * powf(10000.f, -(float)j / 16.f);
            COS[i] = cosf(ang); SIN[i] = sinf(ang);
        }
    }
    if (IN(0)) xcd_barrier(bar);
    if (IN(0) && P_ON(12)) { PHASE_BEGIN;
        WJob Jin{w_in, nullptr, nullptr, (bf16_t*)(ws + WS_WIN), IN_COLS, 1024, WJ_IN, NPROJ / 32, 2, cmx};
        for (int i = gw; i < (NPROJ / 32) * 16; i += NGW) wjob_item(Jin, i, scr, lane);
        norm_rows_i8(gw, NGW, lane, x, mix_norm, XN, SAq);
    }
    SEAM(0);

#pragma unroll 1
    for (int l = 0; l < 2; ++l) {
        const int pb = 1 + 12 * l;
        if (IN(pb + 0) && P_ON(0)) { PHASE_BEGIN;
            pg8::Gemm g{XN, (const bf16_t*)(ws + WS_WIN + l * WIN_STRIDE), D, D, SAq, (const float*)(cmx + l * NPROJ)}; pg8::StaticOrder S; S.init(M, NPROJ, pG, pbx);
            pg8::EpiInProj E{QKV, Zb, MISC, GATE, gate_bias + l * 2048};
            pg8::gemm_phase<pg8::EpiInProj, pg8::StaticOrder, true, I8_INPROJ ? 2 : 0>(F.lds + RING_OFF, g, S, E, pw);
        }
        SEAM(pb + 0);
        if (IN(pb + 1) && P_ON(1)) { PHASE_BEGIN;
            bf16_t* UT = (bf16_t*)(ws + WS_UT); bf16_t* Wg = (bf16_t*)(ws + WS_W); bf16_t* QD = (bf16_t*)(ws + WS_QD); bf16_t* KDT = (bf16_t*)(ws + WS_KDT); bf16_t* ATb = (bf16_t*)(ws + WS_AT); float* CD = (float*)(ws + WS_CD);
            for (int up = F.vcu; up < 512; up += pG) gdn::local_pair(F.lds + RING_OFF, QKV, MISC, conv_w + l * 4 * 1536, a_log + l * 4, dt_bias + l * 4, UT, Wg, QD, KDT, ATb, CD, up, pw);
            if (!(args.flags & 2)) mla_prep_rows(gw, NGW, lane, MISC, rstdq, rstdkv);
        }
        SEAM(pb + 1);
        if (IN(pb + 2) && P_ON(2)) { PHASE_BEGIN;
            bf16_t* UT = (bf16_t*)(ws + WS_UT); bf16_t* Wg = (bf16_t*)(ws + WS_W); bf16_t* QD = (bf16_t*)(ws + WS_QD); bf16_t* KDT = (bf16_t*)(ws + WS_KDT); bf16_t* ATb = (bf16_t*)(ws + WS_AT); float* CD = (float*)(ws + WS_CD);
            if (pw < 4) { __builtin_amdgcn_s_setprio(3);
                for (int u = F.vcu; u < 256; u += pG) gdn::scan_unit(F.lds + RING_OFF, UT, Wg, QD, KDT, ATb, CD, ORAW, u >> 3, u & 7, tid, pw, lane);
                __builtin_amdgcn_s_setprio(0); }
            else scan_converter(ap, ws, l, (pw - 4) * pG + F.vcu, 4 * pG, F.vcu < 256 ? (256 - F.vcu + pG - 1) / pG : 0, scr, lane);
        }
        SEAM(pb + 2);
        if (IN(pb + 3) && P_ON(3)) { PHASE_BEGIN;
            mla_kpe_rows(gw, NGW, lane, MISC, COS, SIN, Kb);
            { pg8::Gemm g{MISC + MC_CQ, (const bf16_t*)(ws + WS_WQB + l * 768 * KiB), MISC_LD, 384}; pg8::StaticOrder S; S.init(M, 768, pG, pbx);
              pg8::EpiQRope E{Qb, rstdq, COS, SIN};
              pg8::gemm_phase<pg8::EpiQRope, pg8::StaticOrder, false>(F.lds + RING_OFF, g, S, E, pw); }
            { pg8::Gemm g{MISC + MC_CKV, (const bf16_t*)(ws + WS_WKVB + l * 512 * KiB), MISC_LD, 256}; pg8::StaticOrder S; S.init(M, 1024, pG, pbx);
              pg8::EpiKV E{Kb, Vb, rstdkv};
              pg8::gemm_phase<pg8::EpiKV, pg8::StaticOrder, false>(F.lds + RING_OFF, g, S, E, pw); }
        }
        SEAM(pb + 3);
        if (IN(pb + 4) && P_ON(4)) { PHASE_BEGIN;
            if (!(args.flags & 1)) {
                for (int u = F.vcu; u < 256; u += pG) {
                    const int bh = u >> 2, sp = u & 3, b = bh >> 3, h = bh & 7;
                    att::attn_unit(F.lds + RING_OFF, Qb, Kb, Vb, AO, b, h, 7 - sp, tid, pw, lane);
                    att::attn_unit(F.lds + RING_OFF, Qb, Kb, Vb, AO, b, h, sp, tid, pw, lane);
                }
            }
            if (!(args.flags & 2)) gdn_gate_rows(gw, NGW, lane, ORAW, Zb, gdn_out_norm + l * 128, GO);
        }
        SEAM(pb + 4);
        if (IN(pb + 5) && P_ON(5)) { PHASE_BEGIN;
            pg8::Gemm g{AO, (const bf16_t*)(ws + WS_WGDNO + l * MiB), 512, 512}; pg8::TwoSegOrder S;
            S.init(M, D, pG, pbx, (size_t)(WS_GO - WS_AO), (size_t)(WS_WMLAO - WS_WGDNO));
            pg8::EpiMerge2 E{MERGED, GATE};
            pg8::gemm_phase<pg8::EpiMerge2, pg8::TwoSegOrder, false>(F.lds + RING_OFF, g, S, E, pw);
        }
        SEAM(pb + 5);
        if (IN(pb + 6) && P_ON(6)) { PHASE_BEGIN;
            pg8::Gemm g{MERGED, (const bf16_t*)(ws + WS_WOUT + l * 2 * MiB), D, D}; pg8::StaticOrder S; S.init(M, D, pG, pbx);
            if (l == 0) { pg8::EpiResidB<true> E{x, XB, 1.f}; pg8::gemm_phase<pg8::EpiResidB<true>, pg8::StaticOrder, false>(F.lds + RING_OFF, g, S, E, pw); }
            else { pg8::EpiResidB<false> E{XB, XB, 1.f}; pg8::gemm_phase<pg8::EpiResidB<false>, pg8::StaticOrder, false>(F.lds + RING_OFF, g, S, E, pw); }
        }
        SEAM(pb + 6);
        if (IN(pb + 7) && P_ON(7)) { PHASE_BEGIN;
            if (l == 0) { if (I8_DUP) norm_rows_bi8(gw, NGW, lane, XB, ffn_norm, XN, SAq); else if (DENSE_UP_FP8) norm_rows_b8(gw, NGW, lane, XB, ffn_norm, XN); else norm_rows_b(gw, NGW, lane, XB, ffn_norm, XN); }
            else {
                __syncthreads();
                LAS unsigned* rbc = (LAS unsigned*)(F.lds + 131072);
                LAS int* rinfo = (LAS int*)(F.lds + 131072 + 64);
                if (tid < 16) rbc[tid] = 0u;
                __syncthreads();
                int nrow = 0;
                f32x4 gn[4]; { const GAS f32x4* gr = (const GAS f32x4*)(ffn_norm + D) + lane;
#pragma unroll
                    for (int j = 0; j < 4; ++j) gn[j] = gr[64 * j]; }
                u32x2 wc[4], wn[4];
#pragma unroll
                for (int j = 0; j < 4; ++j) { wc[j] = (u32x2){0u, 0u}; wn[j] = wc[j]; }
                if (gw < M) row_issue_b(XB + (size_t)gw * D, lane, wn);
                f32x4 rw[16][2];
#pragma unroll
                for (int j = 0; j < 4; ++j)
#pragma unroll
                    for (int i = 0; i < 4; ++i) { const float* rp = router_w + (size_t)(4 * (lane + 64 * j) + i) * NE; rw[4 * j + i][0] = *(const f32x4*)rp; rw[4 * j + i][1] = *(const f32x4*)(rp + 4); }
                for (int m = gw; m < M; m += NGW) {
#pragma unroll
                    for (int j = 0; j < 4; ++j) wc[j] = wn[j];
                    asm volatile("" : "+v"(wc[0]), "+v"(wc[1]), "+v"(wc[2]), "+v"(wc[3]));
                    if (m + NGW < M) row_issue_b(XB + (size_t)(m + NGW) * D, lane, wn);
                    f32x4 v[4]; row_norm_b(wc, gn, v);
                    { GAS unsigned* o8 = (GAS unsigned*)((unsigned char*)XN + (size_t)m * D) + lane;
#pragma unroll
                      for (int j = 0; j < 4; ++j) { const float c0 = __builtin_amdgcn_fmed3f(v[j].x, -448.f, 448.f), c1 = __builtin_amdgcn_fmed3f(v[j].y, -448.f, 448.f), c2 = __builtin_amdgcn_fmed3f(v[j].z, -448.f, 448.f), c3 = __builtin_amdgcn_fmed3f(v[j].w, -448.f, 448.f);
                        unsigned w = __builtin_amdgcn_cvt_pk_fp8_f32(c0, c1, 0, false); w = __builtin_amdgcn_cvt_pk_fp8_f32(c2, c3, w, true); o8[64 * j] = w; } }
                    float lg[NE];
#pragma unroll
                    for (int e = 0; e < NE; ++e) lg[e] = 0.f;
#pragma unroll
                    for (int j = 0; j < 4; ++j) {
                        const int c = 4 * (lane + 64 * j);
#pragma unroll
                        for (int i = 0; i < 4; ++i) {
                            const f32x4 r0 = rw[4 * j + i][0], r1 = rw[4 * j + i][1];
                            const float xv = v[j][i];
                            lg[0] += xv * r0.x; lg[1] += xv * r0.y; lg[2] += xv * r0.z; lg[3] += xv * r0.w;
                            lg[4] += xv * r1.x; lg[5] += xv * r1.y; lg[6] += xv * r1.z; lg[7] += xv * r1.w;
                        }
                    }
#pragma unroll
                    for (int e = 0; e < NE; ++e) lg[e] = wave_sum(lg[e]);
                    if (lane == 0) {
                        int i0 = 0; float b0 = lg[0];
#pragma unroll
                        for (int e = 1; e < NE; ++e) if (lg[e] > b0) { b0 = lg[e]; i0 = e; }
                        int i1 = 0; float b1 = -3.4e38f;
#pragma unroll
                        for (int e = 0; e < NE; ++e) if (e != i0 && lg[e] > b1) { b1 = lg[e]; i1 = e; }
                        const float e1 = __expf(b1 - b0); const float w0 = 1.f / (1.f + e1), w1 = e1 / (1.f + e1);
                        topw[2 * m] = w0; topw[2 * m + 1] = w1;
                        const unsigned q0 = __hip_atomic_fetch_add((LAS unsigned*)(rbc + i0), 1u, __ATOMIC_RELAXED, __HIP_MEMORY_SCOPE_WORKGROUP);
                        const unsigned q1 = __hip_atomic_fetch_add((LAS unsigned*)(rbc + i1), 1u, __ATOMIC_RELAXED, __HIP_MEMORY_SCOPE_WORKGROUP);
                        if (nrow < 16) { rinfo[(pw * 16 + nrow) * 2] = (i0 << 20) | (int)q0; rinfo[(pw * 16 + nrow) * 2 + 1] = (i1 << 20) | (int)q1; }
                    }
                    ++nrow;
                }
                __syncthreads();
                if (tid < NE) rbc[8 + tid] = atomicAdd(&cnt[tid], rbc[tid]);
                __syncthreads();
                { int k = 0;
                  for (int m = gw; m < M; m += NGW, ++k) if (lane == 0 && k < 16) {
#pragma unroll
                    for (int s2 = 0; s2 < 2; ++s2) { const int q = rinfo[(pw * 16 + k) * 2 + s2]; const int e = q >> 20; const int p = (int)rbc[8 + e] + (q & 0xfffff);
                        list[e * M + p] = 2 * m + s2; pairrow[2 * m + s2] = (e << 20) | p; }
                  } }
            }
        }
        SEAM(pb + 7);
        if (IN(pb + 9) && P_ON(9)) { PHASE_BEGIN;
            if (l == 0) {
                pg8::Gemm g{XN, (const bf16_t*)(ws + WS_WD13), D, D, SAq, (const float*)(cmx + 2 * NPROJ)}; pg8::StaticOrder S; S.init(M, 2 * D_FF, pG, pbx);
                pg8::EpiSwiGLU E{HB, D_FF, (!I8_DUP && DENSE_UP_FP8) ? 1.f / W8_SCALE : 1.f, DENSE_DN_FP8 ? H8_SCALE : 0.f};
                pg8::gemm_phase<pg8::EpiSwiGLU, pg8::StaticOrder, true, I8_DUP ? 2 : (DENSE_UP_FP8 ? 1 : 0)>(F.lds + RING_OFF, g, S, E, pw);
            } else {
                pg8::Gemm g{XN, (const bf16_t*)ap->out, D, D}; pg8::MoeGatherOrder S; S.init(cnt, list, 2 * DFE, pG, F.vcu, 7 * MiB / 2, D);
                pg8::EpiSwiGLU E{Hm, DFE, 1.f / W8_SCALE, H8_SCALE};
                pg8::gemm_phase<pg8::EpiSwiGLU, pg8::MoeGatherOrder, true, true>(F.lds + RING_OFF, g, S, E, pw);
            }
        }
        SEAM(pb + 9);
        if (IN(pb + 10) && P_ON(10)) { PHASE_BEGIN;
            if (l == 0) {
                pg8::Gemm g{HB, (const bf16_t*)(ws + WS_WD2), D_FF, D_FF}; pg8::StaticOrder S; S.init(M, D, pG, pbx);
                pg8::EpiResidB<false> E{XB, XB, DENSE_DN_FP8 ? 1.f / (W8_SCALE * H8_SCALE) : 1.f};
                pg8::gemm_phase<pg8::EpiResidB<false>, pg8::StaticOrder, false, DENSE_DN_FP8 != 0>(F.lds + RING_OFF, g, S, E, pw);
            } else {
                pg8::Gemm g{Hm, (const bf16_t*)(ws + WS_WM2), DFE, DFE}; pg8::MoeOrder S; S.init(cnt, D, pG, F.vcu, 7 * MiB / 4);
                pg8::EpiStore E{Yb, D, 1.f / (W8_SCALE * H8_SCALE)};
                pg8::gemm_phase<pg8::EpiStore, pg8::MoeOrder, true, true>(F.lds + RING_OFF, g, S, E, pw);
            }
        }
        SEAM(pb + 10);
        if (IN(pb + 11) && P_ON(11)) { PHASE_BEGIN;
            if (l == 0) { if (I8_INPROJ) norm_rows_bi8(gw, NGW, lane, XB, mix_norm + D, XN, SAq); else norm_rows_b(gw, NGW, lane, XB, mix_norm + D, XN); }
            else {
                int oo[NE]; { int a = 0; int cn8[8]; pg8::load_counts8(cnt, cn8);
#pragma unroll
                    for (int e = 0; e < NE; ++e) { oo[e] = a; a += (cn8[e] + 255) & ~255; } }
                const int nrow = (M - gw + NGW - 1) / NGW;
                int mq0 = 0, mq1 = 0; float mw0 = 0.f, mw1 = 0.f;
                if (lane < nrow) { const int mk = gw + lane * NGW; mq0 = pairrow[2 * mk]; mq1 = pairrow[2 * mk + 1]; mw0 = topw[2 * mk]; mw1 = topw[2 * mk + 1]; }
                f32x4 gfin[4]; { const GAS f32x4* gr = (const GAS f32x4*)final_norm + lane;
#pragma unroll
                    for (int j = 0; j < 4; ++j) gfin[j] = gr[64 * j]; }
#define FIN_ISSUE(k, YA, YB, XW) do { const int m_ = gw + (k) * NGW; const int q0_ = __builtin_amdgcn_readlane(mq0, (k)), q1_ = __builtin_amdgcn_readlane(mq1, (k)); int r0_ = q0_ & 0xfffff, r1_ = q1_ & 0xfffff; \
                    _Pragma("unroll") for (int e = 0; e < NE; ++e) { if ((q0_ >> 20) == e) r0_ += oo[e]; if ((q1_ >> 20) == e) r1_ += oo[e]; } \
                    const GAS u32x2* xb_ = (const GAS u32x2*)(XB + (size_t)m_ * D) + lane; const GAS u32x2* y0_ = (const GAS u32x2*)(Yb + (size_t)r0_ * D) + lane; const GAS u32x2* y1_ = (const GAS u32x2*)(Yb + (size_t)r1_ * D) + lane; \
                    _Pragma("unroll") for (int j = 0; j < 4; ++j) { YA[j] = y0_[64 * j]; YB[j] = y1_[64 * j]; XW[j] = xb_[64 * j]; } } while (0)
#define FIN_DO(k, YA, YB, XW) do { const int m_ = gw + (k) * NGW; const float w0 = __builtin_bit_cast(float, __builtin_amdgcn_readlane(__builtin_bit_cast(int, mw0), (k))), w1 = __builtin_bit_cast(float, __builtin_amdgcn_readlane(__builtin_bit_cast(int, mw1), (k))); \
                    GAS f32x4* xr = (GAS f32x4*)(X + (size_t)m_ * D) + lane;                 \
                    f32x4 v[4]; float ss = 0.f; \
                    _Pragma("unroll") for (int j = 0; j < 4; ++j) { const u32x2 a = YA[j], b = YB[j], xw = XW[j]; f32x4 t = (f32x4){bflo(xw.x), bfhi(xw.x), bflo(xw.y), bfhi(xw.y)}; \
                        t.x += w0 * bflo(a.x) + w1 * bflo(b.x); t.y += w0 * bfhi(a.x) + w1 * bfhi(b.x); t.z += w0 * bflo(a.y) + w1 * bflo(b.y); t.w += w0 * bfhi(a.y) + w1 * bfhi(b.y); \
                        v[j] = t; ss += (t.x * t.x + t.y * t.y) + (t.z * t.z + t.w * t.w); } \
                    ss = wave_sum(ss); const float rstd = rsqrtf(ss * (1.f / D) + EPS); \
                    _Pragma("unroll") for (int j = 0; j < 4; ++j) xr[64 * j] = v[j] * gfin[j] * rstd; } while (0)
                u32x2 yan[4], ybn[4], xwn[4];
#pragma unroll
                for (int j = 0; j < 4; ++j) { yan[j] = (u32x2){0u, 0u}; ybn[j] = yan[j]; xwn[j] = yan[j]; }
                if (nrow > 0) FIN_ISSUE(0, yan, ybn, xwn);
#pragma unroll 1
                for (int k = 0; k < nrow; ++k) {
                    u32x2 yac[4], ybc[4], xwc[4];
#pragma unroll
                    for (int j = 0; j < 4; ++j) { yac[j] = yan[j]; ybc[j] = ybn[j]; xwc[j] = xwn[j]; }
                    asm volatile("" : "+v"(yac[0]), "+v"(yac[1]), "+v"(yac[2]), "+v"(yac[3]), "+v"(ybc[0]), "+v"(ybc[1]), "+v"(ybc[2]), "+v"(ybc[3]), "+v"(xwc[0]), "+v"(xwc[1]), "+v"(xwc[2]), "+v"(xwc[3]));
                    if (k + 1 < nrow) FIN_ISSUE(k + 1, yan, ybn, xwn);
                    FIN_DO(k, yac, ybc, xwc);
                }
#undef FIN_ISSUE
#undef FIN_DO
            }
        }
        SEAM(pb + 11);
    }
#undef IN
#undef SEAM
}
#ifndef MEGA_MASK
#define MEGA_MASK 0xFFF
#endif
#ifndef ONE_LAUNCH
#define ONE_LAUNCH 0
#endif
static void launch_mega(hipStream_t st, Args a, int lo, int hi, int grid) {
    a.ph_lo = lo; a.ph_hi = hi;
    hipLaunchKernelGGL(mega_fwd, dim3(grid), dim3(NWAVES * 64), LDS_BYTES, st, a);
}

extern "C" void kernel_launch(void* const* d_in, const int* in_sizes, int n_in, void* d_out, int out_size, void* d_ws, size_t ws_size, hipStream_t stream) {
    static int grid = 0;
    if (grid == 0) {
        int dev = 0, cus = 0, per_cu = 0;
        if (n_in != 25 || out_size != M * D || ws_size < WS_END) { grid = -1; return; }
        if (hipGetDevice(&dev) != hipSuccess || hipDeviceGetAttribute(&cus, hipDeviceAttributeMultiprocessorCount, dev) != hipSuccess) { grid = -1; return; }
        if (hipFuncSetAttribute((const void*)mega_fwd, hipFuncAttributeMaxDynamicSharedMemorySize, LDS_BYTES) != hipSuccess) { grid = -1; return; }
        if (hipOccupancyMaxActiveBlocksPerMultiprocessor(&per_cu, (const void*)mega_fwd, NWAVES * 64, LDS_BYTES) != hipSuccess || per_cu < 1) { (void)hipGetLastError(); }
        (void)hipGetLastError();
        grid = cus;
    }
    if (grid < 0) return;
    (void)hipMemsetAsync((char*)d_ws + WS_CTL, 0, CTL_ZERO_BYTES, stream);
    Args a{};
    for (int i = 0; i < 25; ++i) a.in[i] = (const float*)d_in[i];
    a.out = (float*)d_out; a.ws = (unsigned char*)d_ws; a.flags = 0; a.pad = 0;
#if ONE_LAUNCH
    launch_mega(stream, a, 0, 25, grid);
#else
    const float* x = (const float*)d_in[0]; const int* pos = (const int*)d_in[1];
    const float* mix_norm = (const float*)d_in[2]; const float* w_in = (const float*)d_in[3]; const float* gate_bias = (const float*)d_in[4];
    const float* conv_w = (const float*)d_in[5]; const float* a_log = (const float*)d_in[6]; const float* dt_bias = (const float*)d_in[7];
    const float* gdn_out_norm = (const float*)d_in[8]; const float* w_gdn_o = (const float*)d_in[9]; const float* q_a_norm = (const float*)d_in[10];
    const float* w_q_b = (const float*)d_in[11]; const float* kv_a_norm = (const float*)d_in[12]; const float* w_kv_b = (const float*)d_in[13];
    const float* w_mla_o = (const float*)d_in[14]; const float* w_out = (const float*)d_in[15]; const float* ffn_norm = (const float*)d_in[16];
    const float* dense_w1 = (const float*)d_in[17]; const float* dense_w3 = (const float*)d_in[18]; const float* dense_w2 = (const float*)d_in[19];
    const float* router_w = (const float*)d_in[20]; const float* moe_w1 = (const float*)d_in[21]; const float* moe_w3 = (const float*)d_in[22];
    const float* moe_w2 = (const float*)d_in[23]; const float* final_norm = (const float*)d_in[24];
    float* X = (float*)d_out;
    unsigned char* ws = (unsigned char*)d_ws;
    unsigned* ctl = (unsigned*)(ws + WS_CTL);
    bf16_t* GATE = (bf16_t*)(ws + WS_GATE); bf16_t* Zb = (bf16_t*)(ws + WS_Z); bf16_t* MISC = (bf16_t*)(ws + WS_MISC); bf16_t* QKV = (bf16_t*)(ws + WS_QKV);
    bf16_t* Qb = (bf16_t*)(ws + WS_Q); bf16_t* Kb = (bf16_t*)(ws + WS_K); bf16_t* Vb = (bf16_t*)(ws + WS_V); bf16_t* AO = (bf16_t*)(ws + WS_AO); bf16_t* GO = (bf16_t*)(ws + WS_GO);
    bf16_t* XN = (bf16_t*)(ws + WS_XN); bf16_t* MERGED = (bf16_t*)(ws + WS_MERGED);
    bf16_t* HB = (bf16_t*)(ws + WS_HB); bf16_t* XG = (bf16_t*)(ws + WS_XG); bf16_t* Hm = (bf16_t*)(ws + WS_H); bf16_t* Yb = (bf16_t*)(ws + WS_Y);
    bf16_t* QN = (bf16_t*)(ws + WS_QN); bf16_t* KN = (bf16_t*)(ws + WS_KN); bf16_t* VN = (bf16_t*)(ws + WS_VN); bf16_t* QRAW = (bf16_t*)(ws + WS_QRAW);
    float* ORAW = (float*)(ws + WS_ORAW);
    float* rstdq = (float*)(ws + WS_RSTD); float* rstdkv = rstdq + M;
    float* gbuf = (float*)(ws + WS_GB); float* bbuf = gbuf + M * 4;
    int* topi = (int*)(ws + WS_MOE); float* topw = (float*)(topi + 2 * M); int* pairrow = (int*)(topw + 2 * M); int* list = pairrow + 2 * M; int* offs = list + NE * M;
    unsigned* cnt = ctl + CW_CNT;
    const int mask = MEGA_MASK;
#define USE_MEGA(s) ((mask >> (s)) & 1)
    launch_mega(stream, a, 0, 1, grid);
    for (int l = 0; l < 2; ++l) {
        const int pb = 1 + 12 * l;
        const float* xin = (l == 0) ? x : X;
        const float* wi = w_in + (size_t)l * D * IN_COLS;
        if (USE_MEGA(0)) launch_mega(stream, a, pb + 0, pb + 1, grid);
        else {
            EpiArgs e0{}; e0.mode = 0;
            e0.ob = QKV; e0.ldo = QKV_LD; e0.col0 = 0;      gemm(stream, false, XN, D, wi, nullptr, IN_COLS, WC_Q, M, 1536, D, e0);
            e0.ob = Zb; e0.ldo = Z_LD; e0.col0 = 0;         gemm(stream, false, XN, D, wi, nullptr, IN_COLS, WC_Z, M, 512, D, e0);
            e0.ob = MISC; e0.ldo = MISC_LD; e0.col0 = MC_A; gemm(stream, false, XN, D, wi, nullptr, IN_COLS, WC_A, M, 8, D, e0);
            e0.col0 = MC_CQ;  gemm(stream, false, XN, D, wi, nullptr, IN_COLS, WC_CQ, M, 384, D, e0);
            e0.col0 = MC_CKV; gemm(stream, false, XN, D, wi, nullptr, IN_COLS, WC_CKV, M, 256, D, e0);
            e0.col0 = MC_KR;  gemm(stream, false, XN, D, wi, nullptr, IN_COLS, WC_KR, M, 32, D, e0);
            EpiArgs e1{}; e1.mode = 1; e1.ob = GATE; e1.ldo = GATE_LD; e1.col0 = 0; e1.bias = gate_bias + l * 2048;
            gemm(stream, false, XN, D, wi, nullptr, IN_COLS, WC_GATE, M, 2048, D, e1);
        }
        if (USE_MEGA(1)) { launch_mega(stream, a, pb + 1, pb + 2, grid); launch_mega(stream, a, pb + 2, pb + 3, grid); }
        else {
            hipLaunchKernelGGL(k_gdn_prep, dim3(M), dim3(256), 0, stream, (const bf16_t*)QKV, (const bf16_t*)MISC, conv_w + l * 4 * 1536, a_log + l * 4, dt_bias + l * 4, QN, KN, VN, gbuf, bbuf);
            hipLaunchKernelGGL(k_gdn_rec, dim3(32, 16), dim3(1024), 0, stream, (const bf16_t*)QN, (const bf16_t*)KN, (const bf16_t*)VN, (const float*)gbuf, (const float*)bbuf, ORAW);
            hipLaunchKernelGGL(k_mla_prep, dim3(M / 4), dim3(256), 0, stream, (const bf16_t*)MISC, pos, rstdq, rstdkv, Kb);
        }
        if (USE_MEGA(3)) launch_mega(stream, a, pb + 3, pb + 4, grid);
        else {
            EpiArgs eq{}; eq.mode = 0; eq.ob = QRAW; eq.ldo = 768; eq.col0 = 0; eq.kgain = q_a_norm + l * 384; eq.rowscale = rstdq;
            gemm(stream, false, MISC + MC_CQ, MISC_LD, w_q_b + (size_t)l * 384 * 768, nullptr, 768, 0, M, 768, 384, eq);
            hipLaunchKernelGGL(k_q_rope, dim3(M * 768 / 256), dim3(256), 0, stream, (const bf16_t*)QRAW, pos, Qb);
            EpiArgs ekv{}; ekv.mode = 6; ekv.ob = Kb; ekv.ob2 = Vb; ekv.kgain = kv_a_norm + l * 256; ekv.rowscale = rstdkv;
            gemm(stream, false, MISC + MC_CKV, MISC_LD, w_kv_b + (size_t)l * 256 * 1024, nullptr, 1024, 0, M, 1024, 256, ekv);
        }
        if (USE_MEGA(4)) launch_mega(stream, a, pb + 4, pb + 5, grid);
        else {
            hipLaunchKernelGGL(k_attn, dim3(M * 8 / 4), dim3(256), 0, stream, (const bf16_t*)Qb, (const bf16_t*)Kb, (const bf16_t*)Vb, AO);
            hipLaunchKernelGGL(k_gdn_gate, dim3(M / 4), dim3(256), 0, stream, (const float*)ORAW, (const bf16_t*)Zb, gdn_out_norm + l * 128, GO);
        }
        if (USE_MEGA(5)) launch_mega(stream, a, pb + 5, pb + 6, grid);
        else {
            EpiArgs em{}; em.mode = 2; em.ob = MERGED; em.ldo = D; em.gate = GATE; em.ldg = GATE_LD; em.gcol0 = 0;
            gemm(stream, false, GO, 512, w_gdn_o + (size_t)l * 512 * D, nullptr, D, 0, M, D, 512, em);
            em.mode = 3; em.gcol0 = D;
            gemm(stream, false, AO, 512, w_mla_o + (size_t)l * 512 * D, nullptr, D, 0, M, D, 512, em);
        }
        if (USE_MEGA(6)) launch_mega(stream, a, pb + 6, pb + 7, grid);
        else { EpiArgs eo{}; eo.mode = 4; eo.res = xin; eo.of = X; gemm(stream, false, MERGED, D, w_out + (size_t)l * D * D, nullptr, D, 0, M, D, D, eo); }
        if (USE_MEGA(7)) launch_mega(stream, a, pb + 7, pb + 8, grid);
        else hipLaunchKernelGGL(k_rmsnorm, dim3(M / 4), dim3(256), 0, stream, (const float*)X, ffn_norm + l * D, XN, (float*)nullptr, l, router_w, topi, topw, cnt, list);
        if (l == 1) {
            if (USE_MEGA(8)) launch_mega(stream, a, pb + 8, pb + 9, grid);
            else {
                hipLaunchKernelGGL(k_moe_offsets, dim3(1), dim3(64), 0, stream, (const unsigned*)cnt, offs);
                hipLaunchKernelGGL(k_moe_gather, dim3(MOE_ROWS / 4), dim3(256), 0, stream, (const bf16_t*)XN, (const unsigned*)cnt, (const int*)offs, (const int*)list, XG, pairrow);
            }
        }
        if (USE_MEGA(9)) launch_mega(stream, a, pb + 9, pb + 10, grid);
        else if (l == 0) { EpiArgs eu{}; eu.mode = 5; eu.ob = HB; eu.ldo = D_FF; gemm(stream, true, XN, D, dense_w1, dense_w3, D_FF, 0, M, D_FF, D, eu); }
        else { EpiArgs eu{}; eu.mode = 5; eu.ob = Hm; eu.ldo = DFE; gemm(stream, true, XG, D, moe_w1, moe_w3, DFE, 0, MOE_ROWS, DFE, D, eu, offs, (size_t)D * DFE); }
        if (USE_MEGA(10)) launch_mega(stream, a, pb + 10, pb + 11, grid);
        else if (l == 0) { EpiArgs ed{}; ed.mode = 4; ed.res = X; ed.of = X; gemm(stream, false, HB, D_FF, dense_w2, nullptr, D, 0, M, D, D_FF, ed); }
        else { EpiArgs ed{}; ed.mode = 0; ed.ob = Yb; ed.ldo = D; ed.col0 = 0; gemm(stream, false, Hm, DFE, moe_w2, nullptr, D, 0, MOE_ROWS, D, DFE, ed, offs, (size_t)DFE * D); }
        if (USE_MEGA(11)) launch_mega(stream, a, pb + 11, pb + 12, grid);
        else if (l == 0) hipLaunchKernelGGL(k_rmsnorm, dim3(M / 4), dim3(256), 0, stream, (const float*)X, mix_norm + D, XN, (float*)nullptr, 0, (const float*)nullptr, (int*)nullptr, (float*)nullptr, (unsigned*)nullptr, (int*)nullptr);
        else {
            hipLaunchKernelGGL(k_moe_combine, dim3(M / 4), dim3(256), 0, stream, X, (const bf16_t*)Yb, (const int*)pairrow, (const float*)topw);
            hipLaunchKernelGGL(k_rmsnorm, dim3(M / 4), dim3(256), 0, stream, (const float*)X, final_norm, (bf16_t*)nullptr, X, 2, (const float*)nullptr, (int*)nullptr, (float*)nullptr, (unsigned*)nullptr, (int*)nullptr);
        }
    }
#undef USE_MEGA
#endif
}
```

```cpp
#define MEGA_MASK 0xFFF
#define ONE_LAUNCH 1
#include <hip/hip_runtime.h>
#include <stdint.h>

typedef unsigned short bf16_t;
#define DI __device__ __forceinline__
#define GAS __attribute__((address_space(1)))
#define LAS __attribute__((address_space(3)))
typedef short bf16x8 __attribute__((ext_vector_type(8)));
typedef short s16x4 __attribute__((ext_vector_type(4)));
typedef float f32x2 __attribute__((ext_vector_type(2)));
typedef float f32x4 __attribute__((ext_vector_type(4)));
typedef float f32x16 __attribute__((ext_vector_type(16)));
typedef unsigned u32x2 __attribute__((ext_vector_type(2)));
typedef unsigned u32x4 __attribute__((ext_vector_type(4)));
typedef GAS unsigned gu32;
#define RLX_AGENT __ATOMIC_RELAXED, __HIP_MEMORY_SCOPE_AGENT
#define LDS_WAIT() asm volatile("s_waitcnt lgkmcnt(0)" ::: "memory")
#define VM_WAIT() asm volatile("s_waitcnt vmcnt(0)" ::: "memory")

DI float bf2f(bf16_t v) { return __uint_as_float(((unsigned)v) << 16); }
DI unsigned f2bf(float f) { unsigned u = __float_as_uint(f); return (u + 0x7fffu + ((u >> 16) & 1u)) >> 16; }
DI unsigned pk2(float lo, float hi) { return f2bf(lo) | (f2bf(hi) << 16); }
DI float bflo(unsigned w) { return __uint_as_float(w << 16); }
DI float bfhi(unsigned w) { return __uint_as_float(w & 0xffff0000u); }
DI float siluf(float x) { return x * __builtin_amdgcn_rcpf(1.f + __expf(-x)); }
DI float sigmf(float x) { return __builtin_amdgcn_rcpf(1.f + __expf(-x)); }
DI void lds_barrier() { asm volatile("s_waitcnt lgkmcnt(0)" ::: "memory"); __builtin_amdgcn_s_barrier(); asm volatile("" ::: "memory"); }
DI int lane_id_asm() { int l; asm volatile("v_mbcnt_lo_u32_b32 %0, -1, 0\n\tv_mbcnt_hi_u32_b32 %0, -1, %0" : "=v"(l)); return l; }
template <int K> DI float swz_xor(float v) { return __int_as_float(__builtin_amdgcn_ds_swizzle(__float_as_int(v), (K << 10) | 0x1F)); }
DI float xor32_sum(float v) { const auto rr = __builtin_amdgcn_permlane32_swap(__float_as_uint(v), __float_as_uint(v), false, false); return __uint_as_float(rr[0]) + __uint_as_float(rr[1]); }
DI float wave_sum(float v) {
    v += swz_xor<1>(v); v += swz_xor<2>(v); v += swz_xor<4>(v); v += swz_xor<8>(v); v += swz_xor<16>(v);
    return xor32_sum(v);
}

constexpr int M = 16384, D = 1024, SEQ = 2048, NBATCH = 8;
constexpr int IN_COLS = 4776;
constexpr int NPROJ = 4864;
constexpr int MC_CQ = 0, MC_CKV = 384, MC_KR = 640, MC_A = 672, MC_B = 676, MISC_LD = 768;
constexpr int QKV_LD = 1536, Z_LD = 512, GATE_LD = 2048;
constexpr int WC_Q = 0, WC_Z = 1536, WC_A = 2048, WC_B = 2052, WC_CQ = 2056, WC_CKV = 2440, WC_KR = 2696, WC_GATE = 2728;
constexpr int D_FF = 3584, NE = 8, DFE = 1792;
constexpr int MOE_ROWS = 34816;
constexpr float EPS = 1e-6f;
constexpr float QSCALE = 0.10206207261596575f * 1.4426950408889634f;
constexpr int NCHUNK = 32;

constexpr size_t MiB = 1u << 20, KiB = 1u << 10;
constexpr size_t WS_CTL = 0, CTL_ZERO_BYTES = 256 * KiB;
constexpr size_t WS_WIN = 1 * MiB;
constexpr size_t WIN_STRIDE = (size_t)NPROJ * 1024 * 2;
constexpr size_t WS_WGDNO = 20 * MiB;
constexpr size_t WS_WMLAO = 22 * MiB;
constexpr size_t WS_WOUT = 24 * MiB;
constexpr size_t WS_WQB = 28 * MiB;
constexpr size_t WS_WKVB = 29 * MiB + 512 * KiB;
constexpr size_t WS_WD13 = 31 * MiB;
constexpr size_t WS_WD2 = 45 * MiB;
constexpr size_t WS_WM2 = 1 * MiB;
constexpr size_t WS_GATE = 53 * MiB;
constexpr size_t WS_Z = 117 * MiB;
constexpr size_t WS_MISC = 133 * MiB;
constexpr size_t WS_QKV = 157 * MiB;
constexpr size_t WS_Q = 157 * MiB;
constexpr size_t WS_K = 181 * MiB;
constexpr size_t WS_GDNL = 205 * MiB;
constexpr size_t WS_UT = 205 * MiB, WS_W = 221 * MiB, WS_QD = 237 * MiB, WS_KDT = 253 * MiB, WS_AT = 269 * MiB;
constexpr size_t WS_V = 205 * MiB;
constexpr size_t WS_AO = 221 * MiB;
constexpr size_t WS_GO = 237 * MiB;
constexpr size_t WS_QN = 205 * MiB, WS_KN = 221 * MiB, WS_VN = 237 * MiB, WS_QRAW = 253 * MiB;
constexpr size_t WS_XB = 277 * MiB;
constexpr float W8_SCALE = 32.f, H8_SCALE = 4.f;
#ifndef DENSE_UP_FP8
#define DENSE_UP_FP8 0
#endif
#ifndef DENSE_DN_FP8
#define DENSE_DN_FP8 0
#endif
constexpr float W8S_UNUSED = 32.f;
constexpr size_t OUT_XN = 32 * MiB;
constexpr size_t WS_XN_UNUSED = 277 * MiB;
constexpr size_t WS_ORAW = 277 * MiB;
constexpr size_t WS_MERGED = 277 * MiB;
constexpr size_t WS_HB = 53 * MiB;
constexpr size_t WS_XG = 85 * MiB;
constexpr size_t WS_Y = 85 * MiB;
constexpr size_t WS_H = 153 * MiB;
constexpr size_t WS_MOE = 309 * MiB;
constexpr size_t WS_COS = 311 * MiB, WS_SIN = 312 * MiB;
constexpr size_t WS_RSTD = 313 * MiB;
constexpr size_t WS_CD = 313 * MiB + 256 * KiB;
constexpr size_t WS_GB = 313 * MiB + 512 * KiB;
constexpr size_t WS_END = 314 * MiB;
constexpr int CW_CNT = 64;
constexpr int CW_BAR = 4096;
constexpr int CW_CMAX = 32768;
constexpr size_t WS_SA = 314 * MiB;
#ifndef I8_INPROJ
#define I8_INPROJ 1
#endif
#ifndef I8_DUP
#define I8_DUP 1
#endif
namespace pg8 {
constexpr int BM = 256, BK = 64, HALF = 128, HTB = HALF * BK * 2  , STAGE_BYTES = 8 * HTB, NXCD = 8, WGM = 8;

__host__ __device__ __forceinline__ int lds_byte(int r, int c) { const int st = (r >> 4) * 2 + (c >> 5), rr = r & 15, cc = c & 31, ob = rr * 64 + cc * 2; return st * 1024 + (ob ^ (((ob >> 9) & 1) << 5)); }
__host__ __device__ __forceinline__ void stage_rc(int b, int& R, int& C) { const int st = b / 1024, sb = b % 1024, swz = sb ^ (((sb >> 9) & 1) << 5); R = (st >> 1) * 16 + swz / 64; C = (st & 1) * 32 + (swz % 64) / 2; }
__host__ __device__ __forceinline__ int perm32(int rho) { const int n = rho >> 4, i = rho & 15; return 8 * (i >> 2) + 4 * n + (i & 3); }

struct Unit { int pm, pn; size_t boff; size_t aoff; int kind; };
struct Gemm { const bf16_t* A; const bf16_t* Bt; int lda, K; const float* sA; const float* sB; };

struct StaticOrder {
    static constexpr bool GATHER = false;
    int nM, nN, nwg, G, c;
    __device__ void init(int Mr, int N, int G_, int c_) { nM = Mr / BM; nN = N / BM; nwg = nM * nN; G = G_; c = c_; }
    __device__ bool next(int i, Unit& u) const {
        const long L = (long)i * G + c; if (L >= nwg) return false;
        int wgid = (int)L; { const int q = nwg / NXCD, r = nwg % NXCD, xcd = wgid % NXCD, off = wgid / NXCD; wgid = (xcd < r ? xcd * (q + 1) : r * (q + 1) + (xcd - r) * q) + off; }
        const int nig = WGM * nN, gid = wgid / nig, fm = gid * WGM, gsz = (nM - fm) < WGM ? (nM - fm) : WGM;
        u.pm = fm + ((wgid % nig) % gsz); u.pn = (wgid % nig) / gsz; u.boff = 0; u.aoff = 0; u.kind = 0; return true;
    }
    __device__ __forceinline__ void a_ready(const Unit&) const {}
    __device__ __forceinline__ void done(const Unit&) const {}
};
struct TwoSegOrder {
    static constexpr bool GATHER = false;
    StaticOrder so; size_t aoff1, boff1;
    __device__ void init(int Mr, int N, int G_, int c_, size_t aoff1_, size_t boff1_) { so.init(Mr, N, G_, c_); aoff1 = aoff1_; boff1 = boff1_; }
    __device__ bool next(int i, Unit& u) const {
        if (!so.next(i >> 1, u)) return false;
        const int sgm = i & 1; u.kind = sgm; u.aoff = sgm ? aoff1 : 0; u.boff = sgm ? 0 : boff1; return true;
    }
    __device__ __forceinline__ void a_ready(const Unit&) const {}
    __device__ __forceinline__ void done(const Unit&) const {}
};
DI void load_counts8(const unsigned* cnt, int (&cn)[8]) {
    const int l = lane_id_asm();
    const int v = (int)__hip_atomic_load(cnt + (l & 7), __ATOMIC_RELAXED, __HIP_MEMORY_SCOPE_AGENT);
#pragma unroll
    for (int e = 0; e < 8; ++e) cn[e] = __builtin_amdgcn_readlane(v, e);
}
struct MoeOrder {
    static constexpr bool GATHER = false;
    int nN, G, c, nunits; int o1, o2, o3, o4, o5, o6, o7; size_t estride;
    __device__ void init(const unsigned* cnt, int N, int G_, int c_, size_t estride_) {
        nN = N / BM; G = G_; c = c_; estride = estride_;
        int o[9]; int a = 0; int cn8[8]; load_counts8(cnt, cn8);
#pragma unroll
        for (int e = 0; e < 8; ++e) { o[e] = a; a += (cn8[e] + 255) & ~255; }
        o[8] = a;
        o1 = o[1]; o2 = o[2]; o3 = o[3]; o4 = o[4]; o5 = o[5]; o6 = o[6]; o7 = o[7];
        nunits = (a / BM) * nN;
    }
    __device__ bool next(int i, Unit& u) const {
        const long L = (long)i * G + c; if (L >= nunits) return false;
        const int rt = (int)L / nN, pn = (int)L % nN, r0 = rt * BM;
        const int e = __builtin_amdgcn_readfirstlane((r0 >= o1) + (r0 >= o2) + (r0 >= o3) + (r0 >= o4) + (r0 >= o5) + (r0 >= o6) + (r0 >= o7));
        u.pm = rt; u.pn = pn; u.boff = (size_t)e * estride; u.aoff = 0; u.kind = e; return true;
    }
    __device__ __forceinline__ void a_ready(const Unit&) const {}
    __device__ __forceinline__ void done(const Unit&) const {}
};

struct MoeGatherOrder {
    static constexpr bool GATHER = true;
    int nN, G, c, nunits; int o[9]; int cn[8]; size_t estride; const int* list; int rowbytes;
    __device__ void init(const unsigned* cnt, const int* list_, int N, int G_, int c_, size_t estride_, int rowbytes_) {
        nN = N / BM; G = G_; c = c_; estride = estride_; list = list_; rowbytes = rowbytes_;
        int a = 0; load_counts8(cnt, cn);
#pragma unroll
        for (int e = 0; e < 8; ++e) { o[e] = a; a += (cn[e] + 255) & ~255; }
        o[8] = a; nunits = (a / BM) * nN;
    }
    __device__ bool next(int i, Unit& u) const {
        const long L = (long)i * G + c; if (L >= nunits) return false;
        const int rt = (int)L / nN, pn = (int)L % nN, r0 = rt * BM;
        int e = 0;
#pragma unroll
        for (int k = 1; k < 8; ++k) e += (r0 >= o[k]);
        e = __builtin_amdgcn_readfirstlane(e);
        u.pm = rt; u.pn = pn; u.boff = (size_t)e * estride; u.aoff = 0; u.kind = e; return true;
    }
    __device__ __forceinline__ unsigned row_off(const Unit& u, int R) const {
        int oe = 0, ce = 0;
#pragma unroll
        for (int k = 0; k < 8; ++k) if (u.kind == k) { oe = o[k]; ce = cn[k]; }
        const int p = u.pm * BM + R - oe;
        const int tok = (p < ce) ? (list[(size_t)u.kind * 16384 + p] >> 1) : 0;
        return (unsigned)tok * (unsigned)rowbytes;
    }
    __device__ __forceinline__ void a_ready(const Unit&) const {}
    __device__ __forceinline__ void done(const Unit&) const {}
};

DI unsigned cvt_pk_bf16(float lo, float hi) { unsigned r; asm volatile("v_cvt_pk_bf16_f32 %0, %1, %2" : "=v"(r) : "v"(lo), "v"(hi)); return r; }
DI u32x4 pack8(const f32x4 v0, const f32x4 v1) { u32x4 w; w.x = cvt_pk_bf16(v0[0], v0[1]); w.y = cvt_pk_bf16(v0[2], v0[3]); w.z = cvt_pk_bf16(v1[0], v1[1]); w.w = cvt_pk_bf16(v1[2], v1[3]); return w; }
DI f32x4 sig4(f32x4 v) { f32x4 r; r[0] = sigmf(v[0]); r[1] = sigmf(v[1]); r[2] = sigmf(v[2]); r[3] = sigmf(v[3]); return r; }
DI f32x4 silu4(f32x4 v) { f32x4 r; r[0] = siluf(v[0]); r[1] = siluf(v[1]); r[2] = siluf(v[2]); r[3] = siluf(v[3]); return r; }

typedef const f32x4 (&AccRef)[2][2][4][2];
typedef int i32x4_t __attribute__((ext_vector_type(4)));

struct EpiInProj {
    static constexpr bool AFTER_DRAIN = false; static constexpr bool TWOSEG = false; static constexpr bool PERM = true;
    bf16_t *QKV, *Z, *MISC, *GATE; const float* bias;
    DI void operator()(AccRef acc, const Unit& u, int wr, int wc, int fr, int fq) const {
        const int pn = u.pn; const int row0 = u.pm * BM + wr * 64 + fr;
        if (pn >= 11) {
            const int j = pn - 11, c0 = j * HALF + wc * 32 + 8 * fq;
            f32x4 ba[2], bb[2];
#pragma unroll
            for (int n = 0; n < 2; ++n) { ba[n] = *(const f32x4*)(bias + c0 + 4 * n); bb[n] = *(const f32x4*)(bias + 1024 + c0 + 4 * n); }
#pragma unroll
            for (int ai = 0; ai < 2; ++ai)
#pragma unroll
                for (int m = 0; m < 4; ++m) { bf16_t* rowp = GATE + (size_t)(row0 + ai * HALF + m * 16) * GATE_LD + c0;
                    f32x4 ga0 = sig4(acc[ai][0][m][0] + ba[0]), ga1 = sig4(acc[ai][0][m][1] + ba[1]);
                    f32x4 gb0 = sig4(acc[ai][1][m][0] + bb[0]), gb1 = sig4(acc[ai][1][m][1] + bb[1]);
                    const u32x4 wa = pack8(ga0, ga1);
                    f32x4 ra0, ra1; ra0[0] = bflo(wa.x); ra0[1] = bfhi(wa.x); ra0[2] = bflo(wa.y); ra0[3] = bfhi(wa.y); ra1[0] = bflo(wa.z); ra1[1] = bfhi(wa.z); ra1[2] = bflo(wa.w); ra1[3] = bfhi(wa.w);
#pragma unroll
                    for (int i = 0; i < 4; ++i) { gb0[i] *= __builtin_amdgcn_rcpf(ra0[i]); gb1[i] *= __builtin_amdgcn_rcpf(ra1[i]); }
                    __builtin_nontemporal_store(wa, (u32x4*)rowp); __builtin_nontemporal_store(pack8(gb0, gb1), (u32x4*)(rowp + 1024));
                    asm volatile("" ::: "memory"); }
            return;
        }
        bf16_t* base; int ld, colt;
        if (pn < 6) { base = QKV; ld = QKV_LD; colt = pn * 256; }
        else if (pn < 8) { base = Z; ld = Z_LD; colt = (pn - 6) * 256; }
        else { base = MISC; ld = MISC_LD; colt = (pn - 8) * 256; }
        const int col0 = colt + wc * 32 + 8 * fq;
#pragma unroll
        for (int ai = 0; ai < 2; ++ai)
#pragma unroll
            for (int m = 0; m < 4; ++m) { bf16_t* rowp = base + (size_t)(row0 + ai * HALF + m * 16) * ld + col0;
#pragma unroll
                for (int bj = 0; bj < 2; ++bj) *(u32x4*)(rowp + bj * HALF) = pack8(acc[ai][bj][m][0], acc[ai][bj][m][1]);
                asm volatile("" ::: "memory"); }
    }
};
struct EpiQRope {
    static constexpr bool AFTER_DRAIN = false; static constexpr bool TWOSEG = false; static constexpr bool PERM = false;
    bf16_t* Q; const float* rstd; const float* COS; const float* SIN;
    DI void operator()(AccRef acc, const Unit& u, int wr, int wc, int fr, int fq) const {
        const int row0 = u.pm * BM + wr * 64 + fr;
#pragma unroll
        for (int ai = 0; ai < 2; ++ai) {
            float scv[4]; f32x4 csv[4], snv[4];
#pragma unroll
            for (int m = 0; m < 4; ++m) { const int row = row0 + ai * HALF + m * 16; scv[m] = rstd[row]; csv[m] = *(const f32x4*)(COS + (size_t)row * 16 + 4 * fq); snv[m] = *(const f32x4*)(SIN + (size_t)row * 16 + 4 * fq); }
#pragma unroll
            for (int m = 0; m < 4; ++m) {
                const int row = row0 + ai * HALF + m * 16;
                const float sc = scv[m] * QSCALE;
                const f32x4 cs = csv[m], sn = snv[m];
#pragma unroll
                for (int bj = 0; bj < 2; ++bj) {
                    const int gi = 8 * u.pn + 4 * bj + wc;
                    f32x4 v0 = acc[ai][bj][m][0] * sc, v1 = acc[ai][bj][m][1] * sc;
                    if (gi % 3 == 2) { const f32x4 o0 = v0 * cs - v1 * sn, o1 = v1 * cs + v0 * sn; v0 = o0; v1 = o1; }
                    bf16_t* p = Q + (size_t)row * 768 + gi * 32 + 4 * fq;
                    u32x2 w0, w1; w0.x = cvt_pk_bf16(v0[0], v0[1]); w0.y = cvt_pk_bf16(v0[2], v0[3]); w1.x = cvt_pk_bf16(v1[0], v1[1]); w1.y = cvt_pk_bf16(v1[2], v1[3]);
                    *(u32x2*)p = w0; *(u32x2*)(p + 16) = w1;
                }
            }
            asm volatile("" ::: "memory");
        }
    }
};
struct EpiKV {
    static constexpr bool AFTER_DRAIN = true; static constexpr bool TWOSEG = false; static constexpr bool PERM = true;
    bf16_t* K; bf16_t* V; const float* rstd;
    DI void operator()(AccRef, const Unit&, int, int, int, int) const {}
    DI void after(AccRef acc, const Unit& u, int wr, int wc, int fr, int fq, LAS unsigned char* lds, int tid) const {
#pragma unroll
        for (int ai = 0; ai < 2; ++ai)
#pragma unroll
            for (int m = 0; m < 4; ++m) { const int r = wr * 64 + ai * HALF + m * 16 + fr; const float sc = rstd[u.pm * BM + r];
#pragma unroll
                for (int bj = 0; bj < 2; ++bj) *(LAS u32x4*)(lds + r * 528 + (bj * HALF + wc * 32 + 8 * fq) * 2) = pack8(acc[ai][bj][m][0] * sc, acc[ai][bj][m][1] * sc); }
        asm volatile("s_waitcnt lgkmcnt(0)" ::: "memory"); __builtin_amdgcn_s_barrier(); asm volatile("" ::: "memory");
        const int ch = tid & 31, r0 = tid >> 5;
#pragma unroll 4
        for (int i = 0; i < 16; ++i) {
            const int r = r0 + 16 * i;
            const u32x4 a = *(const LAS u32x4*)(lds + r * 528 + ch * 16);
            const size_t row = (size_t)(u.pm * BM + r); const int c = (u.pn & 1) * 256 + ch * 8;
            bf16_t* p = (u.pn < 2) ? K + row * 768 + (c >> 6) * 96 + (c & 63) : V + row * 512 + c;
            *(u32x4*)p = a;
        }
    }
};
template <int MODE> struct EpiMerge {
    static constexpr bool AFTER_DRAIN = false; static constexpr bool TWOSEG = false; static constexpr bool PERM = true;
    bf16_t* MG; const bf16_t* GATE;
    DI void operator()(AccRef acc, const Unit& u, int wr, int wc, int fr, int fq) const {
        const int row0 = u.pm * BM + wr * 64 + fr, col0 = u.pn * BM + wc * 32 + 8 * fq;
#pragma unroll
        for (int ai = 0; ai < 2; ++ai)
#pragma unroll
            for (int m = 0; m < 4; ++m) { const size_t row = (size_t)(row0 + ai * HALF + m * 16);
#pragma unroll
                for (int bj = 0; bj < 2; ++bj) {
                    const u32x4 g = *(const u32x4*)(GATE + row * GATE_LD + MODE * 1024 + col0 + bj * HALF);
                    bf16_t* p = MG + row * 1024 + col0 + bj * HALF;
                    f32x4 v0 = acc[ai][bj][m][0], v1 = acc[ai][bj][m][1];
                    v0[0] *= bflo(g.x); v0[1] *= bfhi(g.x); v0[2] *= bflo(g.y); v0[3] *= bfhi(g.y);
                    v1[0] *= bflo(g.z); v1[1] *= bfhi(g.z); v1[2] *= bflo(g.w); v1[3] *= bfhi(g.w);
                    if (MODE == 1) { const u32x4 o = *(const u32x4*)p;
                        v0[0] += bflo(o.x); v0[1] += bfhi(o.x); v0[2] += bflo(o.y); v0[3] += bfhi(o.y);
                        v1[0] += bflo(o.z); v1[1] += bfhi(o.z); v1[2] += bflo(o.w); v1[3] += bfhi(o.w); }
                    *(u32x4*)p = pack8(v0, v1);
                }
                asm volatile("" ::: "memory");
            }
    }
};
struct EpiMerge2 {
    static constexpr bool AFTER_DRAIN = true; static constexpr bool TWOSEG = true; static constexpr bool PERM = true;
    bf16_t* MG; const bf16_t* GATE;
    DI void mid(f32x4 (&acc)[2][2][4][2], const Unit& u, int wr, int wc, int fr, int fq) const {
        const int row0 = u.pm * BM + wr * 64 + fr, col0 = u.pn * BM + wc * 32 + 8 * fq;
#pragma unroll
        for (int ai = 0; ai < 2; ++ai) {
            u32x4 rr[4][2];
#pragma unroll
            for (int m = 0; m < 4; ++m)
#pragma unroll
                for (int bj = 0; bj < 2; ++bj) rr[m][bj] = *(const u32x4*)(GATE + (size_t)(row0 + ai * HALF + m * 16) * GATE_LD + 1024 + col0 + bj * HALF);
#pragma unroll
            for (int m = 0; m < 4; ++m)
#pragma unroll
                for (int bj = 0; bj < 2; ++bj) { const u32x4 r = rr[m][bj];
                    f32x4& v0 = acc[ai][bj][m][0]; f32x4& v1 = acc[ai][bj][m][1];
                    v0[0] *= bflo(r.x); v0[1] *= bfhi(r.x); v0[2] *= bflo(r.y); v0[3] *= bfhi(r.y);
                    v1[0] *= bflo(r.z); v1[1] *= bfhi(r.z); v1[2] *= bflo(r.w); v1[3] *= bfhi(r.w); }
            asm volatile("" ::: "memory"); }
    }
    DI void operator()(AccRef, const Unit&, int, int, int, int) const {}
    DI void after(AccRef acc, const Unit& u, int wr, int wc, int fr, int fq, LAS unsigned char* lds, int tid) const {
#pragma unroll
        for (int ai = 0; ai < 2; ++ai)
#pragma unroll
            for (int m = 0; m < 4; ++m) { const int r = wr * 64 + ai * HALF + m * 16 + fr;
#pragma unroll
                for (int bj = 0; bj < 2; ++bj) *(LAS u32x4*)(lds + r * 528 + (bj * HALF + wc * 32 + 8 * fq) * 2) = pack8(acc[ai][bj][m][0], acc[ai][bj][m][1]); }
        asm volatile("s_waitcnt lgkmcnt(0)" ::: "memory"); __builtin_amdgcn_s_barrier(); asm volatile("" ::: "memory");
        const int ch = tid & 31, r0 = tid >> 5;
        u32x4 gg[16];
#pragma unroll
        for (int i = 0; i < 16; ++i) gg[i] = *(const u32x4*)(GATE + (size_t)(u.pm * BM + r0 + 16 * i) * GATE_LD + u.pn * BM + ch * 8);
#pragma unroll
        for (int i = 0; i < 16; ++i) {
            const int r = r0 + 16 * i;
            const u32x4 a = *(const LAS u32x4*)(lds + r * 528 + ch * 16);
            const size_t row = (size_t)(u.pm * BM + r); const int col = u.pn * BM + ch * 8;
            const u32x4 g = gg[i];
            f32x4 v0, v1; v0[0] = bflo(a.x) * bflo(g.x); v0[1] = bfhi(a.x) * bfhi(g.x); v0[2] = bflo(a.y) * bflo(g.y); v0[3] = bfhi(a.y) * bfhi(g.y);
            v1[0] = bflo(a.z) * bflo(g.z); v1[1] = bfhi(a.z) * bfhi(g.z); v1[2] = bflo(a.w) * bflo(g.w); v1[3] = bfhi(a.w) * bfhi(g.w);
            *(u32x4*)(MG + row * 1024 + col) = pack8(v0, v1);
        }
    }
};
struct EpiResid {
    static constexpr bool AFTER_DRAIN = false; static constexpr bool TWOSEG = false; static constexpr bool PERM = false;
    const float* res; float* out;
    DI void operator()(AccRef acc, const Unit& u, int wr, int wc, int fr, int fq) const {
        const int row0 = u.pm * BM + wr * 64 + fr, col0 = u.pn * BM + wc * 32 + 4 * fq;
#pragma unroll
        for (int ai = 0; ai < 2; ++ai)
#pragma unroll
            for (int m = 0; m < 4; ++m) { const size_t off = (size_t)(row0 + ai * HALF + m * 16) * D + col0;
#pragma unroll
                for (int bj = 0; bj < 2; ++bj)
#pragma unroll
                    for (int n = 0; n < 2; ++n) { const f32x4 r = *(const f32x4*)(res + off + bj * HALF + n * 16); *(f32x4*)(out + off + bj * HALF + n * 16) = r + acc[ai][bj][m][n]; }
                asm volatile("" ::: "memory"); }
    }
};
template <bool RES_F32> struct EpiResidB {
    static constexpr bool AFTER_DRAIN = true; static constexpr bool TWOSEG = false; static constexpr bool PERM = true;
    const void* res; bf16_t* out; float scale;
    DI void operator()(AccRef, const Unit&, int, int, int, int) const {}
    DI void after(AccRef acc, const Unit& u, int wr, int wc, int fr, int fq, LAS unsigned char* lds, int tid) const {
#pragma unroll
        for (int ai = 0; ai < 2; ++ai)
#pragma unroll
            for (int m = 0; m < 4; ++m) { const int r = wr * 64 + ai * HALF + m * 16 + fr;
#pragma unroll
                for (int bj = 0; bj < 2; ++bj) *(LAS u32x4*)(lds + r * 528 + (bj * HALF + wc * 32 + 8 * fq) * 2) = pack8(acc[ai][bj][m][0] * scale, acc[ai][bj][m][1] * scale); }
        asm volatile("s_waitcnt lgkmcnt(0)" ::: "memory"); __builtin_amdgcn_s_barrier(); asm volatile("" ::: "memory");
        const int ch = tid & 31, r0 = tid >> 5;
#pragma unroll
        for (int i0 = 0; i0 < 16; i0 += 8) {
        f32x4 rf[RES_F32 ? 8 : 1][2]; u32x4 rb[RES_F32 ? 1 : 8];
#pragma unroll
        for (int i = 0; i < 8; ++i) { const size_t off = (size_t)(u.pm * BM + r0 + 16 * (i0 + i)) * D + u.pn * BM + ch * 8;
            if (RES_F32) { const float* rp = (const float*)res + off; rf[RES_F32 ? i : 0][0] = __builtin_nontemporal_load((const f32x4*)rp); rf[RES_F32 ? i : 0][1] = __builtin_nontemporal_load((const f32x4*)(rp + 4)); }
            else rb[RES_F32 ? 0 : i] = *(const u32x4*)((const bf16_t*)res + off); }
#pragma unroll
        for (int i = 0; i < 8; ++i) {
            const int r = r0 + 16 * (i0 + i);
            const u32x4 a = *(const LAS u32x4*)(lds + r * 528 + ch * 16);
            const size_t off = (size_t)(u.pm * BM + r) * D + u.pn * BM + ch * 8;
            f32x4 v0, v1; v0[0] = bflo(a.x); v0[1] = bfhi(a.x); v0[2] = bflo(a.y); v0[3] = bfhi(a.y); v1[0] = bflo(a.z); v1[1] = bfhi(a.z); v1[2] = bflo(a.w); v1[3] = bfhi(a.w);
            if (RES_F32) { v0 = v0 + rf[RES_F32 ? i : 0][0]; v1 = v1 + rf[RES_F32 ? i : 0][1]; }
            else { const u32x4 rr = rb[RES_F32 ? 0 : i];
                v0[0] += bflo(rr.x); v0[1] += bfhi(rr.x); v0[2] += bflo(rr.y); v0[3] += bfhi(rr.y); v1[0] += bflo(rr.z); v1[1] += bfhi(rr.z); v1[2] += bflo(rr.w); v1[3] += bfhi(rr.w); }
            *(u32x4*)(out + off) = pack8(v0, v1);
        }
        }
    }
};
struct EpiSwiGLU {
    static constexpr bool AFTER_DRAIN = false; static constexpr bool TWOSEG = false; static constexpr bool PERM = true;
    bf16_t* H; int ldh; float scale; float oscale;
    DI void operator()(AccRef acc, const Unit& u, int wr, int wc, int fr, int fq) const {
        const int row0 = u.pm * BM + wr * 64 + fr, col0 = u.pn * HALF + wc * 32 + 8 * fq;
#pragma unroll
        for (int ai = 0; ai < 2; ++ai)
#pragma unroll
            for (int m = 0; m < 4; ++m) {
                const f32x4 v0 = silu4(acc[ai][0][m][0] * scale) * (acc[ai][1][m][0] * scale), v1 = silu4(acc[ai][0][m][1] * scale) * (acc[ai][1][m][1] * scale);
                if (oscale != 0.f) { f32x4 w0 = v0 * oscale, w1 = v1 * oscale; u32x2 o;
#pragma unroll
                    for (int i = 0; i < 4; ++i) { w0[i] = __builtin_amdgcn_fmed3f(w0[i], -448.f, 448.f); w1[i] = __builtin_amdgcn_fmed3f(w1[i], -448.f, 448.f); }
                    o.x = __builtin_amdgcn_cvt_pk_fp8_f32(w0[0], w0[1], 0, false); o.x = __builtin_amdgcn_cvt_pk_fp8_f32(w0[2], w0[3], o.x, true);
                    o.y = __builtin_amdgcn_cvt_pk_fp8_f32(w1[0], w1[1], 0, false); o.y = __builtin_amdgcn_cvt_pk_fp8_f32(w1[2], w1[3], o.y, true);
                    __builtin_nontemporal_store(o, (u32x2*)((unsigned char*)H + (size_t)(row0 + ai * HALF + m * 16) * ldh + col0)); }
                else __builtin_nontemporal_store(pack8(v0, v1), (u32x4*)(H + (size_t)(row0 + ai * HALF + m * 16) * ldh + col0));
                asm volatile("" ::: "memory");
            }
    }
};
struct EpiStore {
    static constexpr bool AFTER_DRAIN = false; static constexpr bool TWOSEG = false; static constexpr bool PERM = true;
    bf16_t* O; int ldc; float scale;
    DI void operator()(AccRef acc, const Unit& u, int wr, int wc, int fr, int fq) const {
        const int row0 = u.pm * BM + wr * 64 + fr, col0 = u.pn * BM + wc * 32 + 8 * fq;
#pragma unroll
        for (int ai = 0; ai < 2; ++ai)
#pragma unroll
            for (int m = 0; m < 4; ++m) { bf16_t* rowp = O + (size_t)(row0 + ai * HALF + m * 16) * ldc + col0;
#pragma unroll
                for (int bj = 0; bj < 2; ++bj) *(u32x4*)(rowp + bj * HALF) = pack8(acc[ai][bj][m][0] * scale, acc[ai][bj][m][1] * scale);
                asm volatile("" ::: "memory"); }
    }
};

template <class Epi, class Sched, bool ALIGN_EPI, int QM = 0>
DI void gemm_phase(LAS unsigned char* lds, const Gemm g, const Sched& S, const Epi& E, int tid_in) {
    constexpr bool FP8 = (QM == 1); constexpr bool I8 = (QM == 2);
    int tid_ = tid_in * 64 + lane_id_asm();
    const int tid = tid_, wid = tid_in, lane = tid & 63, wr = wid >> 2, wc = wid & 3, fr = lane & 15, fq = lane >> 4;
    constexpr int EB = QM ? 1 : 2;
    const int K = g.K, lda = g.lda, nt = K * EB / (BK * 2);
    const char* gA = (const char*)g.A; const char* gB = (const char*)g.Bt;
    asm volatile("" : "+s"(gA), "+s"(gB));
    const __amdgpu_buffer_rsrc_t rsA = __builtin_amdgcn_make_buffer_rsrc((void*)gA, 0, 0x7ffff000, 0x00020000), rsB = __builtin_amdgcn_make_buffer_rsrc((void*)gB, 0, 0x7ffff000, 0x00020000);
    unsigned voffA[2], voffB[2];
#pragma unroll
    for (int i = 0; i < 2; ++i) { int R, C; stage_rc(tid * 16 + i * 8192, R, C); const int Rb = Epi::PERM ? ((R & ~31) + perm32(R & 31)) : R;
        voffA[i] = (unsigned)(R * lda * EB + C * 2); voffB[i] = (unsigned)(Rb * K * EB + C * 2); }
    constexpr bool GATHER = Sched::GATHER;
    const unsigned kstep = (unsigned)(BK * 2);
    const unsigned hstepA = GATHER ? 0u : (unsigned)(HALF * lda * EB), hstepB = (unsigned)(HALF * K * EB);
    const unsigned tstepA = GATHER ? 0u : 2u * hstepA, tstepB = 2u * hstepB;
    unsigned va[2][2] = {{0u, 0u}, {0u, 0u}}, vaN[2][2] = {{0u, 0u}, {0u, 0u}};
    const unsigned ldsw = (unsigned)wid * 1024u;
    const int aoff = lds_byte(wr * 64 + fr, fq * 8), boff = lds_byte(wc * 32 + fr, fq * 8);
#define PG8_SA(b, h) (((b) * 2 + (h)) * HTB)
#define PG8_SB(b, h) ((4 + (b) * 2 + (h)) * HTB)
#define PG8_STAGE(bufoff, goff, voff) do { _Pragma("unroll") for (int _i = 0; _i < 2; ++_i) \
        __builtin_amdgcn_raw_ptr_buffer_load_lds(rsB, (LAS unsigned*)(lds + (bufoff) + ldsw + _i * 8192), 16, (voff)[_i], (goff), 0, 0); } while (0)
#define PG8_STAGE_A(bufoff, goff, NX, h) do { _Pragma("unroll") for (int _i = 0; _i < 2; ++_i) \
        __builtin_amdgcn_raw_ptr_buffer_load_lds(rsA, (LAS unsigned*)(lds + (bufoff) + ldsw + _i * 8192), 16, GATHER ? ((NX) ? vaN[h][_i] : va[h][_i]) : voffA[_i], (goff), 0, 0); } while (0)
#define PG8_GOFFS(dst, u) do { int gR0_, gC_; stage_rc((wid * 64 + lane_id_asm()) * 16, gR0_, gC_);     \
        _Pragma("unroll") for (int _h = 0; _h < 2; ++_h) _Pragma("unroll") for (int _i = 0; _i < 2; ++_i) dst[_h][_i] = S.row_off(u, _h * HALF + gR0_ + 64 * _i) + (unsigned)(gC_ * 2); } while (0)
#define PG8_LD32(base) ({ typedef int v4i_t __attribute__((ext_vector_type(4))); const v4i_t lo_ = *(const LAS v4i_t*)(base), hi_ = *(const LAS v4i_t*)((base) + 1024); __builtin_shufflevector(lo_, hi_, 0, 1, 2, 3, 4, 5, 6, 7); })
#define PG8_LDA(dst, b, h) do { if constexpr (FP8) { _Pragma("unroll") for (int m = 0; m < 4; ++m) A8[m] = PG8_LD32(lds + PG8_SA(b, h) + aoff + m * 2048); } \
        else { _Pragma("unroll") for (int m = 0; m < 4; ++m) _Pragma("unroll") for (int k = 0; k < 2; ++k) dst[m][k] = *(const LAS bf16x8*)(lds + PG8_SA(b, h) + aoff + m * 2048 + k * 1024); } } while (0)
#define PG8_LDB(dst, b, h) do { if constexpr (FP8) { _Pragma("unroll") for (int n = 0; n < 2; ++n) dst##8[n] = PG8_LD32(lds + PG8_SB(b, h) + boff + n * 2048); } \
        else { _Pragma("unroll") for (int n = 0; n < 2; ++n) _Pragma("unroll") for (int k = 0; k < 2; ++k) dst[n][k] = *(const LAS bf16x8*)(lds + PG8_SB(b, h) + boff + n * 2048 + k * 1024); } } while (0)
#define PG8_MMA(ai, bj, At, Bt) do { __builtin_amdgcn_s_setprio(1); _Pragma("unroll") for (int m = 0; m < 4; ++m) _Pragma("unroll") for (int n = 0; n < 2; ++n) { \
        if constexpr (FP8) acc[ai][bj][m][n] = __builtin_amdgcn_mfma_scale_f32_16x16x128_f8f6f4(Bt##8[n], A8[m], acc[ai][bj][m][n], 0, 0, 0, 0, 0, 0); \
        else if constexpr (I8) { _Pragma("unroll") for (int k = 0; k < 2; ++k) acc[ai][bj][m][n] = __builtin_bit_cast(f32x4, __builtin_amdgcn_mfma_i32_16x16x64_i8(__builtin_bit_cast(i32x4_t, Bt[n][k]), __builtin_bit_cast(i32x4_t, At[m][k]), __builtin_bit_cast(i32x4_t, acc[ai][bj][m][n]), 0, 0, 0)); } \
        else { _Pragma("unroll") for (int k = 0; k < 2; ++k) acc[ai][bj][m][n] = __builtin_amdgcn_mfma_f32_16x16x32_bf16(Bt[n][k], At[m][k], acc[ai][bj][m][n], 0, 0, 0); } } \
        __builtin_amdgcn_s_setprio(0); } while (0)
#define PG8_WAIT_V(n) asm volatile("s_waitcnt vmcnt(" #n ")" ::: "memory")
#define PG8_WAIT_L(n) asm volatile("s_waitcnt lgkmcnt(" #n ")" ::: "memory")
#define PG8_BAR __builtin_amdgcn_s_barrier()
#define PG8_SCHED __builtin_amdgcn_sched_barrier(0)
    Unit cur, nxt; int ui = 0;
    if (!S.next(0, cur)) return;
    f32x4 acc[2][2][4][2];
#pragma unroll
    for (int a = 0; a < 2; ++a)
#pragma unroll
        for (int b = 0; b < 2; ++b)
#pragma unroll
            for (int m = 0; m < 4; ++m)
#pragma unroll
                for (int n = 0; n < 2; ++n) acc[a][b][m][n] = (f32x4){0.f, 0.f, 0.f, 0.f};
    typedef int v8i_t __attribute__((ext_vector_type(8)));
    bf16x8 At[FP8 ? 1 : 4][2], B0[2][FP8 ? 1 : 2], B1[2][FP8 ? 1 : 2];
    v8i_t A8[FP8 ? 4 : 1], B08[FP8 ? 2 : 1], B18[FP8 ? 2 : 1];
    unsigned cA = (unsigned)cur.aoff + (unsigned)cur.pm * tstepA, cB = (unsigned)cur.boff + (unsigned)cur.pn * tstepB;
    S.a_ready(cur);
    if constexpr (GATHER) PG8_GOFFS(va, cur);
    PG8_STAGE(PG8_SB(0, 0), cB, voffB); PG8_STAGE(PG8_SB(0, 1), cB + hstepB, voffB); PG8_STAGE_A(PG8_SA(0, 0), cA, false, 0); PG8_STAGE_A(PG8_SA(0, 1), cA + hstepA, false, 1);
    if (wr == 1) PG8_BAR;
    PG8_WAIT_V(2); PG8_BAR;
    PG8_STAGE(PG8_SB(1, 0), cB + kstep, voffB); PG8_STAGE_A(PG8_SA(1, 0), cA + kstep, false, 0); PG8_STAGE(PG8_SB(1, 1), cB + hstepB + kstep, voffB);
    PG8_WAIT_V(6); PG8_BAR;
    for (;;) {
        const bool has_next = S.next(ui + 1, nxt);
        if constexpr (GATHER) { if (has_next) PG8_GOFFS(vaN, nxt); else { _Pragma("unroll") for (int _h = 0; _h < 2; ++_h) _Pragma("unroll") for (int _i = 0; _i < 2; ++_i) vaN[_h][_i] = va[_h][_i]; } }
        const unsigned nA = has_next ? (unsigned)nxt.aoff + (unsigned)nxt.pm * tstepA : cA, nB = has_next ? (unsigned)nxt.boff + (unsigned)nxt.pn * tstepB : cB;
#pragma unroll 1
        for (int t = 0; t < nt; t += 2) {
            const bool last = (t == nt - 2);
            const unsigned a1 = cA + (unsigned)(t + 1) * kstep;
            const unsigned a2 = last ? nA : cA + (unsigned)(t + 2) * kstep, b2 = last ? nB : cB + (unsigned)(t + 2) * kstep;
            const unsigned a3 = a2 + kstep, b3 = b2 + kstep;
            if (last && has_next) S.a_ready(nxt);
            PG8_LDB(B0, 0, 0); PG8_LDB(B1, 0, 1); PG8_SCHED; PG8_LDA(At, 0, 0); PG8_STAGE_A(PG8_SA(1, 1), a1 + hstepA, false, 1);
            PG8_WAIT_V(8); PG8_WAIT_L(0); PG8_BAR; PG8_MMA(0, 0, At, B0); PG8_MMA(0, 1, At, B1); PG8_BAR; PG8_SCHED;
            PG8_LDA(At, 0, 1); PG8_STAGE(PG8_SB(0, 0), b2, voffB); PG8_STAGE(PG8_SB(0, 1), b2 + hstepB, voffB); PG8_STAGE_A(PG8_SA(0, 0), a2, last, 0);
            PG8_WAIT_V(8); PG8_WAIT_L(0); PG8_BAR; PG8_MMA(1, 0, At, B0); PG8_MMA(1, 1, At, B1); PG8_BAR; PG8_SCHED;
            PG8_LDB(B0, 1, 0); PG8_LDB(B1, 1, 1); PG8_SCHED; PG8_LDA(At, 1, 0); PG8_STAGE_A(PG8_SA(0, 1), a2 + hstepA, last, 1);
            PG8_WAIT_V(8); PG8_WAIT_L(0); PG8_BAR; PG8_MMA(0, 0, At, B0); PG8_MMA(0, 1, At, B1); PG8_BAR; PG8_SCHED;
            PG8_LDA(At, 1, 1); PG8_STAGE(PG8_SB(1, 0), b3, voffB); PG8_STAGE(PG8_SB(1, 1), b3 + hstepB, voffB); PG8_STAGE_A(PG8_SA(1, 0), a3, last, 0);
            PG8_WAIT_V(8); PG8_WAIT_L(0); PG8_BAR; PG8_MMA(1, 0, At, B0); PG8_MMA(1, 1, At, B1); PG8_BAR; PG8_SCHED;
        }
        if constexpr (ALIGN_EPI) { if (wr == 0) PG8_BAR; }
        if constexpr (I8) { const int l2 = lane_id_asm();
            const float* sAp = g.sA + cur.pm * BM + wr * 64 + (l2 & 15); const float* sBp = g.sB + cur.pn * BM + wc * 32 + 8 * (l2 >> 4);
            float rs[2][4]; f32x4 cs[2][2];
#pragma unroll
            for (int ai = 0; ai < 2; ++ai)
#pragma unroll
                for (int m = 0; m < 4; ++m) rs[ai][m] = sAp[ai * HALF + m * 16];
#pragma unroll
            for (int bj = 0; bj < 2; ++bj)
#pragma unroll
                for (int n = 0; n < 2; ++n) cs[bj][n] = *(const f32x4*)(sBp + bj * HALF + 4 * n);
#pragma unroll
            for (int bj = 0; bj < 2; ++bj)
#pragma unroll
                for (int n = 0; n < 2; ++n) cs[bj][n] = cs[bj][n] * (1.f / 127.f);
#pragma unroll
            for (int ai = 0; ai < 2; ++ai)
#pragma unroll
                for (int m = 0; m < 4; ++m)
#pragma unroll
                    for (int bj = 0; bj < 2; ++bj)
#pragma unroll
                        for (int n = 0; n < 2; ++n) { const i32x4_t iv = __builtin_bit_cast(i32x4_t, acc[ai][bj][m][n]);
                            acc[ai][bj][m][n] = (f32x4){(float)iv[0], (float)iv[1], (float)iv[2], (float)iv[3]} * (cs[bj][n] * rs[ai][m]); }
        }
        { const int l2 = lane_id_asm();
          if constexpr (Epi::TWOSEG) { if (cur.kind == 0) E.mid(acc, cur, wr, wc, l2 & 15, l2 >> 4); else E(acc, cur, wr, wc, l2 & 15, l2 >> 4); }
          else E(acc, cur, wr, wc, l2 & 15, l2 >> 4); } S.done(cur);
        if (!has_next) break;
        if (!(Epi::TWOSEG && cur.kind == 0))
#pragma unroll
        for (int a = 0; a < 2; ++a)
#pragma unroll
            for (int b = 0; b < 2; ++b)
#pragma unroll
                for (int m = 0; m < 4; ++m)
#pragma unroll
                    for (int n = 0; n < 2; ++n) acc[a][b][m][n] = (f32x4){0.f, 0.f, 0.f, 0.f};
        cur = nxt; cA = nA; cB = nB; ++ui;
        if constexpr (GATHER) { _Pragma("unroll") for (int _h = 0; _h < 2; ++_h) _Pragma("unroll") for (int _i = 0; _i < 2; ++_i) va[_h][_i] = vaN[_h][_i]; }
        if constexpr (ALIGN_EPI) { if (wr == 1) PG8_BAR; }
    }
    PG8_WAIT_V(0);
    if constexpr (!ALIGN_EPI) { if (wr == 0) PG8_BAR; }
    PG8_BAR;
    if constexpr (Epi::AFTER_DRAIN) { const int l2 = lane_id_asm(); E.after(acc, cur, wr, wc, l2 & 15, l2 >> 4, lds, wid * 64 + l2); }
#undef PG8_SA
#undef PG8_SB
#undef PG8_STAGE
#undef PG8_STAGE_A
#undef PG8_GOFFS
#undef PG8_LD32
#undef PG8_LDA
#undef PG8_LDB
#undef PG8_MMA
#undef PG8_WAIT_V
#undef PG8_WAIT_L
#undef PG8_BAR
#undef PG8_SCHED
}
}
#define XB_TMO      128
#define XB_XCNT(j)  (256  + 64 * (j))
#define XB_XSUB(j)  (1280 + 64 * (j))
#define XB_XGEN(j)  (2304 + 64 * (j))
#define XB_TOP      3328
#define XB_TOPGEN   3392
#define XCD_BAR_WORDS 3456
#define XB_SPIN_CAP (1u << 18)

__device__ __forceinline__ unsigned xb_ld(unsigned* p)              { return __hip_atomic_load(p, __ATOMIC_RELAXED, __HIP_MEMORY_SCOPE_AGENT); }
__device__ __forceinline__ unsigned xb_add(unsigned* p, unsigned v) { return __hip_atomic_fetch_add(p, v, __ATOMIC_RELAXED, __HIP_MEMORY_SCOPE_AGENT); }
__device__ __forceinline__ unsigned xb_xcc_id() { return (unsigned)__builtin_amdgcn_s_getreg((3 << 11) | 20) & 0xFu; }
#define XB_SPIN(cond, bar) do { unsigned _sp = 0; while (cond) { __builtin_amdgcn_s_sleep(1); \
    if ((++_sp & 255u) == 0u) { if (xb_ld(&(bar)[XB_TMO])) break; if (_sp > XB_SPIN_CAP) { atomicAdd(&(bar)[XB_TMO], 1u); break; } } } } while (0)

struct XcdBarrier {
    unsigned* bar; unsigned x; int wave;
    volatile LAS unsigned* st;
};

__device__ __forceinline__ XcdBarrier xcd_barrier_post(unsigned* bar, volatile LAS unsigned* st) {
    XcdBarrier b; b.bar = bar; b.x = xb_xcc_id(); b.st = st;
    if (threadIdx.x == 0) (void)xb_add(&bar[XB_XCNT(b.x)], 1u);
    return b;
}
__device__ __forceinline__ void xcd_barrier_complete(unsigned* bar, unsigned x, unsigned& nloc, unsigned& nx) {
    const unsigned G = gridDim.x * gridDim.y * gridDim.z;
    unsigned sum, cnt, mine, sp = 0u;
    for (;;) {
        sum = 0u; cnt = 0u; mine = 0u;
#pragma unroll
        for (unsigned j = 0; j < 16; ++j) { const unsigned c = xb_ld(&bar[XB_XCNT(j)]); sum += c; cnt += (c > 0u) ? 1u : 0u; mine = (j == x) ? c : mine; }
        if (sum == G) break;
        __builtin_amdgcn_s_sleep(1);
        if ((++sp & 255u) == 0u) { if (xb_ld(&bar[XB_TMO])) break; if (sp > XB_SPIN_CAP) { atomicAdd(&bar[XB_TMO], 1u); break; } }
    }
    nloc = mine > 0u ? mine : 1u; nx = cnt > 0u ? cnt : 1u;
}

__device__ __noinline__ void xcd_barrier(const XcdBarrier b) {
    asm volatile("s_waitcnt vmcnt(0)" ::: "memory");
    __syncthreads();
    if (b.wave == 0 && lane_id_asm() == 0) {
        unsigned* bar = b.bar;
        __builtin_amdgcn_s_waitcnt(0);
        unsigned nloc = b.st[0], nx = b.st[1];
        if (nloc == 0u) { xcd_barrier_complete(bar, b.x, nloc, nx); b.st[0] = nloc; b.st[1] = nx; }
        const unsigned old = xb_add(&bar[XB_XSUB(b.x)], 1u);
        const unsigned gen = old / nloc;
        if (old + 1u == (gen + 1u) * nloc) {
            __builtin_amdgcn_fence(__ATOMIC_RELEASE, "agent");
            asm volatile("s_waitcnt vmcnt(0)" ::: "memory");
            const unsigned og = xb_add(&bar[XB_TOP], 1u);
            const unsigned tg = og / nx;
            if (og + 1u == (tg + 1u) * nx) xb_add(&bar[XB_TOPGEN], 1u);
            else XB_SPIN(xb_ld(&bar[XB_TOPGEN]) == tg, bar);
            __builtin_amdgcn_fence(__ATOMIC_ACQUIRE, "agent");
            xb_add(&bar[XB_XGEN(b.x)], 1u);
            asm volatile("s_waitcnt vmcnt(0)" ::: "memory");
        } else {
            XB_SPIN(xb_ld(&bar[XB_XGEN(b.x)]) == gen, bar);
            __builtin_amdgcn_fence(__ATOMIC_ACQUIRE, "agent");
            asm volatile("s_waitcnt vmcnt(0)" ::: "memory");
        }
    }
    __syncthreads();
}
namespace att {
constexpr float ATT_THR = 8.f;
constexpr int KROW = 208;
constexpr int KBUF = 64 * KROW;
constexpr int VBUF = 8192;
constexpr int BUF = KBUF + VBUF;
constexpr int WSF_OFF = 3 * BUF;
constexpr int LDS_NEED = WSF_OFF + 8 * 256;
typedef short v4i16_t __attribute__((ext_vector_type(4)));
DI s16x4 vtr(const LAS unsigned char* p) { return __builtin_bit_cast(s16x4, __builtin_amdgcn_ds_read_tr16_b64_v4i16((LAS v4i16_t*)p)); }
DI float xor32_max(float v) { const auto rr = __builtin_amdgcn_permlane32_swap(__float_as_uint(v), __float_as_uint(v), false, false); return fmaxf(__uint_as_float(rr[0]), __uint_as_float(rr[1])); }
DI bf16x8 pack_p(const f32x16& x, int s) {
    u32x4 p;
    p.x = pg8::cvt_pk_bf16(x[8 * s + 0], x[8 * s + 1]); p.y = pg8::cvt_pk_bf16(x[8 * s + 2], x[8 * s + 3]);
    p.z = pg8::cvt_pk_bf16(x[8 * s + 4], x[8 * s + 5]); p.w = pg8::cvt_pk_bf16(x[8 * s + 6], x[8 * s + 7]);
    return __builtin_bit_cast(bf16x8, p);
}

DI void qk_tile(f32x16& s0, f32x16& s1, const LAS unsigned char* buf, int koff, const bf16x8 (&qf)[6], const f32x16& negv) {
    s0 = negv; s1 = negv;
    __builtin_amdgcn_s_setprio(1);
#pragma unroll
    for (int ks = 0; ks < 6; ++ks) {
        const bf16x8 a0 = *(const LAS bf16x8*)(buf + koff + ks * 32);
        const bf16x8 a1 = *(const LAS bf16x8*)(buf + koff + 32 * KROW + ks * 32);
        s0 = __builtin_amdgcn_mfma_f32_32x32x16_bf16(a0, qf[ks], s0, 0, 0, 0);
        s1 = __builtin_amdgcn_mfma_f32_32x32x16_bf16(a1, qf[ks], s1, 0, 0, 0);
    }
    __builtin_amdgcn_s_setprio(0);
}
DI void attn_unit(LAS unsigned char* lds, const bf16_t* Q, const bf16_t* K, const bf16_t* V, bf16_t* AO, int b, int h, int qb, int tid_, int wave, int lane_) {
    const int lane = lane_id_asm(), tid = wave * 64 + lane; (void)tid_; (void)lane_;
    const int r32 = lane & 31, hi = lane >> 5;
    const int NT = 4 * (qb + 1);
    const size_t rowbase = (size_t)b * SEQ;
    const int q0 = qb * 256 + wave * 32;
    const int cw = q0 >> 6;
    bf16x8 qf[6];
    { const bf16_t* qp = Q + (rowbase + q0 + r32) * 768 + h * 96 + hi * 8;
#pragma unroll
      for (int ks = 0; ks < 6; ++ks) qf[ks] = *(const bf16x8*)(qp + ks * 16); }
    f32x16 o0, o1;
#pragma unroll
    for (int r = 0; r < 16; ++r) { o0[r] = 0.f; o1[r] = 0.f; }
    float mref = 0.f, lrun = 0.f, pend = 0.f;
    f32x16 negv;
#pragma unroll
    for (int r = 0; r < 16; ++r) negv[r] = 0.f;
    const int vkey = tid >> 3, vc = tid & 7;
    const bf16_t* vsrc = V + (rowbase + vkey) * 512 + h * 64 + vc * 8;
    const int vdst = KBUF + (vc >> 2) * 4096 + vkey * 64 + (vc & 3) * 16;
    const int ka = tid / 12, kac = tid - ka * 12;
    const bf16_t* ksrc0 = K + (rowbase + ka) * 768 + h * 96 + kac * 8;
    const int kdst0 = ka * KROW + kac * 16;
    const int i1 = tid + 512, kb = i1 / 12, kbc = i1 - kb * 12;
    const bf16_t* ksrc1 = K + (rowbase + kb) * 768 + h * 96 + kbc * 8;
    const int kdst1 = kb * KROW + kbc * 16;
    const bool has1 = tid < 256;
    u32x4 rk0, rk1 = (u32x4){0u, 0u, 0u, 0u}, rv;
#pragma unroll
    for (int t0 = 0; t0 < 2; ++t0) {
        const size_t adv = (size_t)t0 * 64;
        rk0 = *(const u32x4*)(ksrc0 + adv * 768); if (has1) rk1 = *(const u32x4*)(ksrc1 + adv * 768); rv = *(const u32x4*)(vsrc + adv * 512);
        LAS unsigned char* d = lds + t0 * BUF;
        *(LAS u32x4*)(d + kdst0) = rk0; if (has1) *(LAS u32x4*)(d + kdst1) = rk1; *(LAS u32x4*)(d + vdst) = rv;
    }
    { const size_t adv = (size_t)2 * 64; rk0 = *(const u32x4*)(ksrc0 + adv * 768); if (has1) rk1 = *(const u32x4*)(ksrc1 + adv * 768); rv = *(const u32x4*)(vsrc + adv * 512); }
    lds_barrier();
    LAS float* wsf = (LAS float*)(lds + WSF_OFF + wave * 256);
    const int koff = r32 * KROW + hi * 16;
    const int voff = KBUF + (((lane >> 4) & 1) * 16 + (lane & 3) * 4) * 2 + (4 * hi + ((lane & 15) >> 2)) * 64;
    f32x16 sa0, sa1, sb0, sb1;
    qk_tile(sa0, sa1, lds, koff, qf, negv);
    int scur = 0, snxt = BUF, sfree = 2 * BUF;
#define ATT_STEP(SA0, SA1, SB0, SB1) do { \
        if (t + 2 < NT) { LAS unsigned char* d = lds + sfree; *(LAS u32x4*)(d + kdst0) = rk0; if (has1) *(LAS u32x4*)(d + kdst1) = rk1; *(LAS u32x4*)(d + vdst) = rv; }     \
        if (t + 3 < NT) { const size_t adv = (size_t)(t + 3) * 64; rk0 = *(const u32x4*)(ksrc0 + adv * 768); if (has1) rk1 = *(const u32x4*)(ksrc1 + adv * 768); rv = *(const u32x4*)(vsrc + adv * 512); } \
        const bool act = (t <= cw), actn = (t + 1 <= cw) && (t + 1 < NT); \
        if (actn) qk_tile(SB0, SB1, lds + snxt, koff, qf, negv);         \
        if (act) { \
            if (__any(pend != 0.f)) {                                        \
                _Pragma("unroll") for (int r = 0; r < 16; ++r) { SA0[r] -= pend; SA1[r] -= pend; } \
            } \
            float mx = SA0[0]; \
            _Pragma("unroll") for (int r = 0; r < 16; ++r) mx = __builtin_fmaxf(__builtin_fmaxf(mx, SA0[r]), SA1[r]); \
            mx = xor32_max(mx); \
            pend = 0.f; \
            if (t == 0 || __any(mx > ATT_THR)) {                             \
                const float dl = (t == 0) ? mx : __builtin_fmaxf(mx, 0.f); \
                mref += dl; pend = dl; \
                _Pragma("unroll") for (int r = 0; r < 16; ++r) { SA0[r] -= dl; SA1[r] -= dl; negv[r] = -mref; } \
                if (t != 0) {                                                   \
                    const float f = __builtin_amdgcn_exp2f(-dl); \
                    lrun *= f; \
                    if (hi == 0) wsf[r32] = f; \
                    LDS_WAIT(); \
                    _Pragma("unroll") for (int g = 0; g < 4; ++g) { const f32x4 fv = *(const LAS f32x4*)(wsf + 8 * g + 4 * hi); \
                        _Pragma("unroll") for (int j = 0; j < 4; ++j) { o0[4 * g + j] *= fv[j]; o1[4 * g + j] *= fv[j]; } } \
                } \
            } \
            float ps = 0.f; \
            _Pragma("unroll") for (int r = 0; r < 16; ++r) { SA0[r] = __builtin_amdgcn_exp2f(SA0[r]); SA1[r] = __builtin_amdgcn_exp2f(SA1[r]); ps += SA0[r] + SA1[r]; } \
            lrun += ps; \
            const LAS unsigned char* cur = lds + scur; \
            _Pragma("unroll") for (int s = 0; s < 4; ++s) { \
                const bf16x8 pa = pack_p((s < 2) ? SA0 : SA1, s & 1); \
                const LAS unsigned char* vp = cur + voff + s * 16 * 64; \
                const s16x4 l0 = vtr(vp), h0 = vtr(vp + 8 * 64), l1 = vtr(vp + 4096), h1 = vtr(vp + 4096 + 8 * 64); \
                const bf16x8 vb0 = (bf16x8){l0[0], l0[1], l0[2], l0[3], h0[0], h0[1], h0[2], h0[3]}; \
                const bf16x8 vb1 = (bf16x8){l1[0], l1[1], l1[2], l1[3], h1[0], h1[1], h1[2], h1[3]}; \
                o0 = __builtin_amdgcn_mfma_f32_32x32x16_bf16(pa, vb0, o0, 0, 0, 0); \
                o1 = __builtin_amdgcn_mfma_f32_32x32x16_bf16(pa, vb1, o1, 0, 0, 0); \
            } \
        } \
        lds_barrier(); \
        { const int tmp = scur; scur = snxt; snxt = sfree; sfree = tmp; } \
    } while (0)
#pragma unroll 1
    for (int t2 = 0; t2 < NT; t2 += 2) {
        { const int t = t2; ATT_STEP(sa0, sa1, sb0, sb1); }
        { const int t = t2 + 1; ATT_STEP(sb0, sb1, sa0, sa1); }
    }
#undef ATT_STEP
    lrun = xor32_sum(lrun);
    if (hi == 0) wsf[r32] = __builtin_amdgcn_rcpf(lrun);
    LDS_WAIT();
    bf16_t* op = AO + (rowbase + q0) * 512 + h * 64 + r32;
#pragma unroll
    for (int g = 0; g < 4; ++g) { const f32x4 fv = *(const LAS f32x4*)(wsf + 8 * g + 4 * hi);
#pragma unroll
        for (int j = 0; j < 4; ++j) { const int q = 8 * g + 4 * hi + j;
            op[(size_t)q * 512] = (bf16_t)f2bf(o0[4 * g + j] * fv[j]); op[(size_t)q * 512 + 32] = (bf16_t)f2bf(o1[4 * g + j] * fv[j]); } }
    LDS_WAIT();
    __syncthreads();
}
}

DI void gdn_gate_rows(int gw, int NGW, int lane, const float* ORAW, const bf16_t* Zb, const float* out_norm, bf16_t* GO) {
    const int c0 = lane * 8, e0 = c0 & 127;
    const f32x4 n0 = *(const f32x4*)(out_norm + e0), n1 = *(const f32x4*)(out_norm + e0 + 4);
    f32x4 na = (f32x4){0.f, 0.f, 0.f, 0.f}, nb = na; u32x4 nz = (u32x4){0u, 0u, 0u, 0u};
    if (gw < M) { const GAS f32x4* o4 = (const GAS f32x4*)(ORAW + (size_t)gw * 512 + c0); na = o4[0]; nb = o4[1]; nz = *(const GAS u32x4*)(Zb + (size_t)gw * Z_LD + c0); }
    for (int m = gw; m < M; m += NGW) {
        f32x4 a = na, b = nb; u32x4 zz = nz;
        asm volatile("" : "+v"(a), "+v"(b), "+v"(zz));
        if (m + NGW < M) { const GAS f32x4* o4 = (const GAS f32x4*)(ORAW + (size_t)(m + NGW) * 512 + c0); na = o4[0]; nb = o4[1]; nz = *(const GAS u32x4*)(Zb + (size_t)(m + NGW) * Z_LD + c0); }
        float ss = (a.x * a.x + a.y * a.y) + (a.z * a.z + a.w * a.w) + (b.x * b.x + b.y * b.y) + (b.z * b.z + b.w * b.w);
        ss += swz_xor<1>(ss); ss += swz_xor<2>(ss); ss += swz_xor<4>(ss); ss += swz_xor<8>(ss);
        const float r = rsqrtf(ss * (1.f / 128.f) + EPS);
        u32x4 o;
        o.x = pk2(a.x * r * n0.x * siluf(bflo(zz.x)), a.y * r * n0.y * siluf(bfhi(zz.x)));
        o.y = pk2(a.z * r * n0.z * siluf(bflo(zz.y)), a.w * r * n0.w * siluf(bfhi(zz.y)));
        o.z = pk2(b.x * r * n1.x * siluf(bflo(zz.z)), b.y * r * n1.y * siluf(bfhi(zz.z)));
        o.w = pk2(b.z * r * n1.z * siluf(bflo(zz.w)), b.w * r * n1.w * siluf(bfhi(zz.w)));
        *(GAS u32x4*)(GO + (size_t)m * 512 + c0) = o;
    }
}

DI void mla_prep_rows(int gw, int NGW, int lane, const bf16_t* MISC, float* rstdq, float* rstdkv) {
    unsigned nq[3] = {0u, 0u, 0u}, nk[2] = {0u, 0u};
#define MLA_ISSUE(mm) do { const bf16_t* pr_ = MISC + (size_t)(mm) * MISC_LD; \
        _Pragma("unroll") for (int i = 0; i < 3; ++i) nq[i] = *(const GAS unsigned*)(pr_ + MC_CQ + 2 * lane + 128 * i); \
        _Pragma("unroll") for (int i = 0; i < 2; ++i) nk[i] = *(const GAS unsigned*)(pr_ + MC_CKV + 2 * lane + 128 * i); } while (0)
    if (gw < M) MLA_ISSUE(gw);
    for (int m = gw; m < M; m += NGW) {
        unsigned q0 = nq[0], q1 = nq[1], q2 = nq[2], k0 = nk[0], k1 = nk[1];
        asm volatile("" : "+v"(q0), "+v"(q1), "+v"(q2), "+v"(k0), "+v"(k1));
        if (m + NGW < M) MLA_ISSUE(m + NGW);
        float ss = (bflo(q0) * bflo(q0) + bfhi(q0) * bfhi(q0)) + (bflo(q1) * bflo(q1) + bfhi(q1) * bfhi(q1)) + (bflo(q2) * bflo(q2) + bfhi(q2) * bfhi(q2));
        ss = wave_sum(ss);
        const float rq = rsqrtf(ss * (1.f / 384.f) + EPS);
        ss = (bflo(k0) * bflo(k0) + bfhi(k0) * bfhi(k0)) + (bflo(k1) * bflo(k1) + bfhi(k1) * bfhi(k1));
        ss = wave_sum(ss);
        const float rkv = rsqrtf(ss * (1.f / 256.f) + EPS);
        if (lane == 0) { rstdq[m] = rq; rstdkv[m] = rkv; }
    }
#undef MLA_ISSUE
}
DI void mla_kpe_rows(int gw, int NGW, int lane, const bf16_t* MISC, const float* COS, const float* SIN, bf16_t* Kb) {
    const int sub = lane >> 4, j = lane & 15;
    for (int m = 4 * gw + sub; m < M; m += 4 * NGW) {
        const bf16_t* pr = MISC + (size_t)m * MISC_LD;
        const float c = COS[(size_t)m * 16 + j], s = SIN[(size_t)m * 16 + j];
        const float t1 = bf2f(pr[MC_KR + j]), t2 = bf2f(pr[MC_KR + 16 + j]);
        const bf16_t o1 = (bf16_t)f2bf(t1 * c - t2 * s), o2 = (bf16_t)f2bf(t2 * c + t1 * s);
#pragma unroll
        for (int h = 0; h < 8; ++h) { Kb[(size_t)m * 768 + h * 96 + 64 + j] = o1; Kb[(size_t)m * 768 + h * 96 + 80 + j] = o2; }
    }
}

namespace gdn {
constexpr int ROWB = 272;
constexpr int GV = 0, LS = 1024, PART = 18432, QS = 26624, KS = 44032, VS = 61440;
constexpr int LDS_NEED = VS + 17408;


constexpr int T_GV = 0, T_LS = 1024, T_PART = 1024  , T_QS = 18432, T_KS = 35840, T_VS = 53248, TEAM_LDS = 70656;
DI void conv8(float (&y)[8][8], float (&ps)[8], const bf16_t* QKV, const float* conv_w, size_t m0, int c, int ch, int rg) {
    f32x4 cw[4][2];
#pragma unroll
    for (int j = 0; j < 4; ++j) { cw[j][0] = *(const f32x4*)(conv_w + j * 1536 + ch); cw[j][1] = *(const f32x4*)(conv_w + j * 1536 + ch + 4); }
    u32x4 xw[11];
#pragma unroll
    for (int i = 0; i < 11; ++i) {
        const int row = 8 * rg - 3 + i;
        xw[i] = (u32x4){0u, 0u, 0u, 0u};
        if (row >= 0 || c > 0) xw[i] = *(const GAS u32x4*)((const GAS char*)(QKV + (m0 - 3) * QKV_LD) + (unsigned)(((row + 3) * QKV_LD + ch) * 2));
    }
#pragma unroll
    for (int r = 0; r < 8; ++r) {
        float p = 0.f;
#pragma unroll
        for (int i = 0; i < 8; ++i) {
            float a = 0.f;
#pragma unroll
            for (int j = 0; j < 4; ++j) { const unsigned w = xw[r + j][i >> 1]; a += cw[j][i >> 2][i & 3] * ((i & 1) ? bfhi(w) : bflo(w)); }
            a = siluf(a); y[r][i] = a; p += a * a;
        }
        ps[r] = p;
    }
}
DI void local_pair(LAS unsigned char* lds_, const bf16_t* QKV, const bf16_t* MISC, const float* conv_w, const float* a_log, const float* dt_bias,
                   bf16_t* UT, bf16_t* Wb, bf16_t* QD, bf16_t* KDT, bf16_t* AT, float* CD, int up, int wave8) {
    const int lane = lane_id_asm();
    const int team = wave8 >> 2, w4 = wave8 & 3, un = 2 * up + team;
    LAS unsigned char* lds = lds_ + team * TEAM_LDS;
    const int bh = un >> 5, c = un & 31, b = bh >> 2, h = bh & 3;
    const size_t m0 = (size_t)b * SEQ + (size_t)c * 64;
    unsigned vz = 0u; asm volatile("" : "+v"(vz));
    LAS unsigned char* ldv = lds + vz;
    LAS float* Gs = (LAS float*)(ldv + T_GV); LAS float* Bs = Gs + 64; LAS float* EGs = Gs + 128; LAS float* ELs = Gs + 192;
    const int cg = lane & 15, rg = 4 * (w4 & 1) + (lane >> 4);
    if (w4 < 2) {
        float y[8][8], ps[8];
        conv8(y, ps, QKV, conv_w, m0, c, 1024 + h * 128 + cg * 8, rg);
#pragma unroll
        for (int r = 0; r < 8; ++r) { u32x4 w; w.x = pk2(y[r][0], y[r][1]); w.y = pk2(y[r][2], y[r][3]); w.z = pk2(y[r][4], y[r][5]); w.w = pk2(y[r][6], y[r][7]);
            *(LAS u32x4*)(lds + T_VS + (8 * rg + r) * ROWB + cg * 16) = w; }
    } else if (w4 == 2) {
        const size_t m = m0 + lane;
        const float a = bf2f(MISC[m * MISC_LD + MC_A + h]) + dt_bias[h];
        const float ea = __expf(a);
        const float sp = a > 20.f ? a : (ea < 0.015625f ? ea * (1.f - ea * (0.5f - ea * (1.f / 3.f - 0.25f * ea))) : __logf(1.f + ea));
        const float g = -__expf(a_log[h]) * sp;
        Bs[lane] = sigmf(bf2f(MISC[m * MISC_LD + MC_B + h]));
        Gs[lane] = g;
        LDS_WAIT();
        float G = 0.f;
#pragma unroll
        for (int j4 = 0; j4 < 16; ++j4) { const f32x4 gv = *(const LAS f32x4*)(Gs + 4 * j4);
#pragma unroll
            for (int jj = 0; jj < 4; ++jj) G += (4 * j4 + jj <= lane) ? gv[jj] : 0.f; }
        const float GL = __int_as_float(__builtin_amdgcn_readlane(__float_as_int(G), 63));
        LDS_WAIT();
        Gs[lane] = G; EGs[lane] = __expf(G); ELs[lane] = __expf(GL - G);
        if (lane == 63) CD[un] = __expf(GL);
    }
    const int mat = w4 >> 1;
    float y[8][8];
    {
        float ps[8];
        conv8(y, ps, QKV, conv_w, m0, c, mat * 512 + h * 128 + cg * 8, rg);
#pragma unroll
        for (int r = 0; r < 8; ++r) ((LAS float*)(lds + T_PART))[(mat * 64 + 8 * rg + r) * 16 + cg] = ps[r];
    }
    lds_barrier();
    {
        LAS unsigned char* tile = lds + (mat == 0 ? T_QS : T_KS);
#pragma unroll
        for (int r = 0; r < 8; ++r) {
            const LAS f32x4* pp = (const LAS f32x4*)(ldv + T_PART) + (mat * 64 + 8 * rg + r) * 4;
            const f32x4 p0 = pp[0], p1 = pp[1], p2 = pp[2], p3 = pp[3];
            const float ss = ((p0.x + p0.y) + (p0.z + p0.w)) + ((p1.x + p1.y) + (p1.z + p1.w)) + ((p2.x + p2.y) + (p2.z + p2.w)) + ((p3.x + p3.y) + (p3.z + p3.w));
            const float rn = rsqrtf(ss + EPS) * (mat == 0 ? 0.08838834764831845f : 1.f);
            const int row = 8 * rg + r;
            u32x4 w; w.x = pk2(y[r][0] * rn, y[r][1] * rn); w.y = pk2(y[r][2] * rn, y[r][3] * rn); w.z = pk2(y[r][4] * rn, y[r][5] * rn); w.w = pk2(y[r][6] * rn, y[r][7] * rn);
            *(LAS u32x4*)(tile + row * ROWB + cg * 16) = w;
            if (mat == 0) {
                const float eg = EGs[row];
                u32x4 d; d.x = pk2(bflo(w.x) * eg, bfhi(w.x) * eg); d.y = pk2(bflo(w.y) * eg, bfhi(w.y) * eg); d.z = pk2(bflo(w.z) * eg, bfhi(w.z) * eg); d.w = pk2(bflo(w.w) * eg, bfhi(w.w) * eg);
                *(GAS u32x4*)(QD + (((size_t)un * 16 + (row >> 4) * 4 + (cg >> 2)) * 64 + (row & 15) + 16 * (cg & 3)) * 8) = d;
            }
        }
    }
    lds_barrier();
    {
        const int r32 = lane & 31, hi = lane >> 5, bi = w4 >> 1, bj = w4 & 1;
        const int j = 32 * bj + r32; const float Gj = Gs[j];
#pragma unroll
        for (int pass = 0; pass < 2; ++pass) {
            const bool qk = pass == 1;
            f32x16 acc;
#pragma unroll
            for (int r = 0; r < 16; ++r) acc[r] = 0.f;
            if (w4 != 1) {
                const LAS unsigned char* At = lds + (qk ? T_QS : T_KS) + (32 * bi + r32) * ROWB + hi * 16;
                const LAS unsigned char* Bt = lds + T_KS + (32 * bj + r32) * ROWB + hi * 16;
#pragma unroll
                for (int ks = 0; ks < 8; ++ks) acc = __builtin_amdgcn_mfma_f32_32x32x16_bf16(*(const LAS bf16x8*)(At + ks * 32), *(const LAS bf16x8*)(Bt + ks * 32), acc, 0, 0, 0);
            }
#pragma unroll
            for (int g4 = 0; g4 < 4; ++g4) {
                const int ib = 32 * bi + 8 * g4 + 4 * hi;
                const f32x4 Gi = *(const LAS f32x4*)(Gs + ib), Bi = *(const LAS f32x4*)(Bs + ib);
#pragma unroll
                for (int jj = 0; jj < 4; ++jj) {
                    const int i = ib + jj; const float d = __expf(Gi[jj] - Gj); const float cv = acc[4 * g4 + jj];
                    if (!qk) ((LAS float*)(lds + T_LS))[i * 68 + j] = (i > j) ? Bi[jj] * cv * d : 0.f;
                    else AT[(((size_t)un * 8 + (i >> 4) * 2 + (j >> 5)) * 64 + (i & 15) + 16 * ((j & 31) >> 3)) * 8 + (j & 7)] = (bf16_t)f2bf((i >= j) ? cv * d : 0.f);
                }
            }
        }
    }
    lds_barrier();
    {
        const int col = 64 * w4 + lane;
        const bool isk = w4 >= 2;
        const LAS unsigned char* src = lds + (isk ? T_KS : T_VS) + (col & 127) * 2;
        f32x2 sol[32];
#pragma unroll
        for (int t = 0; t < 32; ++t) { sol[t].x = bf2f(*(const LAS bf16_t*)(src + (2 * t) * ROWB)); sol[t].y = bf2f(*(const LAS bf16_t*)(src + (2 * t + 1) * ROWB)); }
        if (isk) {
            const int dkk = col & 127;
#pragma unroll
            for (int t8 = 0; t8 < 8; ++t8) { const f32x4 e0 = *(const LAS f32x4*)(ELs + 8 * t8), e1 = *(const LAS f32x4*)(ELs + 8 * t8 + 4);
                u32x4 w; w.x = pk2(sol[4 * t8].x * e0.x, sol[4 * t8].y * e0.y); w.y = pk2(sol[4 * t8 + 1].x * e0.z, sol[4 * t8 + 1].y * e0.w);
                w.z = pk2(sol[4 * t8 + 2].x * e1.x, sol[4 * t8 + 2].y * e1.y); w.w = pk2(sol[4 * t8 + 3].x * e1.z, sol[4 * t8 + 3].y * e1.w);
                *(GAS u32x4*)(KDT + (((size_t)un * 16 + (dkk >> 4) * 2 + (t8 >> 2)) * 64 + (dkk & 15) + 16 * (t8 & 3)) * 8) = w; }
        }
#pragma unroll
        for (int t4 = 0; t4 < 16; ++t4) { const f32x4 bb = *(const LAS f32x4*)(Bs + 4 * t4); f32x4 ee = (f32x4){1.f, 1.f, 1.f, 1.f}; if (isk) ee = *(const LAS f32x4*)(EGs + 4 * t4);
            sol[2 * t4].x *= bb[0] * ee[0]; sol[2 * t4].y *= bb[1] * ee[1]; sol[2 * t4 + 1].x *= bb[2] * ee[2]; sol[2 * t4 + 1].y *= bb[3] * ee[3]; }
        const LAS float* Lm = (const LAS float*)(ldv + T_LS);
        f32x4 La[8], Lb[8]; f32x2 acc = (f32x2){0.f, 0.f};
#define GL_INFO(sx) const int i_ = (sx) < 32 ? (sx) + 1 : 33 + (((sx) - 32) >> 1); const int tot_ = (i_ + 3) / 4; const int q0_ = ((sx) >= 32 && (((sx) - 32) & 1)) ? 8 : 0; const int nq_ = (sx) < 32 ? tot_ : ((((sx) - 32) & 1) ? tot_ - 8 : 8)
#define GL_LOAD(buf, sx) do { GL_INFO(sx); _Pragma("unroll") for (int q_ = 0; q_ < nq_; ++q_) buf[q_] = *(const LAS f32x4*)(Lm + i_ * 68 + 4 * (q0_ + q_)); } while (0)
#define GL_APPLY(buf, sx) do { GL_INFO(sx); if (q0_ == 0) acc = (f32x2){(i_ & 1) ? sol[i_ >> 1].y : sol[i_ >> 1].x, 0.f}; \
            _Pragma("unroll") for (int q_ = 0; q_ < nq_; ++q_) { acc = acc - (f32x2){buf[q_].x, buf[q_].y} * sol[2 * (q0_ + q_)]; acc = acc - (f32x2){buf[q_].z, buf[q_].w} * sol[2 * (q0_ + q_) + 1]; } \
            if (q0_ + nq_ == tot_) { if (i_ & 1) sol[i_ >> 1].y = acc.x + acc.y; else sol[i_ >> 1].x = acc.x + acc.y; } } while (0)
        GL_LOAD(La, 0);
#pragma unroll
        for (int sx = 0; sx < 94; sx += 2) {
            GL_LOAD(Lb, sx + 1);
            __builtin_amdgcn_sched_barrier(0);
            GL_APPLY(La, sx);
            if (sx + 2 < 94) GL_LOAD(La, sx + 2);
            __builtin_amdgcn_sched_barrier(0);
            GL_APPLY(Lb, sx + 1);
        }
#undef GL_INFO
#undef GL_LOAD
#undef GL_APPLY
        if (!isk) {
            GAS u32x4* upp = (GAS u32x4*)(UT + ((size_t)un * 128 + col) * 64);
#pragma unroll
            for (int t8 = 0; t8 < 8; ++t8) { u32x4 w; w.x = pk2(sol[4 * t8].x, sol[4 * t8].y); w.y = pk2(sol[4 * t8 + 1].x, sol[4 * t8 + 1].y); w.z = pk2(sol[4 * t8 + 2].x, sol[4 * t8 + 2].y); w.w = pk2(sol[4 * t8 + 3].x, sol[4 * t8 + 3].y); upp[t8] = w; }
        } else {
            const int dk = col & 127;
            bf16_t* wp = Wb + (((size_t)un * 16 + (dk >> 5)) * 64 + 16 * ((dk & 31) >> 3)) * 8 + (dk & 7);
#pragma unroll
            for (int t = 0; t < 64; ++t) wp[(((t >> 4) * 4) * 64 + (t & 15)) * 8] = (bf16_t)f2bf((t & 1) ? sol[t >> 1].y : sol[t >> 1].x);
        }
    }
    lds_barrier();
}

constexpr int ST_OFF = 0, ST_ROWB = 272, VN_OFF = 4352, VN_ROWB = 144, SCAN_LDS = VN_OFF + 16 * VN_ROWB;
struct Frag { bf16x8 w[4], qd[4], at[2], kd[2][2]; u32x2 u; float cd; };
struct ScanRs { __amdgpu_buffer_rsrc_t w, qd, kdt, at, ut; const float* CD; };
DI ScanRs scan_rs(const bf16_t* UT, const bf16_t* Wb, const bf16_t* QD, const bf16_t* KDT, const bf16_t* AT, const float* CD) {
    ScanRs r; r.w = __builtin_amdgcn_make_buffer_rsrc((void*)Wb, 0, 0x7ffff000, 0x00020000); r.qd = __builtin_amdgcn_make_buffer_rsrc((void*)QD, 0, 0x7ffff000, 0x00020000);
    r.kdt = __builtin_amdgcn_make_buffer_rsrc((void*)KDT, 0, 0x7ffff000, 0x00020000); r.at = __builtin_amdgcn_make_buffer_rsrc((void*)AT, 0, 0x7ffff000, 0x00020000);
    r.ut = __builtin_amdgcn_make_buffer_rsrc((void*)UT, 0, 0x7ffff000, 0x00020000); r.CD = CD; return r;
}
DI bf16x8 ld128(__amdgpu_buffer_rsrc_t rs, unsigned voff, unsigned soff) { return __builtin_bit_cast(bf16x8, __builtin_amdgcn_raw_buffer_load_b128(rs, voff, soff, 0)); }
DI void load_frag(Frag& f, const ScanRs& R, int un, int sl, int wave, unsigned vl16, unsigned vut) {
    const unsigned sw = (unsigned)((un * 16 + wave * 4) * 1024);
#pragma unroll
    for (int ks = 0; ks < 4; ++ks) { f.w[ks] = ld128(R.w, vl16, sw + ks * 1024); f.qd[ks] = ld128(R.qd, vl16, sw + ks * 1024); }
    const unsigned sa = (unsigned)((un * 8 + wave * 2) * 1024);
#pragma unroll
    for (int ks = 0; ks < 2; ++ks) f.at[ks] = ld128(R.at, vl16, sa + ks * 1024);
#pragma unroll
    for (int rb = 0; rb < 2; ++rb) { const unsigned sk = (unsigned)((un * 16 + (2 * wave + rb) * 2) * 1024);
#pragma unroll
        for (int ks = 0; ks < 2; ++ks) f.kd[rb][ks] = ld128(R.kdt, vl16, sk + ks * 1024); }
    f.u = __builtin_bit_cast(u32x2, __builtin_amdgcn_raw_buffer_load_b64(R.ut, vut, (unsigned)(((un * 128 + 16 * sl) * 64 + 16 * wave) * 2), 0));
    f.cd = R.CD[un];
}
DI void scan_step(LAS unsigned char* lds, const Frag& cur, f32x4& S0, f32x4& S1, __amdgpu_buffer_rsrc_t ro, unsigned vo, int n, int b, int h, int sl, int wave, int e, int kc) {
    f32x4 oq = (f32x4){0.f, 0.f, 0.f, 0.f};
    {
        f32x4 ws = (f32x4){0.f, 0.f, 0.f, 0.f};
#pragma unroll
        for (int ks = 0; ks < 4; ++ks) { const bf16x8 sb = *(const LAS bf16x8*)(lds + ST_OFF + e * ST_ROWB + (32 * ks + 8 * kc) * 2);
            ws = __builtin_amdgcn_mfma_f32_16x16x32_bf16(cur.w[ks], sb, ws, 0, 0, 0);
            oq = __builtin_amdgcn_mfma_f32_16x16x32_bf16(cur.qd[ks], sb, oq, 0, 0, 0); }
        const float v0 = bflo(cur.u.x) - ws[0], v1 = bfhi(cur.u.x) - ws[1], v2 = bflo(cur.u.y) - ws[2], v3 = bfhi(cur.u.y) - ws[3];
        u32x2 vw; vw.x = pk2(v0, v1); vw.y = pk2(v2, v3);
        *(LAS u32x2*)(lds + VN_OFF + e * VN_ROWB + (16 * wave + 4 * kc) * 2) = vw;
    }
    lds_barrier();
    {
        bf16x8 vb[2];
#pragma unroll
        for (int ks = 0; ks < 2; ++ks) vb[ks] = *(const LAS bf16x8*)(lds + VN_OFF + e * VN_ROWB + (32 * ks + 8 * kc) * 2);
#pragma unroll
        for (int ks = 0; ks < 2; ++ks) oq = __builtin_amdgcn_mfma_f32_16x16x32_bf16(cur.at[ks], vb[ks], oq, 0, 0, 0);
        const unsigned so = (unsigned)((((b * SEQ + 64 * n + 16 * wave) * 512) + h * 128 + 16 * sl) * 4);
#pragma unroll
        for (int i = 0; i < 4; ++i) __builtin_amdgcn_raw_buffer_store_b32(__float_as_uint(oq[i]), ro, vo + i * 2048, so, 0);
        S0 = S0 * cur.cd; S1 = S1 * cur.cd;
#pragma unroll
        for (int ks = 0; ks < 2; ++ks) { S0 = __builtin_amdgcn_mfma_f32_16x16x32_bf16(cur.kd[0][ks], vb[ks], S0, 0, 0, 0); S1 = __builtin_amdgcn_mfma_f32_16x16x32_bf16(cur.kd[1][ks], vb[ks], S1, 0, 0, 0); }
        u32x2 s0w, s1w; s0w.x = pk2(S0[0], S0[1]); s0w.y = pk2(S0[2], S0[3]); s1w.x = pk2(S1[0], S1[1]); s1w.y = pk2(S1[2], S1[3]);
        *(LAS u32x2*)(lds + ST_OFF + e * ST_ROWB + (32 * wave + 4 * kc) * 2) = s0w;
        *(LAS u32x2*)(lds + ST_OFF + e * ST_ROWB + (32 * wave + 16 + 4 * kc) * 2) = s1w;
    }
    lds_barrier();
}
DI void scan_unit(LAS unsigned char* lds, const bf16_t* UT, const bf16_t* Wb, const bf16_t* QD, const bf16_t* KDT, const bf16_t* AT, const float* CD, float* ORAW,
                  int bh, int sl, int tid, int wave, int lane) {
    static_assert(NCHUNK == 32, "the trip structure below is 10 x 3 + 2 steps");
    const int e = lane & 15, kc = lane >> 4, b = bh >> 2, h = bh & 3;
    for (int i = tid; i < SCAN_LDS / 4; i += 256) ((LAS unsigned*)lds)[i] = 0u;
    f32x4 S0 = (f32x4){0.f, 0.f, 0.f, 0.f}, S1 = S0;
    const ScanRs R = scan_rs(UT, Wb, QD, KDT, AT, CD);
    const __amdgpu_buffer_rsrc_t ro = __builtin_amdgcn_make_buffer_rsrc((void*)ORAW, 0, 0x7ffff000, 0x00020000);
    const unsigned vl16 = (unsigned)lane * 16u, vut = (unsigned)((e * 64 + 4 * kc) * 2), vo = (unsigned)((4 * kc * 512 + e) * 4);
    Frag f0, f1, f2;
    load_frag(f0, R, bh * 32, sl, wave, vl16, vut); load_frag(f1, R, bh * 32 + 1, sl, wave, vl16, vut);
    lds_barrier();
#pragma unroll 1
    for (int n = 0; n < 30; n += 3) {
        load_frag(f2, R, bh * 32 + n + 2, sl, wave, vl16, vut);
        scan_step(lds, f0, S0, S1, ro, vo, n, b, h, sl, wave, e, kc);
        load_frag(f0, R, bh * 32 + n + 3, sl, wave, vl16, vut);
        scan_step(lds, f1, S0, S1, ro, vo, n + 1, b, h, sl, wave, e, kc);
        load_frag(f1, R, bh * 32 + n + 4, sl, wave, vl16, vut);
        scan_step(lds, f2, S0, S1, ro, vo, n + 2, b, h, sl, wave, e, kc);
    }
    scan_step(lds, f0, S0, S1, ro, vo, 30, b, h, sl, wave, e, kc);
    scan_step(lds, f1, S0, S1, ro, vo, 31, b, h, sl, wave, e, kc);
}
}
constexpr int NWAVES = 8;
constexpr int RING_OFF = 0, RING_BYTES = 155648;
constexpr int LDSCTL_OFF = RING_BYTES, MISC_OFF = LDSCTL_OFF + 320;
constexpr int LDS_BYTES = 163840;

struct Frame {
    LAS unsigned char* lds;
    int tid, lane, wave;
    int vcu, G;
};

struct Args {
    const float* in[25]; float* out; unsigned char* ws;
    int ph_lo, ph_hi, flags, pad;
};
typedef const __attribute__((address_space(4))) Args* KArgs;

enum { WJ_PLAIN = 0, WJ_IN = 1, WJ_KV = 2, WJ_GLU = 3 };
struct WJob { const float* W; const float* W2; const float* gain; bf16_t* dst; int ldw, K, type, nblk; int fp8; unsigned* cmax; };
DI void wjob_src(const WJob& J, int db, const float*& src, int& scol, int& nvalid) {
    src = J.W; scol = 32 * db; nvalid = 32;
    if (J.type == WJ_IN) {
        if (db < 64) scol = 32 * db;
        else if (db < 76) scol = WC_CQ + 32 * (db - 64);
        else if (db < 84) scol = WC_CKV + 32 * (db - 76);
        else if (db == 84) scol = WC_KR;
        else if (db == 85) { scol = WC_A; nvalid = 8; }
        else if (db < 88) { scol = 0; nvalid = 0; }
        else { const int d2 = db - 88, j = d2 >> 3, w = d2 & 7;
               scol = WC_GATE + (w < 4 ? 0 : 1024) + j * 128 + 32 * (w & 3); }
    } else if (J.type == WJ_KV) {
        if (db < 16) scol = (db >> 1) * 128 + 32 * (db & 1);
        else scol = ((db - 16) >> 1) * 128 + 64 + 32 * (db & 1);
    } else if (J.type == WJ_GLU) {
        const int j = db >> 3, w = db & 7;
        if (w < 4) scol = j * 128 + 32 * w; else { src = J.W2; scol = j * 128 + 32 * (w - 4); }
    }
}
DI void wjob_absmax_item(const WJob& J, int item, int lane) {
    const int nkb = J.K >> 6; const int db = item / nkb, kb = item - db * nkb, k0 = kb << 6;
    const float* src; int scol, nvalid; wjob_src(J, db, src, scol, nvalid);
    const int n4 = (lane & 7) * 4, kr = lane >> 3;
    if (nvalid == 0) return;
    f32x4 mx = (f32x4){0.f, 0.f, 0.f, 0.f};
    if (n4 < nvalid) {
#pragma unroll
        for (int i = 0; i < 8; ++i) { const f32x4 v = *(const GAS f32x4*)(src + (size_t)(k0 + kr + 8 * i) * J.ldw + scol + n4);
            mx.x = fmaxf(mx.x, fabsf(v.x)); mx.y = fmaxf(mx.y, fabsf(v.y)); mx.z = fmaxf(mx.z, fabsf(v.z)); mx.w = fmaxf(mx.w, fabsf(v.w)); }
    }
#pragma unroll
    for (int e = 0; e < 4; ++e) { float t = mx[e]; t = fmaxf(t, swz_xor<8>(t)); t = fmaxf(t, swz_xor<16>(t));
        const auto rr = __builtin_amdgcn_permlane32_swap(__float_as_uint(t), __float_as_uint(t), false, false); mx[e] = fmaxf(__uint_as_float(rr[0]), __uint_as_float(rr[1])); }
    if (lane < 8) {
#pragma unroll
        for (int e = 0; e < 4; ++e) __hip_atomic_fetch_max(J.cmax + 32 * db + n4 + e, __float_as_uint(mx[e]), RLX_AGENT);
    }
}
DI void wjob_absmax_run(const WJob& J, int& base, int gw, int NGW, int lane) {
    const int nitems = J.nblk * (J.K >> 6);
    int it = gw - (base % NGW); if (it < 0) it += NGW;
    for (; it < nitems; it += NGW) wjob_absmax_item(J, it, lane);
    base += nitems;
}
DI void wjob_load(const WJob& J, int item, int lane, f32x4 (&v)[8]) {
    const int nkb = J.K >> 6; const int db = item / nkb, kb = item - db * nkb, k0 = kb << 6;
    const float* src; int scol, nvalid; wjob_src(J, db, src, scol, nvalid);
    const int n4 = (lane & 7) * 4, kr = lane >> 3;
    const bool nin = n4 < nvalid;
#pragma unroll
    for (int i = 0; i < 8; ++i) { v[i] = (f32x4){0.f, 0.f, 0.f, 0.f}; if (nin) v[i] = __builtin_nontemporal_load((const GAS f32x4*)(src + (size_t)(k0 + kr + 8 * i) * J.ldw + scol + n4)); }
}
DI void wjob_fin1(const WJob& J, int item, LAS float* scr, int lane, const f32x4 (&v)[8]) {
    const int nkb = J.K >> 6; const int db = item / nkb, kb = item - db * nkb, k0 = kb << 6;
    const int n4 = (lane & 7) * 4, kr = lane >> 3;
#pragma unroll
    for (int i = 0; i < 8; ++i) { const int kk = kr + 8 * i; f32x4 t = v[i];
        if (J.gain) t = t * J.gain[k0 + kk];
        LAS float* d = scr + kk * 33 + n4;
        d[0] = t.x; d[1] = t.y; d[2] = t.z; d[3] = t.w; }
}
DI void wjob_fin2(const WJob& J, int item, LAS float* scr, int lane, const float (&inv)[4]) {
    const int nkb = J.K >> 6; const int db = item / nkb, kb = item - db * nkb, k0 = kb << 6;
    const int c = lane & 7;
#pragma unroll
    for (int j = 0; j < 4; ++j) { const int nn = (lane >> 3) + 8 * j; const LAS float* s = scr + (8 * c) * 33 + nn;
        if (J.fp8 == 2) {
            unsigned w0 = 0u, w1 = 0u;
#pragma unroll
            for (int i = 0; i < 4; ++i) { w0 = __builtin_amdgcn_cvt_pk_u8_f32(__builtin_rintf(s[i * 33] * inv[j]) + 128.f, i, w0); w1 = __builtin_amdgcn_cvt_pk_u8_f32(__builtin_rintf(s[(i + 4) * 33] * inv[j]) + 128.f, i, w1); }
            u32x2 o; o.x = w0 ^ 0x80808080u; o.y = w1 ^ 0x80808080u;
            *(GAS u32x2*)((unsigned char*)J.dst + (size_t)(32 * db + nn) * J.K + k0 + 8 * c) = o;
        } else if (J.fp8) {
            float q[8];
#pragma unroll
            for (int i = 0; i < 8; ++i) q[i] = __builtin_amdgcn_fmed3f(s[i * 33] * W8_SCALE, -448.f, 448.f);
            unsigned w0 = __builtin_amdgcn_cvt_pk_fp8_f32(q[0], q[1], 0, false); w0 = __builtin_amdgcn_cvt_pk_fp8_f32(q[2], q[3], w0, true);
            unsigned w1 = __builtin_amdgcn_cvt_pk_fp8_f32(q[4], q[5], 0, false); w1 = __builtin_amdgcn_cvt_pk_fp8_f32(q[6], q[7], w1, true);
            u32x2 o; o.x = w0; o.y = w1;
            *(GAS u32x2*)((unsigned char*)J.dst + (size_t)(32 * db + nn) * J.K + k0 + 8 * c) = o;
        } else {
        u32x4 o; o.x = pk2(s[0 * 33], s[1 * 33]); o.y = pk2(s[2 * 33], s[3 * 33]); o.z = pk2(s[4 * 33], s[5 * 33]); o.w = pk2(s[6 * 33], s[7 * 33]);
        *(GAS u32x4*)(J.dst + (size_t)(32 * db + nn) * J.K + k0 + 8 * c) = o; } }
}
DI void wjob_item(const WJob& J, int item, LAS float* scr, int lane) {
    f32x4 v[8]; wjob_load(J, item, lane, v);
    float inv[4] = {0.f, 0.f, 0.f, 0.f};
    if (J.fp8 == 2) { const int db = item / (J.K >> 6);
#pragma unroll
        for (int j = 0; j < 4; ++j) { const float cm = __uint_as_float(__hip_atomic_load(J.cmax + 32 * db + (lane >> 3) + 8 * j, RLX_AGENT)); inv[j] = cm > 0.f ? 127.f / cm : 0.f; } }
    wjob_fin1(J, item, scr, lane, v);
    LDS_WAIT(); asm volatile("" ::: "memory");
    wjob_fin2(J, item, scr, lane, inv);
    LDS_WAIT(); asm volatile("" ::: "memory");
}
DI void wjob_run(const WJob& J, int& base, int gw, int NGW, LAS float* scr, int lane) {
    const int nitems = J.nblk * (J.K >> 6);
    int it = gw - (base % NGW); if (it < 0) it += NGW;
    for (; it < nitems; it += NGW) wjob_item(J, it, scr, lane);
    base += nitems;
}

DI void dec_proj(KArgs ap, unsigned char* ws, int l, int idx, WJob& J, int& item) {
    if (idx < 256) { J = WJob{ap->in[9] + (size_t)l * 512 * D, nullptr, nullptr, (bf16_t*)(ws + WS_WGDNO + l * MiB), D, 512, WJ_PLAIN, 32, 0, nullptr}; item = idx; }
    else if (idx < 512) { J = WJob{ap->in[14] + (size_t)l * 512 * D, nullptr, nullptr, (bf16_t*)(ws + WS_WMLAO + l * MiB), D, 512, WJ_PLAIN, 32, 0, nullptr}; item = idx - 256; }
    else { J = WJob{ap->in[15] + (size_t)l * D * D, nullptr, nullptr, (bf16_t*)(ws + WS_WOUT + l * 2 * MiB), D, 1024, WJ_PLAIN, 32, 0, nullptr}; item = idx - 512; }
}
DI void dec_qkv(KArgs ap, unsigned char* ws, int l, int idx, WJob& J, int& item) {
    if (idx < 144) { J = WJob{ap->in[11] + (size_t)l * 384 * 768, nullptr, ap->in[10] + l * 384, (bf16_t*)(ws + WS_WQB + l * 768 * KiB), 768, 384, WJ_PLAIN, 24, 0, nullptr}; item = idx; }
    else { J = WJob{ap->in[13] + (size_t)l * 256 * 1024, nullptr, ap->in[12] + l * 256, (bf16_t*)(ws + WS_WKVB + l * 512 * KiB), 1024, 256, WJ_KV, 32, 0, nullptr}; item = idx - 144; }
}
constexpr int NPROJ_ITEMS = 1024, NQKV_ITEMS = 272, NCONV_L0 = NPROJ_ITEMS + 32 * (D_FF / 64);
constexpr int MOE_ITEMS_E = (2 * DFE / 32) * 16 + 32 * (DFE / 64), MOE_ITEMS = NE * MOE_ITEMS_E;
DI void dec_moe(KArgs ap, unsigned char* ws, int idx, WJob& J, int& item) {
    const int e = idx / MOE_ITEMS_E, r = idx - e * MOE_ITEMS_E;
    if (r < (2 * DFE / 32) * 16) { J = WJob{ap->in[21] + (size_t)e * D * DFE, ap->in[22] + (size_t)e * D * DFE, nullptr, (bf16_t*)((unsigned char*)ap->out + e * (7 * MiB / 2)), DFE, 1024, WJ_GLU, 2 * DFE / 32, 1, nullptr}; item = r; }
    else { J = WJob{ap->in[23] + (size_t)e * DFE * D, nullptr, nullptr, (bf16_t*)(ws + WS_WM2 + e * (7 * MiB / 4)), D, DFE, WJ_PLAIN, 32, 1, nullptr}; item = r - (2 * DFE / 32) * 16; }
}
DI void conv_dec(KArgs ap, unsigned char* ws, int mode, int idx, WJob& J, int& item) {
    if (mode == 2) dec_moe(ap, ws, idx, J, item);
    else if (idx < NPROJ_ITEMS) dec_proj(ap, ws, 1, idx, J, item);
    else { J = WJob{ap->in[19], nullptr, nullptr, (bf16_t*)(ws + WS_WD2), D, D_FF, WJ_PLAIN, 32, DENSE_DN_FP8, nullptr}; item = idx - NPROJ_ITEMS; }
}
#define CONV_BAR0() do { asm volatile("s_waitcnt lgkmcnt(0)" ::: "memory"); __builtin_amdgcn_s_barrier(); asm volatile("" ::: "memory"); } while (0)
constexpr unsigned OOB = 0x80000000u;
DI void cjob_load(const WJob& J, int item, bool valid, int lane, f32x4 (&v)[8]) {
    const int nkb = J.K >> 6; const int db = item / nkb, kb = item - db * nkb, k0 = kb << 6;
    const float* src; int scol, nvalid; wjob_src(J, db, src, scol, nvalid);
    const __amdgpu_buffer_rsrc_t rs = __builtin_amdgcn_make_buffer_rsrc((void*)src, 0, 0x7ffff000, 0x00020000);
    const int n4 = (lane & 7) * 4, kr = lane >> 3;
    const unsigned bad = (valid && n4 < nvalid) ? 0u : OOB;
#pragma unroll
    for (int i = 0; i < 8; ++i) v[i] = __builtin_bit_cast(f32x4, __builtin_amdgcn_raw_buffer_load_b128(rs, (unsigned)(((k0 + kr + 8 * i) * J.ldw + scol + n4) * 4) | bad, 0, 2));
}
DI void cjob_fin1(LAS float* scr, int lane, const f32x4 (&v)[8]) {
    const int n4 = (lane & 7) * 4, kr = lane >> 3;
#pragma unroll
    for (int i = 0; i < 8; ++i) { LAS float* d = scr + (kr + 8 * i) * 33 + n4; d[0] = v[i].x; d[1] = v[i].y; d[2] = v[i].z; d[3] = v[i].w; }
}
DI void cjob_fin2(const WJob& J, int item, bool valid, LAS float* scr, int lane, const float (&inv)[4]) {
    const int nkb = J.K >> 6; const int db = item / nkb, kb = item - db * nkb, k0 = kb << 6;
    const int c = lane & 7;
    const __amdgpu_buffer_rsrc_t rd = __builtin_amdgcn_make_buffer_rsrc((void*)J.dst, 0, 0x7ffff000, 0x00020000);
    const unsigned bad = valid ? 0u : OOB;
#pragma unroll
    for (int j = 0; j < 4; ++j) { const int nn = (lane >> 3) + 8 * j; const LAS float* s = scr + (8 * c) * 33 + nn;
        if (J.fp8 == 2) {
            unsigned w0 = 0u, w1 = 0u;
#pragma unroll
            for (int i = 0; i < 4; ++i) { w0 = __builtin_amdgcn_cvt_pk_u8_f32(__builtin_rintf(s[i * 33] * inv[j]) + 128.f, i, w0); w1 = __builtin_amdgcn_cvt_pk_u8_f32(__builtin_rintf(s[(i + 4) * 33] * inv[j]) + 128.f, i, w1); }
            u32x2 o; o.x = w0 ^ 0x80808080u; o.y = w1 ^ 0x80808080u;
            __builtin_amdgcn_raw_buffer_store_b64(o, rd, (unsigned)((32 * db + nn) * J.K + k0 + 8 * c) | bad, 0, 2);
        } else if (J.fp8) {
            float q[8];
#pragma unroll
            for (int i = 0; i < 8; ++i) q[i] = __builtin_amdgcn_fmed3f(s[i * 33] * W8_SCALE, -448.f, 448.f);
            unsigned w0 = __builtin_amdgcn_cvt_pk_fp8_f32(q[0], q[1], 0, false); w0 = __builtin_amdgcn_cvt_pk_fp8_f32(q[2], q[3], w0, true);
            unsigned w1 = __builtin_amdgcn_cvt_pk_fp8_f32(q[4], q[5], 0, false); w1 = __builtin_amdgcn_cvt_pk_fp8_f32(q[6], q[7], w1, true);
            u32x2 o; o.x = w0; o.y = w1;
            __builtin_amdgcn_raw_buffer_store_b64(o, rd, (unsigned)((32 * db + nn) * J.K + k0 + 8 * c) | bad, 0, 2);
        } else {
            u32x4 o; o.x = pk2(s[0 * 33], s[1 * 33]); o.y = pk2(s[2 * 33], s[3 * 33]); o.z = pk2(s[4 * 33], s[5 * 33]); o.w = pk2(s[6 * 33], s[7 * 33]);
            __builtin_amdgcn_raw_buffer_store_b128(o, rd, (unsigned)(((32 * db + nn) * J.K + k0 + 8 * c) * 2) | bad, 0, 2); } }
}
DI void cjob_pad_stores(unsigned char* ws, int lane) {
    const __amdgpu_buffer_rsrc_t rd = __builtin_amdgcn_make_buffer_rsrc((void*)ws, 0, 0x7ffff000, 0x00020000);
    u32x2 z; z.x = (unsigned)lane; z.y = (unsigned)lane;
#pragma unroll
    for (int j = 0; j < 4; ++j) __builtin_amdgcn_raw_buffer_store_b64(z, rd, OOB, 0, 0);
}
DI void conv_stream(KArgs ap, unsigned char* ws, int mode, int first, int stride, int total, int nbar, LAS float* scr, int lane) {
    f32x4 va[8], vb[8]; WJob J; int item; const float inv0[4] = {0.f, 0.f, 0.f, 0.f};
    int pa = first, pb2 = first + stride, nxt = first + 2 * stride;
    conv_dec(ap, ws, mode, pa < total ? pa : 0, J, item); cjob_load(J, item, pa < total, lane, va); cjob_pad_stores(ws, lane);
    conv_dec(ap, ws, mode, pb2 < total ? pb2 : 0, J, item); cjob_load(J, item, pb2 < total, lane, vb); cjob_pad_stores(ws, lane);
    int step = 0;
    if (nbar > 0) CONV_BAR0();
#pragma unroll 1
    for (;;) {
        const bool paced = nbar > 0 && step < NCHUNK;
        if (!paced && pa >= total) break;
        { const int pc = pa; WJob Jc; int ic;
          conv_dec(ap, ws, mode, pc < total ? pc : 0, Jc, ic); cjob_fin1(scr, lane, va);
          pa = nxt; nxt += stride; conv_dec(ap, ws, mode, pa < total ? pa : 0, J, item); cjob_load(J, item, pa < total, lane, va);
          if (paced) lds_barrier(); else { LDS_WAIT(); asm volatile("" ::: "memory"); }
          cjob_fin2(Jc, ic, pc < total, scr, lane, inv0);
          if (paced) lds_barrier(); else { LDS_WAIT(); asm volatile("" ::: "memory"); } }
        { const int pc = pb2; WJob Jc; int ic;
          conv_dec(ap, ws, mode, pc < total ? pc : 0, Jc, ic); cjob_fin1(scr, lane, vb);
          pb2 = nxt; nxt += stride; conv_dec(ap, ws, mode, pb2 < total ? pb2 : 0, J, item); cjob_load(J, item, pb2 < total, lane, vb);
          if (paced) lds_barrier(); else { LDS_WAIT(); asm volatile("" ::: "memory"); }
          cjob_fin2(Jc, ic, pc < total, scr, lane, inv0);
          if (paced) lds_barrier(); else { LDS_WAIT(); asm volatile("" ::: "memory"); } }
        step += 2;
    }
#pragma unroll 1
    for (int u = 1; u < nbar; ++u) { CONV_BAR0();
#pragma unroll 1
        for (int n = 0; n < 2 * NCHUNK; ++n) lds_barrier(); }
}
DI void absmax_acc(f32x4& mx, const f32x4 (&v)[8]) {
#pragma unroll
    for (int i = 0; i < 8; ++i) { mx.x = fmaxf(mx.x, fabsf(v[i].x)); mx.y = fmaxf(mx.y, fabsf(v[i].y)); mx.z = fmaxf(mx.z, fabsf(v[i].z)); mx.w = fmaxf(mx.w, fabsf(v[i].w)); }
}
DI void conv_i8_block(const WJob& J, int db, bool bars, LAS float* scr, int lane) {
    f32x4 va[8], vb[8]; f32x4 mx = (f32x4){0.f, 0.f, 0.f, 0.f};
    cjob_load(J, db * 16, true, lane, va); cjob_load(J, db * 16 + 1, true, lane, vb);
    if (bars) CONV_BAR0();
#pragma unroll 1
    for (int kb = 0; kb < 16; kb += 2) {
        absmax_acc(mx, va); cjob_load(J, db * 16 + ((kb + 2) & 15), true, lane, va);
        if (bars) { lds_barrier(); lds_barrier(); }
        absmax_acc(mx, vb); cjob_load(J, db * 16 + ((kb + 3) & 15), true, lane, vb);
        if (bars) { lds_barrier(); lds_barrier(); }
    }
#pragma unroll
    for (int e = 0; e < 4; ++e) { float t = mx[e]; t = fmaxf(t, swz_xor<8>(t)); t = fmaxf(t, swz_xor<16>(t));
        const auto rr = __builtin_amdgcn_permlane32_swap(__float_as_uint(t), __float_as_uint(t), false, false); mx[e] = fmaxf(__uint_as_float(rr[0]), __uint_as_float(rr[1])); }
    if (lane < 8) {
#pragma unroll
        for (int e = 0; e < 4; ++e) { J.cmax[32 * db + 4 * lane + e] = __float_as_uint(mx[e]); scr[2112 + 4 * lane + e] = mx[e]; } }
    LDS_WAIT(); asm volatile("" ::: "memory");
    float inv[4];
#pragma unroll
    for (int j = 0; j < 4; ++j) { const float cm = scr[2112 + (lane >> 3) + 8 * j]; inv[j] = cm > 0.f ? 127.f / cm : 0.f; }
#pragma unroll 1
    for (int kb = 0; kb < 16; kb += 2) {
        cjob_fin1(scr, lane, va); cjob_load(J, db * 16 + ((kb + 2) & 15), kb + 2 < 16, lane, va);
        if (bars) lds_barrier(); else { LDS_WAIT(); asm volatile("" ::: "memory"); }
        cjob_fin2(J, db * 16 + kb, true, scr, lane, inv);
        if (bars) lds_barrier(); else { LDS_WAIT(); asm volatile("" ::: "memory"); }
        cjob_fin1(scr, lane, vb); cjob_load(J, db * 16 + ((kb + 3) & 15), kb + 3 < 16, lane, vb);
        if (bars) lds_barrier(); else { LDS_WAIT(); asm volatile("" ::: "memory"); }
        cjob_fin2(J, db * 16 + kb + 1, true, scr, lane, inv);
        if (bars) lds_barrier(); else { LDS_WAIT(); asm volatile("" ::: "memory"); }
    }
}
constexpr int NI8_L1 = NPROJ / 32, NI8_BLOCKS = NPROJ / 32 + 2 * D_FF / 32;
DI void conv_i8_job(KArgs ap, unsigned char* ws, int b, WJob& J, int& db) {
    unsigned* cmx = (unsigned*)(ws + WS_CTL) + CW_CMAX;
    if (b < NI8_L1) { J = WJob{ap->in[3] + (size_t)D * IN_COLS, nullptr, nullptr, (bf16_t*)(ws + WS_WIN + WIN_STRIDE), IN_COLS, 1024, WJ_IN, NPROJ / 32, 2, cmx + NPROJ}; db = b; }
    else { J = WJob{ap->in[17], ap->in[18], nullptr, (bf16_t*)(ws + WS_WD13), D_FF, 1024, WJ_GLU, 2 * D_FF / 32, 2, cmx + 2 * NPROJ}; db = b - NI8_L1; }
}
DI void scan_converter(KArgs ap, unsigned char* ws, int l, int cw, int NCW, int nun, LAS float* scr, int lane) {
    int nb = nun;
    if (l == 0) {
        const bool split = NCW >= NI8_BLOCKS + 64;
#pragma unroll 1
        for (int b = cw; b < NI8_BLOCKS; b += NCW) { WJob J; int db; conv_i8_job(ap, ws, b, J, db); conv_i8_block(J, db, nb > 0, scr, lane); if (nb > 0) --nb; }
        if (split) { if (cw >= NI8_BLOCKS) conv_stream(ap, ws, 1, cw - NI8_BLOCKS, NCW - NI8_BLOCKS, NCONV_L0, nb, scr, lane); else conv_stream(ap, ws, 1, 0, 1, 0, nb, scr, lane); }
        else conv_stream(ap, ws, 1, cw, NCW, NCONV_L0, nb, scr, lane);
    } else conv_stream(ap, ws, 2, cw, NCW, MOE_ITEMS, nb, scr, lane);
}

DI float rms_row_load(const float* xrow, const float* gain, int lane, f32x4 (&v)[4]) {
    const GAS f32x4* xr = (const GAS f32x4*)xrow + lane;
    float ss = 0.f;
#pragma unroll
    for (int j = 0; j < 4; ++j) { v[j] = xr[64 * j]; ss += (v[j].x * v[j].x + v[j].y * v[j].y) + (v[j].z * v[j].z + v[j].w * v[j].w); }
    ss = wave_sum(ss);
    const float rstd = rsqrtf(ss * (1.f / D) + EPS);
    const GAS f32x4* gr = (const GAS f32x4*)gain + lane;
#pragma unroll
    for (int j = 0; j < 4; ++j) v[j] = v[j] * gr[64 * j] * rstd;
    return rstd;
}
DI float rms_row_load_b(const bf16_t* xrow, const float* gain, int lane, f32x4 (&v)[4]) {
    const GAS u32x2* xr = (const GAS u32x2*)xrow + lane;
    float ss = 0.f;
#pragma unroll
    for (int j = 0; j < 4; ++j) { const u32x2 w = xr[64 * j]; v[j] = (f32x4){bflo(w.x), bfhi(w.x), bflo(w.y), bfhi(w.y)}; ss += (v[j].x * v[j].x + v[j].y * v[j].y) + (v[j].z * v[j].z + v[j].w * v[j].w); }
    ss = wave_sum(ss);
    const float rstd = rsqrtf(ss * (1.f / D) + EPS);
    const GAS f32x4* gr = (const GAS f32x4*)gain + lane;
#pragma unroll
    for (int j = 0; j < 4; ++j) v[j] = v[j] * gr[64 * j] * rstd;
    return rstd;
}
DI void row_store_bf16(bf16_t* orow, int lane, const f32x4 (&v)[4]) {
    GAS u32x2* o8 = (GAS u32x2*)orow + lane;
#pragma unroll
    for (int j = 0; j < 4; ++j) { u32x2 w; w.x = pk2(v[j].x, v[j].y); w.y = pk2(v[j].z, v[j].w); o8[64 * j] = w; }
}
DI float wave_max(float v) {
    v = fmaxf(v, swz_xor<1>(v)); v = fmaxf(v, swz_xor<2>(v)); v = fmaxf(v, swz_xor<4>(v)); v = fmaxf(v, swz_xor<8>(v)); v = fmaxf(v, swz_xor<16>(v));
    const auto rr = __builtin_amdgcn_permlane32_swap(__float_as_uint(v), __float_as_uint(v), false, false); return fmaxf(__uint_as_float(rr[0]), __uint_as_float(rr[1]));
}
DI void row_store_i8(unsigned char* orow, float* srow, int lane, const f32x4 (&v)[4]) {
    float am = 0.f;
#pragma unroll
    for (int j = 0; j < 4; ++j) am = fmaxf(fmaxf(am, fmaxf(fabsf(v[j].x), fabsf(v[j].y))), fmaxf(fabsf(v[j].z), fabsf(v[j].w)));
    am = wave_max(am);
    const float inv = am > 0.f ? 127.f / am : 0.f;
    GAS unsigned* o = (GAS unsigned*)orow + lane;
#pragma unroll
    for (int j = 0; j < 4; ++j) { unsigned w = 0u;
        w = __builtin_amdgcn_cvt_pk_u8_f32(__builtin_rintf(v[j].x * inv) + 128.f, 0, w); w = __builtin_amdgcn_cvt_pk_u8_f32(__builtin_rintf(v[j].y * inv) + 128.f, 1, w);
        w = __builtin_amdgcn_cvt_pk_u8_f32(__builtin_rintf(v[j].z * inv) + 128.f, 2, w); w = __builtin_amdgcn_cvt_pk_u8_f32(__builtin_rintf(v[j].w * inv) + 128.f, 3, w);
        o[64 * j] = w ^ 0x80808080u; }
    if (lane == 0) *srow = am * (1.f / 127.f);
}
DI void row_issue_b(const bf16_t* xrow, int lane, u32x2 (&w)[4]) { const GAS u32x2* xr = (const GAS u32x2*)xrow + lane;
#pragma unroll
    for (int j = 0; j < 4; ++j) w[j] = xr[64 * j]; }
DI void row_issue_f(const float* xrow, int lane, f32x4 (&w)[4]) { const GAS f32x4* xr = (const GAS f32x4*)xrow + lane;
#pragma unroll
    for (int j = 0; j < 4; ++j) w[j] = __builtin_nontemporal_load(xr + 64 * j); }
DI void row_norm_b(const u32x2 (&w)[4], const f32x4 (&g)[4], f32x4 (&v)[4]) {
    float ss = 0.f;
#pragma unroll
    for (int j = 0; j < 4; ++j) { v[j] = (f32x4){bflo(w[j].x), bfhi(w[j].x), bflo(w[j].y), bfhi(w[j].y)}; ss += (v[j].x * v[j].x + v[j].y * v[j].y) + (v[j].z * v[j].z + v[j].w * v[j].w); }
    ss = wave_sum(ss); const float rstd = rsqrtf(ss * (1.f / D) + EPS);
#pragma unroll
    for (int j = 0; j < 4; ++j) v[j] = v[j] * g[j] * rstd;
}
DI void row_norm_f(const f32x4 (&w)[4], const f32x4 (&g)[4], f32x4 (&v)[4]) {
    float ss = 0.f;
#pragma unroll
    for (int j = 0; j < 4; ++j) { v[j] = w[j]; ss += (v[j].x * v[j].x + v[j].y * v[j].y) + (v[j].z * v[j].z + v[j].w * v[j].w); }
    ss = wave_sum(ss); const float rstd = rsqrtf(ss * (1.f / D) + EPS);
#pragma unroll
    for (int j = 0; j < 4; ++j) v[j] = v[j] * g[j] * rstd;
}
DI void norm_rows_i8(int gw, int NGW, int lane, const float* X, const float* gain, bf16_t* XN8, float* sA) {
    f32x4 g[4]; { const GAS f32x4* gr = (const GAS f32x4*)gain + lane;
#pragma unroll
        for (int j = 0; j < 4; ++j) g[j] = gr[64 * j]; }
    f32x4 wn[4];
#pragma unroll
    for (int j = 0; j < 4; ++j) wn[j] = (f32x4){0.f, 0.f, 0.f, 0.f};
    if (gw < M) row_issue_f(X + (size_t)gw * D, lane, wn);
#pragma unroll 1
    for (int m = gw; m < M; m += NGW) {
        f32x4 wc[4];
#pragma unroll
        for (int j = 0; j < 4; ++j) wc[j] = wn[j];
        asm volatile("" : "+v"(wc[0]), "+v"(wc[1]), "+v"(wc[2]), "+v"(wc[3]));
        if (m + NGW < M) row_issue_f(X + (size_t)(m + NGW) * D, lane, wn);
        f32x4 v[4]; row_norm_f(wc, g, v); row_store_i8((unsigned char*)XN8 + (size_t)m * D, sA + m, lane, v);
    }
}
DI void norm_rows_bi8(int gw, int NGW, int lane, const bf16_t* X, const float* gain, bf16_t* XN8, float* sA) {
    f32x4 g[4]; { const GAS f32x4* gr = (const GAS f32x4*)gain + lane;
#pragma unroll
        for (int j = 0; j < 4; ++j) g[j] = gr[64 * j]; }
    u32x2 wn[4];
#pragma unroll
    for (int j = 0; j < 4; ++j) wn[j] = (u32x2){0u, 0u};
    if (gw < M) row_issue_b(X + (size_t)gw * D, lane, wn);
#pragma unroll 1
    for (int m = gw; m < M; m += NGW) {
        u32x2 wc[4];
#pragma unroll
        for (int j = 0; j < 4; ++j) wc[j] = wn[j];
        asm volatile("" : "+v"(wc[0]), "+v"(wc[1]), "+v"(wc[2]), "+v"(wc[3]));
        if (m + NGW < M) row_issue_b(X + (size_t)(m + NGW) * D, lane, wn);
        f32x4 v[4]; row_norm_b(wc, g, v); row_store_i8((unsigned char*)XN8 + (size_t)m * D, sA + m, lane, v);
    }
}
DI void norm_rows_b8(int gw, int NGW, int lane, const bf16_t* X, const float* gain, bf16_t* XN8) {
    for (int m = gw; m < M; m += NGW) { f32x4 v[4]; rms_row_load_b(X + (size_t)m * D, gain, lane, v);
        GAS unsigned* o8 = (GAS unsigned*)((unsigned char*)XN8 + (size_t)m * D) + lane;
#pragma unroll
        for (int j = 0; j < 4; ++j) { const float c0 = __builtin_amdgcn_fmed3f(v[j].x, -448.f, 448.f), c1 = __builtin_amdgcn_fmed3f(v[j].y, -448.f, 448.f), c2 = __builtin_amdgcn_fmed3f(v[j].z, -448.f, 448.f), c3 = __builtin_amdgcn_fmed3f(v[j].w, -448.f, 448.f);
            unsigned w = __builtin_amdgcn_cvt_pk_fp8_f32(c0, c1, 0, false); w = __builtin_amdgcn_cvt_pk_fp8_f32(c2, c3, w, true); o8[64 * j] = w; } }
}
DI void norm_rows_b(int gw, int NGW, int lane, const bf16_t* X, const float* gain, bf16_t* XN) {
    for (int m = gw; m < M; m += NGW) { f32x4 v[4]; rms_row_load_b(X + (size_t)m * D, gain, lane, v); row_store_bf16(XN + (size_t)m * D, lane, v); }
}
DI void norm_rows(int gw, int NGW, int lane, const float* X, const float* gain, bf16_t* XN) {
    for (int m = gw; m < M; m += NGW) { f32x4 v[4]; rms_row_load(X + (size_t)m * D, gain, lane, v); row_store_bf16(XN + (size_t)m * D, lane, v); }
}

#ifdef PROBE_MFMA
typedef int i32x4 __attribute__((ext_vector_type(4)));
__device__ __noinline__ void mfma_rate_probe(unsigned* sink, int iters) {
    const int l = lane_id_asm();
    i32x4 a = (i32x4){l, l * 3, l * 5, l * 7}, b = (i32x4){l * 11, l * 13, l * 17, l * 19};
#if PROBE_MFMA == 2
    i32x4 acc[8];
#pragma unroll
    for (int i = 0; i < 8; ++i) acc[i] = (i32x4){0, 0, 0, 0};
#pragma unroll 1
    for (int it = 0; it < iters; ++it) {
#pragma unroll
        for (int i = 0; i < 8; ++i) acc[i] = __builtin_amdgcn_mfma_i32_16x16x64_i8(a, b, acc[i], 0, 0, 0);
        asm volatile("" : "+v"(a), "+v"(b));
    }
    int s = 0;
#pragma unroll
    for (int i = 0; i < 8; ++i) s += acc[i][0] + acc[i][1] + acc[i][2] + acc[i][3];
    if (s == 0x12345678) sink[l] = (unsigned)s;
#else
    f32x4 acc[8];
#pragma unroll
    for (int i = 0; i < 8; ++i) acc[i] = (f32x4){0.f, 0.f, 0.f, 0.f};
    bf16x8 a8 = __builtin_bit_cast(bf16x8, a), b8 = __builtin_bit_cast(bf16x8, b);
#pragma unroll 1
    for (int it = 0; it < iters; ++it) {
#pragma unroll
        for (int i = 0; i < 8; ++i) acc[i] = __builtin_amdgcn_mfma_f32_16x16x32_bf16(a8, b8, acc[i], 0, 0, 0);
        asm volatile("" : "+v"(a8), "+v"(b8));
    }
    float s = 0.f;
#pragma unroll
    for (int i = 0; i < 8; ++i) s += acc[i][0] + acc[i][1] + acc[i][2] + acc[i][3];
    if (s == 123.456f) sink[l] = __float_as_uint(s);
#endif
}
#endif
#define PHASE_BUFS \
    const float* x = ap->in[0]; const int* pos = (const int*)ap->in[1]; \
    const float* mix_norm = ap->in[2]; const float* w_in = ap->in[3]; const float* gate_bias = ap->in[4]; \
    const float* conv_w = ap->in[5]; const float* a_log = ap->in[6]; const float* dt_bias = ap->in[7]; const float* gdn_out_norm = ap->in[8]; \
    const float* w_gdn_o = ap->in[9]; const float* q_a_norm = ap->in[10]; \
    const float* w_q_b = ap->in[11]; const float* kv_a_norm = ap->in[12]; const float* w_kv_b = ap->in[13]; \
    const float* w_mla_o = ap->in[14]; const float* w_out = ap->in[15]; const float* ffn_norm = ap->in[16]; \
    const float* dense_w1 = ap->in[17]; const float* dense_w3 = ap->in[18]; const float* dense_w2 = ap->in[19]; \
    const float* router_w = ap->in[20]; const float* moe_w1 = ap->in[21]; const float* moe_w3 = ap->in[22]; \
    const float* moe_w2 = ap->in[23]; const float* final_norm = ap->in[24]; \
    float* X = ap->out; \
    bf16_t* GATE = (bf16_t*)(ws + WS_GATE); bf16_t* Zb = (bf16_t*)(ws + WS_Z); bf16_t* MISC = (bf16_t*)(ws + WS_MISC); bf16_t* QKV = (bf16_t*)(ws + WS_QKV); \
    bf16_t* Qb = (bf16_t*)(ws + WS_Q); bf16_t* Kb = (bf16_t*)(ws + WS_K); bf16_t* Vb = (bf16_t*)(ws + WS_V); bf16_t* AO = (bf16_t*)(ws + WS_AO); bf16_t* GO = (bf16_t*)(ws + WS_GO); \
    bf16_t* XN = (bf16_t*)((unsigned char*)ap->out + OUT_XN); bf16_t* MERGED = XN; bf16_t* XB = (bf16_t*)(ws + WS_XB); \
    bf16_t* HB = (bf16_t*)(ws + WS_HB); bf16_t* XG = (bf16_t*)(ws + WS_XG); bf16_t* Hm = (bf16_t*)(ws + WS_H); bf16_t* Yb = (bf16_t*)(ws + WS_Y); \
    float* ORAW = (float*)((unsigned char*)ap->out + OUT_XN); float* COS = (float*)(ws + WS_COS); float* SIN = (float*)(ws + WS_SIN); float* rstdq = (float*)(ws + WS_RSTD); float* rstdkv = rstdq + M; \
    int* topi = (int*)(ws + WS_MOE); float* topw = (float*)(topi + 2 * M); int* pairrow = (int*)(topw + 2 * M); int* list = pairrow + 2 * M; int* offs = list + NE * M; \
    unsigned* cnt = (unsigned*)(ws + WS_CTL) + CW_CNT; unsigned* cmx = (unsigned*)(ws + WS_CTL) + CW_CMAX; float* SAq = (float*)(ws + WS_SA);
__global__ void __launch_bounds__(NWAVES * 64, 2) mega_fwd(Args args) {
    extern __shared__ __attribute__((aligned(16))) unsigned char lds_raw[];
    Frame F;
    F.lds = (LAS unsigned char*)lds_raw;
    volatile LAS unsigned* MISCW = (volatile LAS unsigned*)(F.lds + MISC_OFF);
    F.tid = threadIdx.x; F.lane = F.tid & 63; F.wave = __builtin_amdgcn_readfirstlane(F.tid >> 6);
    F.G = gridDim.x; { const int bx = blockIdx.x; F.vcu = (F.G % 8 == 0) ? (bx % 8) * (F.G / 8) + bx / 8 : bx; }
    unsigned* ctl = (unsigned*)(args.ws + WS_CTL);
    for (int u = F.tid; u < (LDS_BYTES - LDSCTL_OFF) / 4; u += NWAVES * 64) ((LAS unsigned*)(F.lds + LDSCTL_OFF))[u] = 0u;
    __syncthreads();
    XcdBarrier bar = xcd_barrier_post(ctl + CW_BAR, MISCW + 8); bar.wave = F.wave;
    const int lo = args.ph_lo, hi = args.ph_hi;
#ifndef PROBE_LOCAL_X
#define PROBE_LOCAL_X 1
#endif
#ifndef PHASE_ENABLE
#define PHASE_ENABLE 0xFFFFFFF
#endif
#define P_ON(k) (((PHASE_ENABLE) >> (k)) & 1)
#define IN(k) (lo <= (k) && (k) < hi)
#define PHASE_BEGIN int pw = F.wave, pbx = (int)blockIdx.x, pG = F.G; asm volatile("" : "+s"(pw), "+s"(pbx), "+s"(pG)); int lane_ = lane_id_asm(); const int lane = lane_, tid = pw * 64 + lane_; (void)tid; const int gw = F.vcu * NWAVES + pw, NGW = F.G * NWAVES; (void)gw; (void)NGW; LAS float* scr = (LAS float*)(F.lds + RING_OFF + pw * 16384); (void)scr; KArgs ap = (KArgs)__builtin_amdgcn_kernarg_segment_ptr(); asm volatile("" : "+s"(ap)); unsigned char* ws = ap->ws; PHASE_BUFS
#define SEAM(k) do { if (IN(k) && IN((k) + 1)) xcd_barrier(bar); } while (0)


#ifdef PROBE_MFMA
    mfma_rate_probe((unsigned*)(args.ws + WS_END), 2000);
#endif
    if (IN(0) && P_ON(12)) { PHASE_BEGIN;
        WJob Jin{w_in, nullptr, nullptr, (bf16_t*)(ws + WS_WIN), IN_COLS, 1024, WJ_IN, NPROJ / 32, 2, cmx};
        const int nin = (NPROJ / 32) * 16;
        for (int i = gw; i < nin + NPROJ_ITEMS + 2 * NQKV_ITEMS; i += NGW) {
            if (i < nin) wjob_absmax_item(Jin, i, lane);
            else { WJob J; int item; const int r = i - nin;
                if (r < NPROJ_ITEMS) dec_proj(ap, ws, 0, r, J, item); else if (r < NPROJ_ITEMS + NQKV_ITEMS) dec_qkv(ap, ws, 0, r - NPROJ_ITEMS, J, item); else dec_qkv(ap, ws, 1, r - NPROJ_ITEMS - NQKV_ITEMS, J, item);
                wjob_item(J, item, scr, lane); }
        }
        for (int i = pbx * (NWAVES * 64) + tid; i < M * 16; i += pG * NWAVES * 64) {
            const int m = i >> 4, j = i & 15;
            const float ang = (float)pos[m] * powf(10000.f, -(float)j / 16.f);
            COS[i] = cosf(ang); SIN[i] = sinf(ang);
        }
    }
    if (IN(0)) xcd_barrier(bar);
    if (IN(0) && P_ON(12)) { PHASE_BEGIN;
        WJob Jin{w_in, nullptr, nullptr, (bf16_t*)(ws + WS_WIN), IN_COLS, 1024, WJ_IN, NPROJ / 32, 2, cmx};
        for (int i = gw; i < (NPROJ / 32) * 16; i += NGW) wjob_item(Jin, i, scr, lane);
        norm_rows_i8(gw, NGW, lane, x, mix_norm, XN, SAq);
    }
    SEAM(0);

#pragma unroll 1
    for (int l = 0; l < 2; ++l) {
        const int pb = 1 + 12 * l;
        if (IN(pb + 0) && P_ON(0)) { PHASE_BEGIN;
            pg8::Gemm g{XN, (const bf16_t*)(ws + WS_WIN + l * WIN_STRIDE), D, D, SAq, (const float*)(cmx + l * NPROJ)}; pg8::StaticOrder S; S.init(M, NPROJ, pG, pbx);
            pg8::EpiInProj E{QKV, Zb, MISC, GATE, gate_bias + l * 2048};
            pg8::gemm_phase<pg8::EpiInProj, pg8::StaticOrder, true, I8_INPROJ ? 2 : 0>(F.lds + RING_OFF, g, S, E, pw);
        }
        SEAM(pb + 0);
        if (IN(pb + 1) && P_ON(1)) { PHASE_BEGIN;
            bf16_t* UT = (bf16_t*)(ws + WS_UT); bf16_t* Wg = (bf16_t*)(ws + WS_W); bf16_t* QD = (bf16_t*)(ws + WS_QD); bf16_t* KDT = (bf16_t*)(ws + WS_KDT); bf16_t* ATb = (bf16_t*)(ws + WS_AT); float* CD = (float*)(ws + WS_CD);
            for (int up = F.vcu; up < 512; up += pG) gdn::local_pair(F.lds + RING_OFF, QKV, MISC, conv_w + l * 4 * 1536, a_log + l * 4, dt_bias + l * 4, UT, Wg, QD, KDT, ATb, CD, up, pw);
            if (!(args.flags & 2)) mla_prep_rows(gw, NGW, lane, MISC, rstdq, rstdkv);
        }
        SEAM(pb + 1);
        if (IN(pb + 2) && P_ON(2)) { PHASE_BEGIN;
            bf16_t* UT = (bf16_t*)(ws + WS_UT); bf16_t* Wg = (bf16_t*)(ws + WS_W); bf16_t* QD = (bf16_t*)(ws + WS_QD); bf16_t* KDT = (bf16_t*)(ws + WS_KDT); bf16_t* ATb = (bf16_t*)(ws + WS_AT); float* CD = (float*)(ws + WS_CD);
            if (pw < 4) { __builtin_amdgcn_s_setprio(3);
                for (int u = F.vcu; u < 256; u += pG) gdn::scan_unit(F.lds + RING_OFF, UT, Wg, QD, KDT, ATb, CD, ORAW, u >> 3, u & 7, tid, pw, lane);
                __builtin_amdgcn_s_setprio(0); }
            else scan_converter(ap, ws, l, (pw - 4) * pG + F.vcu, 4 * pG, F.vcu < 256 ? (256 - F.vcu + pG - 1) / pG : 0, scr, lane);
        }
        SEAM(pb + 2);
        if (IN(pb + 3) && P_ON(3)) { PHASE_BEGIN;
            mla_kpe_rows(gw, NGW, lane, MISC, COS, SIN, Kb);
            { pg8::Gemm g{MISC + MC_CQ, (const bf16_t*)(ws + WS_WQB + l * 768 * KiB), MISC_LD, 384}; pg8::StaticOrder S; S.init(M, 768, pG, pbx);
              pg8::EpiQRope E{Qb, rstdq, COS, SIN};
              pg8::gemm_phase<pg8::EpiQRope, pg8::StaticOrder, false>(F.lds + RING_OFF, g, S, E, pw); }
            { pg8::Gemm g{MISC + MC_CKV, (const bf16_t*)(ws + WS_WKVB + l * 512 * KiB), MISC_LD, 256}; pg8::StaticOrder S; S.init(M, 1024, pG, pbx);
              pg8::EpiKV E{Kb, Vb, rstdkv};
              pg8::gemm_phase<pg8::EpiKV, pg8::StaticOrder, false>(F.lds + RING_OFF, g, S, E, pw); }
        }
        SEAM(pb + 3);
        if (IN(pb + 4) && P_ON(4)) { PHASE_BEGIN;
            if (!(args.flags & 1)) {
                for (int u = F.vcu; u < 256; u += pG) {
                    const int bh = u >> 2, sp = u & 3, b = bh >> 3, h = bh & 7;
                    att::attn_unit(F.lds + RING_OFF, Qb, Kb, Vb, AO, b, h, 7 - sp, tid, pw, lane);
                    att::attn_unit(F.lds + RING_OFF, Qb, Kb, Vb, AO, b, h, sp, tid, pw, lane);
                }
            }
            if (!(args.flags & 2)) gdn_gate_rows(gw, NGW, lane, ORAW, Zb, gdn_out_norm + l * 128, GO);
        }
        SEAM(pb + 4);
        if (IN(pb + 5) && P_ON(5)) { PHASE_BEGIN;
            pg8::Gemm g{AO, (const bf16_t*)(ws + WS_WGDNO + l * MiB), 512, 512}; pg8::TwoSegOrder S;
            S.init(M, D, pG, pbx, (size_t)(WS_GO - WS_AO), (size_t)(WS_WMLAO - WS_WGDNO));
            pg8::EpiMerge2 E{MERGED, GATE};
            pg8::gemm_phase<pg8::EpiMerge2, pg8::TwoSegOrder, false>(F.lds + RING_OFF, g, S, E, pw);
        }
        SEAM(pb + 5);
        if (IN(pb + 6) && P_ON(6)) { PHASE_BEGIN;
            pg8::Gemm g{MERGED, (const bf16_t*)(ws + WS_WOUT + l * 2 * MiB), D, D}; pg8::StaticOrder S; S.init(M, D, pG, pbx);
            if (l == 0) { pg8::EpiResidB<true> E{x, XB, 1.f}; pg8::gemm_phase<pg8::EpiResidB<true>, pg8::StaticOrder, false>(F.lds + RING_OFF, g, S, E, pw); }
            else { pg8::EpiResidB<false> E{XB, XB, 1.f}; pg8::gemm_phase<pg8::EpiResidB<false>, pg8::StaticOrder, false>(F.lds + RING_OFF, g, S, E, pw); }
        }
        SEAM(pb + 6);
        if (IN(pb + 7) && P_ON(7)) { PHASE_BEGIN;
            if (l == 0) { if (I8_DUP) norm_rows_bi8(gw, NGW, lane, XB, ffn_norm, XN, SAq); else if (DENSE_UP_FP8) norm_rows_b8(gw, NGW, lane, XB, ffn_norm, XN); else norm_rows_b(gw, NGW, lane, XB, ffn_norm, XN); }
            else {
                __syncthreads();
                LAS unsigned* rbc = (LAS unsigned*)(F.lds + 131072);
                LAS int* rinfo = (LAS int*)(F.lds + 131072 + 64);
                if (tid < 16) rbc[tid] = 0u;
                __syncthreads();
                int nrow = 0;
                f32x4 gn[4]; { const GAS f32x4* gr = (const GAS f32x4*)(ffn_norm + D) + lane;
#pragma unroll
                    for (int j = 0; j < 4; ++j) gn[j] = gr[64 * j]; }
                u32x2 wc[4], wn[4];
#pragma unroll
                for (int j = 0; j < 4; ++j) { wc[j] = (u32x2){0u, 0u}; wn[j] = wc[j]; }
                if (gw < M) row_issue_b(XB + (size_t)gw * D, lane, wn);
                f32x4 rw[16][2];
#pragma unroll
                for (int j = 0; j < 4; ++j)
#pragma unroll
                    for (int i = 0; i < 4; ++i) { const float* rp = router_w + (size_t)(4 * (lane + 64 * j) + i) * NE; rw[4 * j + i][0] = *(const f32x4*)rp; rw[4 * j + i][1] = *(const f32x4*)(rp + 4); }
                for (int m = gw; m < M; m += NGW) {
#pragma unroll
                    for (int j = 0; j < 4; ++j) wc[j] = wn[j];
                    asm volatile("" : "+v"(wc[0]), "+v"(wc[1]), "+v"(wc[2]), "+v"(wc[3]));
                    if (m + NGW < M) row_issue_b(XB + (size_t)(m + NGW) * D, lane, wn);
                    f32x4 v[4]; row_norm_b(wc, gn, v);
                    { GAS unsigned* o8 = (GAS unsigned*)((unsigned char*)XN + (size_t)m * D) + lane;
#pragma unroll
                      for (int j = 0; j < 4; ++j) { const float c0 = __builtin_amdgcn_fmed3f(v[j].x, -448.f, 448.f), c1 = __builtin_amdgcn_fmed3f(v[j].y, -448.f, 448.f), c2 = __builtin_amdgcn_fmed3f(v[j].z, -448.f, 448.f), c3 = __builtin_amdgcn_fmed3f(v[j].w, -448.f, 448.f);
                        unsigned w = __builtin_amdgcn_cvt_pk_fp8_f32(c0, c1, 0, false); w = __builtin_amdgcn_cvt_pk_fp8_f32(c2, c3, w, true); o8[64 * j] = w; } }
                    float lg[NE];
#pragma unroll
                    for (int e = 0; e < NE; ++e) lg[e] = 0.f;
#pragma unroll
                    for (int j = 0; j < 4; ++j) {
                        const int c = 4 * (lane + 64 * j);
#pragma unroll
                        for (int i = 0; i < 4; ++i) {
                            const f32x4 r0 = rw[4 * j + i][0], r1 = rw[4 * j + i][1];
                            const float xv = v[j][i];
                            lg[0] += xv * r0.x; lg[1] += xv * r0.y; lg[2] += xv * r0.z; lg[3] += xv * r0.w;
                            lg[4] += xv * r1.x; lg[5] += xv * r1.y; lg[6] += xv * r1.z; lg[7] += xv * r1.w;
                        }
                    }
#pragma unroll
                    for (int e = 0; e < NE; ++e) lg[e] = wave_sum(lg[e]);
                    if (lane == 0) {
                        int i0 = 0; float b0 = lg[0];
#pragma unroll
                        for (int e = 1; e < NE; ++e) if (lg[e] > b0) { b0 = lg[e]; i0 = e; }
                        int i1 = 0; float b1 = -3.4e38f;
#pragma unroll
                        for (int e = 0; e < NE; ++e) if (e != i0 && lg[e] > b1) { b1 = lg[e]; i1 = e; }
                        const float e1 = __expf(b1 - b0); const float w0 = 1.f / (1.f + e1), w1 = e1 / (1.f + e1);
                        topw[2 * m] = w0; topw[2 * m + 1] = w1;
                        const unsigned q0 = __hip_atomic_fetch_add((LAS unsigned*)(rbc + i0), 1u, __ATOMIC_RELAXED, __HIP_MEMORY_SCOPE_WORKGROUP);
                        const unsigned q1 = __hip_atomic_fetch_add((LAS unsigned*)(rbc + i1), 1u, __ATOMIC_RELAXED, __HIP_MEMORY_SCOPE_WORKGROUP);
                        if (nrow < 16) { rinfo[(pw * 16 + nrow) * 2] = (i0 << 20) | (int)q0; rinfo[(pw * 16 + nrow) * 2 + 1] = (i1 << 20) | (int)q1; }
                    }
                    ++nrow;
                }
                __syncthreads();
                if (tid < NE) rbc[8 + tid] = atomicAdd(&cnt[tid], rbc[tid]);
                __syncthreads();
                { int k = 0;
                  for (int m = gw; m < M; m += NGW, ++k) if (lane == 0 && k < 16) {
#pragma unroll
                    for (int s2 = 0; s2 < 2; ++s2) { const int q = rinfo[(pw * 16 + k) * 2 + s2]; const int e = q >> 20; const int p = (int)rbc[8 + e] + (q & 0xfffff);
                        list[e * M + p] = 2 * m + s2; pairrow[2 * m + s2] = (e << 20) | p; }
                  } }
            }
        }
        SEAM(pb + 7);
        if (IN(pb + 9) && P_ON(9)) { PHASE_BEGIN;
            if (l == 0) {
                pg8::Gemm g{XN, (const bf16_t*)(ws + WS_WD13), D, D, SAq, (const float*)(cmx + 2 * NPROJ)}; pg8::StaticOrder S; S.init(M, 2 * D_FF, pG, pbx);
                pg8::EpiSwiGLU E{HB, D_FF, (!I8_DUP && DENSE_UP_FP8) ? 1.f / W8_SCALE : 1.f, DENSE_DN_FP8 ? H8_SCALE : 0.f};
                pg8::gemm_phase<pg8::EpiSwiGLU, pg8::StaticOrder, true, I8_DUP ? 2 : (DENSE_UP_FP8 ? 1 : 0)>(F.lds + RING_OFF, g, S, E, pw);
            } else {
                pg8::Gemm g{XN, (const bf16_t*)ap->out, D, D}; pg8::MoeGatherOrder S; S.init(cnt, list, 2 * DFE, pG, F.vcu, 7 * MiB / 2, D);
                pg8::EpiSwiGLU E{Hm, DFE, 1.f / W8_SCALE, H8_SCALE};
                pg8::gemm_phase<pg8::EpiSwiGLU, pg8::MoeGatherOrder, true, true>(F.lds + RING_OFF, g, S, E, pw);
            }
        }
        SEAM(pb + 9);
        if (IN(pb + 10) && P_ON(10)) { PHASE_BEGIN;
            if (l == 0) {
                pg8::Gemm g{HB, (const bf16_t*)(ws + WS_WD2), D_FF, D_FF}; pg8::StaticOrder S; S.init(M, D, pG, pbx);
                pg8::EpiResidB<false> E{XB, XB, DENSE_DN_FP8 ? 1.f / (W8_SCALE * H8_SCALE) : 1.f};
                pg8::gemm_phase<pg8::EpiResidB<false>, pg8::StaticOrder, false, DENSE_DN_FP8 != 0>(F.lds + RING_OFF, g, S, E, pw);
            } else {
                pg8::Gemm g{Hm, (const bf16_t*)(ws + WS_WM2), DFE, DFE}; pg8::MoeOrder S; S.init(cnt, D, pG, F.vcu, 7 * MiB / 4);
                pg8::EpiStore E{Yb, D, 1.f / (W8_SCALE * H8_SCALE)};
                pg8::gemm_phase<pg8::EpiStore, pg8::MoeOrder, true, true>(F.lds + RING_OFF, g, S, E, pw);
            }
        }
        SEAM(pb + 10);
        if (IN(pb + 11) && P_ON(11)) { PHASE_BEGIN;
            if (l == 0) { if (I8_INPROJ) norm_rows_bi8(gw, NGW, lane, XB, mix_norm + D, XN, SAq); else norm_rows_b(gw, NGW, lane, XB, mix_norm + D, XN); }
            else {
                int oo[NE]; { int a = 0; int cn8[8]; pg8::load_counts8(cnt, cn8);
#pragma unroll
                    for (int e = 0; e < NE; ++e) { oo[e] = a; a += (cn8[e] + 255) & ~255; } }
                const int nrow = (M - gw + NGW - 1) / NGW;
                int mq0 = 0, mq1 = 0; float mw0 = 0.f, mw1 = 0.f;
                if (lane < nrow) { const int mk = gw + lane * NGW; mq0 = pairrow[2 * mk]; mq1 = pairrow[2 * mk + 1]; mw0 = topw[2 * mk]; mw1 = topw[2 * mk + 1]; }
                f32x4 gfin[4]; { const GAS f32x4* gr = (const GAS f32x4*)final_norm + lane;
#pragma unroll
                    for (int j = 0; j < 4; ++j) gfin[j] = gr[64 * j]; }
#define FIN_ISSUE(k, YA, YB, XW) do { const int m_ = gw + (k) * NGW; const int q0_ = __builtin_amdgcn_readlane(mq0, (k)), q1_ = __builtin_amdgcn_readlane(mq1, (k)); int r0_ = q0_ & 0xfffff, r1_ = q1_ & 0xfffff; \
                    _Pragma("unroll") for (int e = 0; e < NE; ++e) { if ((q0_ >> 20) == e) r0_ += oo[e]; if ((q1_ >> 20) == e) r1_ += oo[e]; } \
                    const GAS u32x2* xb_ = (const GAS u32x2*)(XB + (size_t)m_ * D) + lane; const GAS u32x2* y0_ = (const GAS u32x2*)(Yb + (size_t)r0_ * D) + lane; const GAS u32x2* y1_ = (const GAS u32x2*)(Yb + (size_t)r1_ * D) + lane; \
                    _Pragma("unroll") for (int j = 0; j < 4; ++j) { YA[j] = y0_[64 * j]; YB[j] = y1_[64 * j]; XW[j] = xb_[64 * j]; } } while (0)
#define FIN_DO(k, YA, YB, XW) do { const int m_ = gw + (k) * NGW; const float w0 = __builtin_bit_cast(float, __builtin_amdgcn_readlane(__builtin_bit_cast(int, mw0), (k))), w1 = __builtin_bit_cast(float, __builtin_amdgcn_readlane(__builtin_bit_cast(int, mw1), (k))); \
                    GAS f32x4* xr = (GAS f32x4*)(X + (size_t)m_ * D) + lane;                 \
                    f32x4 v[4]; float ss = 0.f; \
                    _Pragma("unroll") for (int j = 0; j < 4; ++j) { const u32x2 a = YA[j], b = YB[j], xw = XW[j]; f32x4 t = (f32x4){bflo(xw.x), bfhi(xw.x), bflo(xw.y), bfhi(xw.y)}; \
                        t.x += w0 * bflo(a.x) + w1 * bflo(b.x); t.y += w0 * bfhi(a.x) + w1 * bfhi(b.x); t.z += w0 * bflo(a.y) + w1 * bflo(b.y); t.w += w0 * bfhi(a.y) + w1 * bfhi(b.y); \
                        v[j] = t; ss += (t.x * t.x + t.y * t.y) + (t.z * t.z + t.w * t.w); } \
                    ss = wave_sum(ss); const float rstd = rsqrtf(ss * (1.f / D) + EPS); \
                    _Pragma("unroll") for (int j = 0; j < 4; ++j) xr[64 * j] = v[j] * gfin[j] * rstd; } while (0)
                u32x2 yan[4], ybn[4], xwn[4];
#pragma unroll
                for (int j = 0; j < 4; ++j) { yan[j] = (u32x2){0u, 0u}; ybn[j] = yan[j]; xwn[j] = yan[j]; }
                if (nrow > 0) FIN_ISSUE(0, yan, ybn, xwn);
#pragma unroll 1
                for (int k = 0; k < nrow; ++k) {
                    u32x2 yac[4], ybc[4], xwc[4];
#pragma unroll
                    for (int j = 0; j < 4; ++j) { yac[j] = yan[j]; ybc[j] = ybn[j]; xwc[j] = xwn[j]; }
                    asm volatile("" : "+v"(yac[0]), "+v"(yac[1]), "+v"(yac[2]), "+v"(yac[3]), "+v"(ybc[0]), "+v"(ybc[1]), "+v"(ybc[2]), "+v"(ybc[3]), "+v"(xwc[0]), "+v"(xwc[1]), "+v"(xwc[2]), "+v"(xwc[3]));
                    if (k + 1 < nrow) FIN_ISSUE(k + 1, yan, ybn, xwn);
                    FIN_DO(k, yac, ybc, xwc);
                }
#undef FIN_ISSUE
#undef FIN_DO
            }
        }
        SEAM(pb + 11);
    }
#undef IN
#undef SEAM
}
#ifndef MEGA_MASK
#define MEGA_MASK 0xFFF
#endif
#ifndef ONE_LAUNCH
#define ONE_LAUNCH 0
#endif
static void launch_mega(hipStream_t st, Args a, int lo, int hi, int grid) {
    a.ph_lo = lo; a.ph_hi = hi;
    hipLaunchKernelGGL(mega_fwd, dim3(grid), dim3(NWAVES * 64), LDS_BYTES, st, a);
}

extern "C" void kernel_launch(void* const* d_in, const int* in_sizes, int n_in, void* d_out, int out_size, void* d_ws, size_t ws_size, hipStream_t stream) {
    static int grid = 0;
    if (grid == 0) {
        int dev = 0, cus = 0, per_cu = 0;
        if (n_in != 25 || out_size != M * D || ws_size < WS_END) { grid = -1; return; }
        if (hipGetDevice(&dev) != hipSuccess || hipDeviceGetAttribute(&cus, hipDeviceAttributeMultiprocessorCount, dev) != hipSuccess) { grid = -1; return; }
        if (hipFuncSetAttribute((const void*)mega_fwd, hipFuncAttributeMaxDynamicSharedMemorySize, LDS_BYTES) != hipSuccess) { grid = -1; return; }
        if (hipOccupancyMaxActiveBlocksPerMultiprocessor(&per_cu, (const void*)mega_fwd, NWAVES * 64, LDS_BYTES) != hipSuccess || per_cu < 1) { (void)hipGetLastError(); }
        (void)hipGetLastError();
        grid = cus;
    }
    if (grid < 0) return;
    (void)hipMemsetAsync((char*)d_ws + WS_CTL, 0, CTL_ZERO_BYTES, stream);
    Args a{};
    for (int i = 0; i < 25; ++i) a.in[i] = (const float*)d_in[i];
    a.out = (float*)d_out; a.ws = (unsigned char*)d_ws; a.flags = 0; a.pad = 0;
#if ONE_LAUNCH
    launch_mega(stream, a, 0, 25, grid);
#else
    const float* x = (const float*)d_in[0]; const int* pos = (const int*)d_in[1];
    const float* mix_norm = (const float*)d_in[2]; const float* w_in = (const float*)d_in[3]; const float* gate_bias = (const float*)d_in[4];
    const float* conv_w = (const float*)d_in[5]; const float* a_log = (const float*)d_in[6]; const float* dt_bias = (const float*)d_in[7];
    const float* gdn_out_norm = (const float*)d_in[8]; const float* w_gdn_o = (const float*)d_in[9]; const float* q_a_norm = (const float*)d_in[10];
    const float* w_q_b = (const float*)d_in[11]; const float* kv_a_norm = (const float*)d_in[12]; const float* w_kv_b = (const float*)d_in[13];
    const float* w_mla_o = (const float*)d_in[14]; const float* w_out = (const float*)d_in[15]; const float* ffn_norm = (const float*)d_in[16];
    const float* dense_w1 = (const float*)d_in[17]; const float* dense_w3 = (const float*)d_in[18]; const float* dense_w2 = (const float*)d_in[19];
    const float* router_w = (const float*)d_in[20]; const float* moe_w1 = (const float*)d_in[21]; const float* moe_w3 = (const float*)d_in[22];
    const float* moe_w2 = (const float*)d_in[23]; const float* final_norm = (const float*)d_in[24];
    float* X = (float*)d_out;
    unsigned char* ws = (unsigned char*)d_ws;
    unsigned* ctl = (unsigned*)(ws + WS_CTL);
    bf16_t* GATE = (bf16_t*)(ws + WS_GATE); bf16_t* Zb = (bf16_t*)(ws + WS_Z); bf16_t* MISC = (bf16_t*)(ws + WS_MISC); bf16_t* QKV = (bf16_t*)(ws + WS_QKV);
    bf16_t* Qb = (bf16_t*)(ws + WS_Q); bf16_t* Kb = (bf16_t*)(ws + WS_K); bf16_t* Vb = (bf16_t*)(ws + WS_V); bf16_t* AO = (bf16_t*)(ws + WS_AO); bf16_t* GO = (bf16_t*)(ws + WS_GO);
    bf16_t* XN = (bf16_t*)(ws + WS_XN); bf16_t* MERGED = (bf16_t*)(ws + WS_MERGED);
    bf16_t* HB = (bf16_t*)(ws + WS_HB); bf16_t* XG = (bf16_t*)(ws + WS_XG); bf16_t* Hm = (bf16_t*)(ws + WS_H); bf16_t* Yb = (bf16_t*)(ws + WS_Y);
    bf16_t* QN = (bf16_t*)(ws + WS_QN); bf16_t* KN = (bf16_t*)(ws + WS_KN); bf16_t* VN = (bf16_t*)(ws + WS_VN); bf16_t* QRAW = (bf16_t*)(ws + WS_QRAW);
    float* ORAW = (float*)(ws + WS_ORAW);
    float* rstdq = (float*)(ws + WS_RSTD); float* rstdkv = rstdq + M;
    float* gbuf = (float*)(ws + WS_GB); float* bbuf = gbuf + M * 4;
    int* topi = (int*)(ws + WS_MOE); float* topw = (float*)(topi + 2 * M); int* pairrow = (int*)(topw + 2 * M); int* list = pairrow + 2 * M; int* offs = list + NE * M;
    unsigned* cnt = ctl + CW_CNT;
    const int mask = MEGA_MASK;
#define USE_MEGA(s) ((mask >> (s)) & 1)
    launch_mega(stream, a, 0, 1, grid);
    for (int l = 0; l < 2; ++l) {
        const int pb = 1 + 12 * l;
        const float* xin = (l == 0) ? x : X;
        const float* wi = w_in + (size_t)l * D * IN_COLS;
        if (USE_MEGA(0)) launch_mega(stream, a, pb + 0, pb + 1, grid);
        else {
            EpiArgs e0{}; e0.mode = 0;
            e0.ob = QKV; e0.ldo = QKV_LD; e0.col0 = 0;      gemm(stream, false, XN, D, wi, nullptr, IN_COLS, WC_Q, M, 1536, D, e0);
            e0.ob = Zb; e0.ldo = Z_LD; e0.col0 = 0;         gemm(stream, false, XN, D, wi, nullptr, IN_COLS, WC_Z, M, 512, D, e0);
            e0.ob = MISC; e0.ldo = MISC_LD; e0.col0 = MC_A; gemm(stream, false, XN, D, wi, nullptr, IN_COLS, WC_A, M, 8, D, e0);
            e0.col0 = MC_CQ;  gemm(stream, false, XN, D, wi, nullptr, IN_COLS, WC_CQ, M, 384, D, e0);
            e0.col0 = MC_CKV; gemm(stream, false, XN, D, wi, nullptr, IN_COLS, WC_CKV, M, 256, D, e0);
            e0.col0 = MC_KR;  gemm(stream, false, XN, D, wi, nullptr, IN_COLS, WC_KR, M, 32, D, e0);
            EpiArgs e1{}; e1.mode = 1; e1.ob = GATE; e1.ldo = GATE_LD; e1.col0 = 0; e1.bias = gate_bias + l * 2048;
            gemm(stream, false, XN, D, wi, nullptr, IN_COLS, WC_GATE, M, 2048, D, e1);
        }
        if (USE_MEGA(1)) { launch_mega(stream, a, pb + 1, pb + 2, grid); launch_mega(stream, a, pb + 2, pb + 3, grid); }
        else {
            hipLaunchKernelGGL(k_gdn_prep, dim3(M), dim3(256), 0, stream, (const bf16_t*)QKV, (const bf16_t*)MISC, conv_w + l * 4 * 1536, a_log + l * 4, dt_bias + l * 4, QN, KN, VN, gbuf, bbuf);
            hipLaunchKernelGGL(k_gdn_rec, dim3(32, 16), dim3(1024), 0, stream, (const bf16_t*)QN, (const bf16_t*)KN, (const bf16_t*)VN, (const float*)gbuf, (const float*)bbuf, ORAW);
            hipLaunchKernelGGL(k_mla_prep, dim3(M / 4), dim3(256), 0, stream, (const bf16_t*)MISC, pos, rstdq, rstdkv, Kb);
        }
        if (USE_MEGA(3)) launch_mega(stream, a, pb + 3, pb + 4, grid);
        else {
            EpiArgs eq{}; eq.mode = 0; eq.ob = QRAW; eq.ldo = 768; eq.col0 = 0; eq.kgain = q_a_norm + l * 384; eq.rowscale = rstdq;
            gemm(stream, false, MISC + MC_CQ, MISC_LD, w_q_b + (size_t)l * 384 * 768, nullptr, 768, 0, M, 768, 384, eq);
            hipLaunchKernelGGL(k_q_rope, dim3(M * 768 / 256), dim3(256), 0, stream, (const bf16_t*)QRAW, pos, Qb);
            EpiArgs ekv{}; ekv.mode = 6; ekv.ob = Kb; ekv.ob2 = Vb; ekv.kgain = kv_a_norm + l * 256; ekv.rowscale = rstdkv;
            gemm(stream, false, MISC + MC_CKV, MISC_LD, w_kv_b + (size_t)l * 256 * 1024, nullptr, 1024, 0, M, 1024, 256, ekv);
        }
        if (USE_MEGA(4)) launch_mega(stream, a, pb + 4, pb + 5, grid);
        else {
            hipLaunchKernelGGL(k_attn, dim3(M * 8 / 4), dim3(256), 0, stream, (const bf16_t*)Qb, (const bf16_t*)Kb, (const bf16_t*)Vb, AO);
            hipLaunchKernelGGL(k_gdn_gate, dim3(M / 4), dim3(256), 0, stream, (const float*)ORAW, (const bf16_t*)Zb, gdn_out_norm + l * 128, GO);
        }
        if (USE_MEGA(5)) launch_mega(stream, a, pb + 5, pb + 6, grid);
        else {
            EpiArgs em{}; em.mode = 2; em.ob = MERGED; em.ldo = D; em.gate = GATE; em.ldg = GATE_LD; em.gcol0 = 0;
            gemm(stream, false, GO, 512, w_gdn_o + (size_t)l * 512 * D, nullptr, D, 0, M, D, 512, em);
            em.mode = 3; em.gcol0 = D;
            gemm(stream, false, AO, 512, w_mla_o + (size_t)l * 512 * D, nullptr, D, 0, M, D, 512, em);
        }
        if (USE_MEGA(6)) launch_mega(stream, a, pb + 6, pb + 7, grid);
        else { EpiArgs eo{}; eo.mode = 4; eo.res = xin; eo.of = X; gemm(stream, false, MERGED, D, w_out + (size_t)l * D * D, nullptr, D, 0, M, D, D, eo); }
        if (USE_MEGA(7)) launch_mega(stream, a, pb + 7, pb + 8, grid);
        else hipLaunchKernelGGL(k_rmsnorm, dim3(M / 4), dim3(256), 0, stream, (const float*)X, ffn_norm + l * D, XN, (float*)nullptr, l, router_w, topi, topw, cnt, list);
        if (l == 1) {
            if (USE_MEGA(8)) launch_mega(stream, a, pb + 8, pb + 9, grid);
            else {
                hipLaunchKernelGGL(k_moe_offsets, dim3(1), dim3(64), 0, stream, (const unsigned*)cnt, offs);
                hipLaunchKernelGGL(k_moe_gather, dim3(MOE_ROWS / 4), dim3(256), 0, stream, (const bf16_t*)XN, (const unsigned*)cnt, (const int*)offs, (const int*)list, XG, pairrow);
            }
        }
        if (USE_MEGA(9)) launch_mega(stream, a, pb + 9, pb + 10, grid);
        else if (l == 0) { EpiArgs eu{}; eu.mode = 5; eu.ob = HB; eu.ldo = D_FF; gemm(stream, true, XN, D, dense_w1, dense_w3, D_FF, 0, M, D_FF, D, eu); }
        else { EpiArgs eu{}; eu.mode = 5; eu.ob = Hm; eu.ldo = DFE; gemm(stream, true, XG, D, moe_w1, moe_w3, DFE, 0, MOE_ROWS, DFE, D, eu, offs, (size_t)D * DFE); }
        if (USE_MEGA(10)) launch_mega(stream, a, pb + 10, pb + 11, grid);
        else if (l == 0) { EpiArgs ed{}; ed.mode = 4; ed.res = X; ed.of = X; gemm(stream, false, HB, D_FF, dense_w2, nullptr, D, 0, M, D, D_FF, ed); }
        else { EpiArgs ed{}; ed.mode = 0; ed.ob = Yb; ed.ldo = D; ed.col0 = 0; gemm(stream, false, Hm, DFE, moe_w2, nullptr, D, 0, MOE_ROWS, D, DFE, ed, offs, (size_t)DFE * D); }
        if (USE_MEGA(11)) launch_mega(stream, a, pb + 11, pb + 12, grid);
        else if (l == 0) hipLaunchKernelGGL(k_rmsnorm, dim3(M / 4), dim3(256), 0, stream, (const float*)X, mix_norm + D, XN, (float*)nullptr, 0, (const float*)nullptr, (int*)nullptr, (float*)nullptr, (unsigned*)nullptr, (int*)nullptr);
        else {
            hipLaunchKernelGGL(k_moe_combine, dim3(M / 4), dim3(256), 0, stream, X, (const bf16_t*)Yb, (const int*)pairrow, (const float*)topw);
            hipLaunchKernelGGL(k_rmsnorm, dim3(M / 4), dim3(256), 0, stream, (const float*)X, final_norm, (bf16_t*)nullptr, X, 2, (const float*)nullptr, (int*)nullptr, (float*)nullptr, (unsigned*)nullptr, (int*)nullptr);
        }
    }
#undef USE_MEGA
#endif
}
```

```cpp
#define MEGA_MASK 0xFFF
#define ONE_LAUNCH 1
#include <hip/hip_runtime.h>
#include <stdint.h>

typedef unsigned short bf16_t;
#define DI __device__ __forceinline__
#define GAS __attribute__((address_space(1)))
#define LAS __attribute__((address_space(3)))
typedef short bf16x8 __attribute__((ext_vector_type(8)));
typedef short s16x4 __attribute__((ext_vector_type(4)));
typedef float f32x2 __attribute__((ext_vector_type(2)));
typedef float f32x4 __attribute__((ext_vector_type(4)));
typedef float f32x16 __attribute__((ext_vector_type(16)));
typedef unsigned u32x2 __attribute__((ext_vector_type(2)));
typedef unsigned u32x4 __attribute__((ext_vector_type(4)));
typedef GAS unsigned gu32;
#define RLX_AGENT __ATOMIC_RELAXED, __HIP_MEMORY_SCOPE_AGENT
#define LDS_WAIT() asm volatile("s_waitcnt lgkmcnt(0)" ::: "memory")
#define VM_WAIT() asm volatile("s_waitcnt vmcnt(0)" ::: "memory")

DI float bf2f(bf16_t v) { return __uint_as_float(((unsigned)v) << 16); }
typedef __bf16 hwbf16x2 __attribute__((ext_vector_type(2)));
DI unsigned pk2(float lo, float hi) { const f32x2 v = (f32x2){lo, hi}; return __builtin_bit_cast(unsigned, __builtin_convertvector(v, hwbf16x2)); }
DI unsigned f2bf(float f) { return pk2(f, 0.f) & 0xffffu; }
DI float bflo(unsigned w) { return __uint_as_float(w << 16); }
DI float bfhi(unsigned w) { return __uint_as_float(w & 0xffff0000u); }
DI float siluf(float x) { return x * __builtin_amdgcn_rcpf(1.f + __expf(-x)); }
DI float sigmf(float x) { return __builtin_amdgcn_rcpf(1.f + __expf(-x)); }
DI void lds_barrier() { asm volatile("s_waitcnt lgkmcnt(0)" ::: "memory"); __builtin_amdgcn_s_barrier(); asm volatile("" ::: "memory"); }
DI int lane_id_asm() { int l; asm volatile("v_mbcnt_lo_u32_b32 %0, -1, 0\n\tv_mbcnt_hi_u32_b32 %0, -1, %0" : "=v"(l)); return l; }
template <int K> DI float swz_xor(float v) { return __int_as_float(__builtin_amdgcn_ds_swizzle(__float_as_int(v), (K << 10) | 0x1F)); }
DI float xor32_sum(float v) { const auto rr = __builtin_amdgcn_permlane32_swap(__float_as_uint(v), __float_as_uint(v), false, false); return __uint_as_float(rr[0]) + __uint_as_float(rr[1]); }
template <int CTRL> DI float dpp_f(float v) { return __int_as_float(__builtin_amdgcn_update_dpp(0, __float_as_int(v), CTRL, 0xf, 0xf, true)); }
DI float row16_sum(float v) { v += dpp_f<0xB1>(v); v += dpp_f<0x4E>(v); v += dpp_f<0x141>(v); v += dpp_f<0x140>(v); return v; }
DI float row16_max(float v) { v = fmaxf(v, dpp_f<0xB1>(v)); v = fmaxf(v, dpp_f<0x4E>(v)); v = fmaxf(v, dpp_f<0x141>(v)); v = fmaxf(v, dpp_f<0x140>(v)); return v; }
DI float xor8_f(float v) { return dpp_f<0x128>(v); }
DI float wave_sum(float v) {
    v = row16_sum(v); v += swz_xor<16>(v);
    return xor32_sum(v);
}

constexpr int M = 16384, D = 1024, SEQ = 2048, NBATCH = 8;
constexpr int IN_COLS = 4776;
constexpr int NPROJ = 4864;
constexpr int MC_CQ = 0, MC_CKV = 384, MC_KR = 640, MC_A = 672, MC_B = 676, MISC_LD = 768;
constexpr int QKV_LD = 1536, Z_LD = 512, GATE_LD = 2048;
constexpr int WC_Q = 0, WC_Z = 1536, WC_A = 2048, WC_B = 2052, WC_CQ = 2056, WC_CKV = 2440, WC_KR = 2696, WC_GATE = 2728;
constexpr int D_FF = 3584, NE = 8, DFE = 1792;
constexpr int MOE_ROWS = 34816;
constexpr float EPS = 1e-6f;
constexpr float QSCALE = 0.10206207261596575f * 1.4426950408889634f;
constexpr int NCHUNK = 32;

constexpr size_t MiB = 1u << 20, KiB = 1u << 10;
constexpr size_t WS_CTL = 0, CTL_ZERO_BYTES = 256 * KiB;
constexpr size_t WS_WIN = 1 * MiB;
constexpr size_t WIN_STRIDE = (size_t)NPROJ * 1024 * 2;
constexpr size_t WS_WGDNO = 20 * MiB;
constexpr size_t WS_WMLAO = 22 * MiB;
constexpr size_t WS_WOUT = 24 * MiB;
constexpr size_t WS_WQB = 28 * MiB;
constexpr size_t WS_WKVB = 29 * MiB + 512 * KiB;
constexpr size_t WS_WD13 = 31 * MiB;
constexpr size_t WS_WD2 = 45 * MiB;
constexpr size_t WS_WM2 = 1 * MiB;
constexpr size_t WS_GATE = 53 * MiB;
constexpr size_t WS_Z = 117 * MiB;
constexpr size_t WS_MISC = 133 * MiB;
constexpr size_t WS_QKV = 157 * MiB;
constexpr size_t WS_Q = 157 * MiB;
constexpr size_t WS_K = 181 * MiB;
constexpr size_t WS_GDNL = 205 * MiB;
constexpr size_t WS_UT = 205 * MiB, WS_W = 221 * MiB, WS_QD = 237 * MiB, WS_KDT = 253 * MiB, WS_AT = 269 * MiB;
constexpr size_t WS_V = 205 * MiB;
constexpr size_t WS_AO = 221 * MiB;
constexpr size_t WS_GO = 237 * MiB;
constexpr size_t WS_QN = 205 * MiB, WS_KN = 221 * MiB, WS_VN = 237 * MiB, WS_QRAW = 253 * MiB;
constexpr size_t WS_XB = 277 * MiB;
constexpr float W8_SCALE = 32.f, H8_SCALE = 4.f;
#ifndef DENSE_UP_FP8
#define DENSE_UP_FP8 0
#endif
#ifndef DENSE_DN_FP8
#define DENSE_DN_FP8 0
#endif
constexpr float W8S_UNUSED = 32.f;
constexpr size_t OUT_XN = 32 * MiB;
constexpr size_t WS_XN_UNUSED = 277 * MiB;
constexpr size_t WS_ORAW = 277 * MiB;
constexpr size_t WS_MERGED = 277 * MiB;
constexpr size_t WS_HB = 53 * MiB;
constexpr size_t WS_XG = 85 * MiB;
constexpr size_t WS_Y = 85 * MiB;
constexpr size_t WS_H = 153 * MiB;
constexpr size_t WS_MOE = 309 * MiB;
constexpr size_t WS_COS = 311 * MiB, WS_SIN = 312 * MiB;
constexpr size_t WS_RSTD = 313 * MiB;
constexpr size_t WS_CD = 313 * MiB + 256 * KiB;
constexpr size_t WS_GB = 313 * MiB + 512 * KiB;
constexpr size_t WS_END = 314 * MiB;
constexpr int CW_CNT = 64;
constexpr int CW_BAR = 4096;
constexpr int CW_CMAX = 32768;
constexpr size_t WS_SA = 314 * MiB;
#ifndef I8_INPROJ
#define I8_INPROJ 1
#endif
#ifndef I8_DUP
#define I8_DUP 1
#endif
namespace pg8 {
constexpr int BM = 256, BK = 64, HALF = 128, HTB = HALF * BK * 2  , STAGE_BYTES = 8 * HTB, NXCD = 8, WGM = 8;

__host__ __device__ __forceinline__ int lds_byte(int r, int c) { const int st = (r >> 4) * 2 + (c >> 5), rr = r & 15, cc = c & 31, ob = rr * 64 + cc * 2; return st * 1024 + (ob ^ (((ob >> 9) & 1) << 5)); }
__host__ __device__ __forceinline__ void stage_rc(int b, int& R, int& C) { const int st = b / 1024, sb = b % 1024, swz = sb ^ (((sb >> 9) & 1) << 5); R = (st >> 1) * 16 + swz / 64; C = (st & 1) * 32 + (swz % 64) / 2; }
__host__ __device__ __forceinline__ int perm32(int rho) { const int n = rho >> 4, i = rho & 15; return 8 * (i >> 2) + 4 * n + (i & 3); }

struct Unit { int pm, pn; size_t boff; size_t aoff; int kind; };
struct Gemm { const bf16_t* A; const bf16_t* Bt; int lda, K; const float* sA; const float* sB; };

struct StaticOrder {
    static constexpr bool GATHER = false;
    int nM, nN, nwg, G, c;
    __device__ void init(int Mr, int N, int G_, int c_) { nM = Mr / BM; nN = N / BM; nwg = nM * nN; G = G_; c = c_; }
    __device__ bool next(int i, Unit& u) const {
        const long L = (long)i * G + c; if (L >= nwg) return false;
        int wgid = (int)L; { const int q = nwg / NXCD, r = nwg % NXCD, xcd = wgid % NXCD, off = wgid / NXCD; wgid = (xcd < r ? xcd * (q + 1) : r * (q + 1) + (xcd - r) * q) + off; }
        const int nig = WGM * nN, gid = wgid / nig, fm = gid * WGM, gsz = (nM - fm) < WGM ? (nM - fm) : WGM;
        u.pm = fm + ((wgid % nig) % gsz); u.pn = (wgid % nig) / gsz; u.boff = 0; u.aoff = 0; u.kind = 0; return true;
    }
    __device__ __forceinline__ void a_ready(const Unit&) const {}
    __device__ __forceinline__ void done(const Unit&) const {}
};
struct TwoSegOrder {
    static constexpr bool GATHER = false;
    StaticOrder so; size_t aoff1, boff1;
    __device__ void init(int Mr, int N, int G_, int c_, size_t aoff1_, size_t boff1_) { so.init(Mr, N, G_, c_); aoff1 = aoff1_; boff1 = boff1_; }
    __device__ bool next(int i, Unit& u) const {
        if (!so.next(i >> 1, u)) return false;
        const int sgm = i & 1; u.kind = sgm; u.aoff = sgm ? aoff1 : 0; u.boff = sgm ? 0 : boff1; return true;
    }
    __device__ __forceinline__ void a_ready(const Unit&) const {}
    __device__ __forceinline__ void done(const Unit&) const {}
};
DI void load_counts8(const unsigned* cnt, int (&cn)[8]) {
    const int l = lane_id_asm();
    const int v = (int)__hip_atomic_load(cnt + (l & 7), __ATOMIC_RELAXED, __HIP_MEMORY_SCOPE_AGENT);
#pragma unroll
    for (int e = 0; e < 8; ++e) cn[e] = __builtin_amdgcn_readlane(v, e);
}
struct MoeOrder {
    static constexpr bool GATHER = false;
    int nN, G, c, cb, nunits; int o1, o2, o3, o4, o5, o6, o7; size_t estride;
    __device__ void init(const unsigned* cnt, int N, int G_, int c_, size_t estride_, int cb_) {
        nN = N / BM; G = G_; c = c_; cb = cb_; estride = estride_;
        int o[9]; int a = 0; int cn8[8]; load_counts8(cnt, cn8);
#pragma unroll
        for (int e = 0; e < 8; ++e) { o[e] = a; a += (cn8[e] + 255) & ~255; }
        o[8] = a;
        o1 = o[1]; o2 = o[2]; o3 = o[3]; o4 = o[4]; o5 = o[5]; o6 = o[6]; o7 = o[7];
        nunits = (a / BM) * nN;
    }
    __device__ bool next(int i, Unit& u) const {
        const long L = (long)i * G + (((long)(i + 1) * G > nunits) ? cb : c); if (L >= nunits) return false;
        const int rt = (int)L / nN, pn = (int)L % nN, r0 = rt * BM;
        const int e = (r0 >= o1) + (r0 >= o2) + (r0 >= o3) + (r0 >= o4) + (r0 >= o5) + (r0 >= o6) + (r0 >= o7);
        u.pm = rt; u.pn = pn; u.boff = (size_t)e * estride; u.aoff = 0; u.kind = e; return true;
    }
    __device__ __forceinline__ void a_ready(const Unit&) const {}
    __device__ __forceinline__ void done(const Unit&) const {}
};

struct MoeGatherOrder {
    static constexpr bool GATHER = true;
    int nN, G, c, cb, nunits; int o[9]; int cn[8]; size_t estride; const int* list; int rowbytes;
    __device__ void init(const unsigned* cnt, const int* list_, int N, int G_, int c_, size_t estride_, int rowbytes_, int cb_) {
        nN = N / BM; G = G_; c = c_; cb = cb_; estride = estride_; list = list_; rowbytes = rowbytes_;
        int a = 0; load_counts8(cnt, cn);
#pragma unroll
        for (int e = 0; e < 8; ++e) { o[e] = a; a += (cn[e] + 255) & ~255; }
        o[8] = a; nunits = (a / BM) * nN;
    }
    __device__ bool next(int i, Unit& u) const {
        const long L = (long)i * G + (((long)(i + 1) * G > nunits) ? cb : c); if (L >= nunits) return false;
        const int rt = (int)L / nN, pn = (int)L % nN, r0 = rt * BM;
        int e = 0;
#pragma unroll
        for (int k = 1; k < 8; ++k) e += (r0 >= o[k]);
        u.pm = rt; u.pn = pn; u.boff = (size_t)e * estride; u.aoff = 0; u.kind = e; return true;
    }
    __device__ __forceinline__ unsigned row_off(const Unit& u, int R) const {
        int oe = 0, ce = 0;
#pragma unroll
        for (int k = 0; k < 8; ++k) if (u.kind == k) { oe = o[k]; ce = cn[k]; }
        const int p = u.pm * BM + R - oe;
        const int tok = (p < ce) ? (list[(size_t)u.kind * 16384 + p] >> 1) : 0;
        return (unsigned)tok * (unsigned)rowbytes;
    }
    __device__ __forceinline__ void a_ready(const Unit&) const {}
    __device__ __forceinline__ void done(const Unit&) const {}
};

DI unsigned cvt_pk_bf16(float lo, float hi) { return pk2(lo, hi); }
DI u32x4 pack8(const f32x4 v0, const f32x4 v1) { u32x4 w; w.x = cvt_pk_bf16(v0[0], v0[1]); w.y = cvt_pk_bf16(v0[2], v0[3]); w.z = cvt_pk_bf16(v1[0], v1[1]); w.w = cvt_pk_bf16(v1[2], v1[3]); return w; }
DI f32x4 sig4(f32x4 v) { f32x4 r; r[0] = sigmf(v[0]); r[1] = sigmf(v[1]); r[2] = sigmf(v[2]); r[3] = sigmf(v[3]); return r; }
DI f32x4 silu4(f32x4 v) { f32x4 r; r[0] = siluf(v[0]); r[1] = siluf(v[1]); r[2] = siluf(v[2]); r[3] = siluf(v[3]); return r; }

typedef const f32x4 (&AccRef)[2][2][4][2];
typedef int i32x4_t __attribute__((ext_vector_type(4)));

struct EpiInProj {
    static constexpr bool AFTER_DRAIN = false; static constexpr bool TWOSEG = false; static constexpr bool PERM = true;
    bf16_t *QKV, *Z, *MISC, *GATE; const float* bias;
    DI void operator()(AccRef acc, const Unit& u, int wr, int wc, int fr, int fq) const {
        const int pn = u.pn; const int row0 = u.pm * BM + wr * 64 + fr;
        if (pn >= 11) {
            const int j = pn - 11, c0 = j * HALF + wc * 32 + 8 * fq;
            f32x4 ba[2], bb[2];
#pragma unroll
            for (int n = 0; n < 2; ++n) { ba[n] = *(const f32x4*)(bias + c0 + 4 * n); bb[n] = *(const f32x4*)(bias + 1024 + c0 + 4 * n); }
#pragma unroll
            for (int ai = 0; ai < 2; ++ai)
#pragma unroll
                for (int m = 0; m < 4; ++m) { bf16_t* rowp = GATE + (size_t)(row0 + ai * HALF + m * 16) * GATE_LD + c0;
                    f32x4 ga0 = sig4(acc[ai][0][m][0] + ba[0]), ga1 = sig4(acc[ai][0][m][1] + ba[1]);
                    f32x4 gb0 = sig4(acc[ai][1][m][0] + bb[0]), gb1 = sig4(acc[ai][1][m][1] + bb[1]);
                    const u32x4 wa = pack8(ga0, ga1);
                    f32x4 ra0, ra1; ra0[0] = bflo(wa.x); ra0[1] = bfhi(wa.x); ra0[2] = bflo(wa.y); ra0[3] = bfhi(wa.y); ra1[0] = bflo(wa.z); ra1[1] = bfhi(wa.z); ra1[2] = bflo(wa.w); ra1[3] = bfhi(wa.w);
#pragma unroll
                    for (int i = 0; i < 4; ++i) { gb0[i] *= __builtin_amdgcn_rcpf(ra0[i]); gb1[i] *= __builtin_amdgcn_rcpf(ra1[i]); }
                    __builtin_nontemporal_store(wa, (u32x4*)rowp); __builtin_nontemporal_store(pack8(gb0, gb1), (u32x4*)(rowp + 1024));
                    asm volatile("" ::: "memory"); }
            return;
        }
        bf16_t* base; int ld, colt;
        if (pn < 6) { base = QKV; ld = QKV_LD; colt = pn * 256; }
        else if (pn < 8) { base = Z; ld = Z_LD; colt = (pn - 6) * 256; }
        else { base = MISC; ld = MISC_LD; colt = (pn - 8) * 256; }
        const int col0 = colt + wc * 32 + 8 * fq;
#pragma unroll
        for (int ai = 0; ai < 2; ++ai)
#pragma unroll
            for (int m = 0; m < 4; ++m) { bf16_t* rowp = base + (size_t)(row0 + ai * HALF + m * 16) * ld + col0;
#pragma unroll
                for (int bj = 0; bj < 2; ++bj) *(u32x4*)(rowp + bj * HALF) = pack8(acc[ai][bj][m][0], acc[ai][bj][m][1]);
                asm volatile("" ::: "memory"); }
    }
};
struct EpiQRope {
    static constexpr bool AFTER_DRAIN = false; static constexpr bool TWOSEG = false; static constexpr bool PERM = false;
    bf16_t* Q; const float* rstd; const float* COS; const float* SIN;
    DI void operator()(AccRef acc, const Unit& u, int wr, int wc, int fr, int fq) const {
        const int row0 = u.pm * BM + wr * 64 + fr;
#pragma unroll
        for (int ai = 0; ai < 2; ++ai) {
            float scv[4]; f32x4 csv[4], snv[4];
#pragma unroll
            for (int m = 0; m < 4; ++m) { const int row = row0 + ai * HALF + m * 16; scv[m] = rstd[row]; csv[m] = *(const f32x4*)(COS + (size_t)row * 16 + 4 * fq); snv[m] = *(const f32x4*)(SIN + (size_t)row * 16 + 4 * fq); }
#pragma unroll
            for (int m = 0; m < 4; ++m) {
                const int row = row0 + ai * HALF + m * 16;
                const float sc = scv[m] * QSCALE;
                const f32x4 cs = csv[m], sn = snv[m];
#pragma unroll
                for (int bj = 0; bj < 2; ++bj) {
                    const int gi = 8 * u.pn + 4 * bj + wc;
                    f32x4 v0 = acc[ai][bj][m][0] * sc, v1 = acc[ai][bj][m][1] * sc;
                    if (gi % 3 == 2) { const f32x4 o0 = v0 * cs - v1 * sn, o1 = v1 * cs + v0 * sn; v0 = o0; v1 = o1; }
                    bf16_t* p = Q + (size_t)row * 768 + gi * 32 + 4 * fq;
                    u32x2 w0, w1; w0.x = cvt_pk_bf16(v0[0], v0[1]); w0.y = cvt_pk_bf16(v0[2], v0[3]); w1.x = cvt_pk_bf16(v1[0], v1[1]); w1.y = cvt_pk_bf16(v1[2], v1[3]);
                    *(u32x2*)p = w0; *(u32x2*)(p + 16) = w1;
                }
            }
            asm volatile("" ::: "memory");
        }
    }
};
struct EpiKV {
    static constexpr bool AFTER_DRAIN = true; static constexpr bool TWOSEG = false; static constexpr bool PERM = true;
    bf16_t* K; bf16_t* V; const float* rstd;
    DI void operator()(AccRef, const Unit&, int, int, int, int) const {}
    DI void after(AccRef acc, const Unit& u, int wr, int wc, int fr, int fq, LAS unsigned char* lds, int tid) const {
#pragma unroll
        for (int ai = 0; ai < 2; ++ai)
#pragma unroll
            for (int m = 0; m < 4; ++m) { const int r = wr * 64 + ai * HALF + m * 16 + fr; const float sc = rstd[u.pm * BM + r];
#pragma unroll
                for (int bj = 0; bj < 2; ++bj) *(LAS u32x4*)(lds + r * 528 + (bj * HALF + wc * 32 + 8 * fq) * 2) = pack8(acc[ai][bj][m][0] * sc, acc[ai][bj][m][1] * sc); }
        asm volatile("s_waitcnt lgkmcnt(0)" ::: "memory"); __builtin_amdgcn_s_barrier(); asm volatile("" ::: "memory");
        const int ch = tid & 31, r0 = tid >> 5;
#pragma unroll 4
        for (int i = 0; i < 16; ++i) {
            const int r = r0 + 16 * i;
            const u32x4 a = *(const LAS u32x4*)(lds + r * 528 + ch * 16);
            const size_t row = (size_t)(u.pm * BM + r); const int c = (u.pn & 1) * 256 + ch * 8;
            bf16_t* p = (u.pn < 2) ? K + row * 768 + (c >> 6) * 96 + (c & 63) : V + row * 512 + c;
            *(u32x4*)p = a;
        }
    }
};
template <int MODE> struct EpiMerge {
    static constexpr bool AFTER_DRAIN = false; static constexpr bool TWOSEG = false; static constexpr bool PERM = true;
    bf16_t* MG; const bf16_t* GATE;
    DI void operator()(AccRef acc, const Unit& u, int wr, int wc, int fr, int fq) const {
        const int row0 = u.pm * BM + wr * 64 + fr, col0 = u.pn * BM + wc * 32 + 8 * fq;
#pragma unroll
        for (int ai = 0; ai < 2; ++ai)
#pragma unroll
            for (int m = 0; m < 4; ++m) { const size_t row = (size_t)(row0 + ai * HALF + m * 16);
#pragma unroll
                for (int bj = 0; bj < 2; ++bj) {
                    const u32x4 g = *(const u32x4*)(GATE + row * GATE_LD + MODE * 1024 + col0 + bj * HALF);
                    bf16_t* p = MG + row * 1024 + col0 + bj * HALF;
                    f32x4 v0 = acc[ai][bj][m][0], v1 = acc[ai][bj][m][1];
                    v0[0] *= bflo(g.x); v0[1] *= bfhi(g.x); v0[2] *= bflo(g.y); v0[3] *= bfhi(g.y);
                    v1[0] *= bflo(g.z); v1[1] *= bfhi(g.z); v1[2] *= bflo(g.w); v1[3] *= bfhi(g.w);
                    if (MODE == 1) { const u32x4 o = *(const u32x4*)p;
                        v0[0] += bflo(o.x); v0[1] += bfhi(o.x); v0[2] += bflo(o.y); v0[3] += bfhi(o.y);
                        v1[0] += bflo(o.z); v1[1] += bfhi(o.z); v1[2] += bflo(o.w); v1[3] += bfhi(o.w); }
                    *(u32x4*)p = pack8(v0, v1);
                }
                asm volatile("" ::: "memory");
            }
    }
};
struct EpiMerge2 {
    static constexpr bool AFTER_DRAIN = true; static constexpr bool TWOSEG = true; static constexpr bool PERM = true;
    bf16_t* MG; const bf16_t* GATE;
    DI void mid(f32x4 (&acc)[2][2][4][2], const Unit& u, int wr, int wc, int fr, int fq) const {
        const int row0 = u.pm * BM + wr * 64 + fr, col0 = u.pn * BM + wc * 32 + 8 * fq;
#pragma unroll
        for (int ai = 0; ai < 2; ++ai) {
            u32x4 rr[4][2];
#pragma unroll
            for (int m = 0; m < 4; ++m)
#pragma unroll
                for (int bj = 0; bj < 2; ++bj) rr[m][bj] = *(const u32x4*)(GATE + (size_t)(row0 + ai * HALF + m * 16) * GATE_LD + 1024 + col0 + bj * HALF);
#pragma unroll
            for (int m = 0; m < 4; ++m)
#pragma unroll
                for (int bj = 0; bj < 2; ++bj) { const u32x4 r = rr[m][bj];
                    f32x4& v0 = acc[ai][bj][m][0]; f32x4& v1 = acc[ai][bj][m][1];
                    v0[0] *= bflo(r.x); v0[1] *= bfhi(r.x); v0[2] *= bflo(r.y); v0[3] *= bfhi(r.y);
                    v1[0] *= bflo(r.z); v1[1] *= bfhi(r.z); v1[2] *= bflo(r.w); v1[3] *= bfhi(r.w); }
            asm volatile("" ::: "memory"); }
    }
    DI void operator()(AccRef, const Unit&, int, int, int, int) const {}
    DI void after(AccRef acc, const Unit& u, int wr, int wc, int fr, int fq, LAS unsigned char* lds, int tid) const {
#pragma unroll
        for (int ai = 0; ai < 2; ++ai)
#pragma unroll
            for (int m = 0; m < 4; ++m) { const int r = wr * 64 + ai * HALF + m * 16 + fr;
#pragma unroll
                for (int bj = 0; bj < 2; ++bj) *(LAS u32x4*)(lds + r * 528 + (bj * HALF + wc * 32 + 8 * fq) * 2) = pack8(acc[ai][bj][m][0], acc[ai][bj][m][1]); }
        asm volatile("s_waitcnt lgkmcnt(0)" ::: "memory"); __builtin_amdgcn_s_barrier(); asm volatile("" ::: "memory");
        const int ch = tid & 31, r0 = tid >> 5;
        u32x4 gg[16];
#pragma unroll
        for (int i = 0; i < 16; ++i) gg[i] = *(const u32x4*)(GATE + (size_t)(u.pm * BM + r0 + 16 * i) * GATE_LD + u.pn * BM + ch * 8);
#pragma unroll
        for (int i = 0; i < 16; ++i) {
            const int r = r0 + 16 * i;
            const u32x4 a = *(const LAS u32x4*)(lds + r * 528 + ch * 16);
            const size_t row = (size_t)(u.pm * BM + r); const int col = u.pn * BM + ch * 8;
            const u32x4 g = gg[i];
            f32x4 v0, v1; v0[0] = bflo(a.x) * bflo(g.x); v0[1] = bfhi(a.x) * bfhi(g.x); v0[2] = bflo(a.y) * bflo(g.y); v0[3] = bfhi(a.y) * bfhi(g.y);
            v1[0] = bflo(a.z) * bflo(g.z); v1[1] = bfhi(a.z) * bfhi(g.z); v1[2] = bflo(a.w) * bflo(g.w); v1[3] = bfhi(a.w) * bfhi(g.w);
            *(u32x4*)(MG + row * 1024 + col) = pack8(v0, v1);
        }
    }
};
struct EpiResid {
    static constexpr bool AFTER_DRAIN = false; static constexpr bool TWOSEG = false; static constexpr bool PERM = false;
    const float* res; float* out;
    DI void operator()(AccRef acc, const Unit& u, int wr, int wc, int fr, int fq) const {
        const int row0 = u.pm * BM + wr * 64 + fr, col0 = u.pn * BM + wc * 32 + 4 * fq;
#pragma unroll
        for (int ai = 0; ai < 2; ++ai)
#pragma unroll
            for (int m = 0; m < 4; ++m) { const size_t off = (size_t)(row0 + ai * HALF + m * 16) * D + col0;
#pragma unroll
                for (int bj = 0; bj < 2; ++bj)
#pragma unroll
                    for (int n = 0; n < 2; ++n) { const f32x4 r = *(const f32x4*)(res + off + bj * HALF + n * 16); *(f32x4*)(out + off + bj * HALF + n * 16) = r + acc[ai][bj][m][n]; }
                asm volatile("" ::: "memory"); }
    }
};
template <bool RES_F32> struct EpiResidB {
    static constexpr bool AFTER_DRAIN = true; static constexpr bool TWOSEG = false; static constexpr bool PERM = true;
    const void* res; bf16_t* out; float scale;
    DI void operator()(AccRef, const Unit&, int, int, int, int) const {}
    DI void after(AccRef acc, const Unit& u, int wr, int wc, int fr, int fq, LAS unsigned char* lds, int tid) const {
#pragma unroll
        for (int ai = 0; ai < 2; ++ai)
#pragma unroll
            for (int m = 0; m < 4; ++m) { const int r = wr * 64 + ai * HALF + m * 16 + fr;
#pragma unroll
                for (int bj = 0; bj < 2; ++bj) *(LAS u32x4*)(lds + r * 528 + (bj * HALF + wc * 32 + 8 * fq) * 2) = (scale == 1.f) ? pack8(acc[ai][bj][m][0], acc[ai][bj][m][1]) : pack8(acc[ai][bj][m][0] * scale, acc[ai][bj][m][1] * scale); }
        asm volatile("s_waitcnt lgkmcnt(0)" ::: "memory"); __builtin_amdgcn_s_barrier(); asm volatile("" ::: "memory");
        const int ch = tid & 31, r0 = tid >> 5;
#pragma unroll
        for (int i0 = 0; i0 < 16; i0 += 8) {
        f32x4 rf[RES_F32 ? 8 : 1][2]; u32x4 rb[RES_F32 ? 1 : 8];
#pragma unroll
        for (int i = 0; i < 8; ++i) { const size_t off = (size_t)(u.pm * BM + r0 + 16 * (i0 + i)) * D + u.pn * BM + ch * 8;
            if (RES_F32) { const float* rp = (const float*)res + off; rf[RES_F32 ? i : 0][0] = __builtin_nontemporal_load((const f32x4*)rp); rf[RES_F32 ? i : 0][1] = __builtin_nontemporal_load((const f32x4*)(rp + 4)); }
            else rb[RES_F32 ? 0 : i] = *(const u32x4*)((const bf16_t*)res + off); }
#pragma unroll
        for (int i = 0; i < 8; ++i) {
            const int r = r0 + 16 * (i0 + i);
            const u32x4 a = *(const LAS u32x4*)(lds + r * 528 + ch * 16);
            const size_t off = (size_t)(u.pm * BM + r) * D + u.pn * BM + ch * 8;
            f32x4 v0, v1; v0[0] = bflo(a.x); v0[1] = bfhi(a.x); v0[2] = bflo(a.y); v0[3] = bfhi(a.y); v1[0] = bflo(a.z); v1[1] = bfhi(a.z); v1[2] = bflo(a.w); v1[3] = bfhi(a.w);
            if (RES_F32) { v0 = v0 + rf[RES_F32 ? i : 0][0]; v1 = v1 + rf[RES_F32 ? i : 0][1]; }
            else { const u32x4 rr = rb[RES_F32 ? 0 : i];
                v0[0] += bflo(rr.x); v0[1] += bfhi(rr.x); v0[2] += bflo(rr.y); v0[3] += bfhi(rr.y); v1[0] += bflo(rr.z); v1[1] += bfhi(rr.z); v1[2] += bflo(rr.w); v1[3] += bfhi(rr.w); }
            *(u32x4*)(out + off) = pack8(v0, v1);
        }
        }
    }
};
struct EpiSwiGLU {
    static constexpr bool AFTER_DRAIN = false; static constexpr bool TWOSEG = false; static constexpr bool PERM = true;
    bf16_t* H; int ldh; float scale; float oscale;
    DI void operator()(AccRef acc, const Unit& u, int wr, int wc, int fr, int fq) const {
        const int row0 = u.pm * BM + wr * 64 + fr, col0 = u.pn * HALF + wc * 32 + 8 * fq;
#pragma unroll
        for (int ai = 0; ai < 2; ++ai)
#pragma unroll
            for (int m = 0; m < 4; ++m) {
                f32x4 g0 = acc[ai][0][m][0], g1 = acc[ai][0][m][1], u0 = acc[ai][1][m][0], u1 = acc[ai][1][m][1];
                if (scale != 1.f) { g0 = g0 * scale; g1 = g1 * scale; u0 = u0 * scale; u1 = u1 * scale; }
                const f32x4 v0 = silu4(g0) * u0, v1 = silu4(g1) * u1;
                if (oscale != 0.f) { f32x4 w0 = v0 * oscale, w1 = v1 * oscale; u32x2 o;
#pragma unroll
                    for (int i = 0; i < 4; ++i) { w0[i] = __builtin_amdgcn_fmed3f(w0[i], -448.f, 448.f); w1[i] = __builtin_amdgcn_fmed3f(w1[i], -448.f, 448.f); }
                    o.x = __builtin_amdgcn_cvt_pk_fp8_f32(w0[0], w0[1], 0, false); o.x = __builtin_amdgcn_cvt_pk_fp8_f32(w0[2], w0[3], o.x, true);
                    o.y = __builtin_amdgcn_cvt_pk_fp8_f32(w1[0], w1[1], 0, false); o.y = __builtin_amdgcn_cvt_pk_fp8_f32(w1[2], w1[3], o.y, true);
                    __builtin_nontemporal_store(o, (u32x2*)((unsigned char*)H + (size_t)(row0 + ai * HALF + m * 16) * ldh + col0)); }
                else __builtin_nontemporal_store(pack8(v0, v1), (u32x4*)(H + (size_t)(row0 + ai * HALF + m * 16) * ldh + col0));
                asm volatile("" ::: "memory");
            }
    }
};
struct EpiStore {
    static constexpr bool AFTER_DRAIN = false; static constexpr bool TWOSEG = false; static constexpr bool PERM = true;
    bf16_t* O; int ldc; float scale;
    DI void operator()(AccRef acc, const Unit& u, int wr, int wc, int fr, int fq) const {
        const int row0 = u.pm * BM + wr * 64 + fr, col0 = u.pn * BM + wc * 32 + 8 * fq;
#pragma unroll
        for (int ai = 0; ai < 2; ++ai)
#pragma unroll
            for (int m = 0; m < 4; ++m) { bf16_t* rowp = O + (size_t)(row0 + ai * HALF + m * 16) * ldc + col0;
#pragma unroll
                for (int bj = 0; bj < 2; ++bj) *(u32x4*)(rowp + bj * HALF) = pack8(acc[ai][bj][m][0] * scale, acc[ai][bj][m][1] * scale);
                asm volatile("" ::: "memory"); }
    }
};

template <class Epi, class Sched, bool ALIGN_EPI, int QM = 0>
DI void gemm_phase(LAS unsigned char* lds, const Gemm g, const Sched& S, const Epi& E, int tid_in) {
    constexpr bool FP8 = (QM == 1); constexpr bool I8 = (QM == 2);
    int tid_ = tid_in * 64 + lane_id_asm();
    const int tid = tid_, wid = tid_in, lane = tid & 63, wr = wid >> 2, wc = wid & 3, fr = lane & 15, fq = lane >> 4;
    constexpr int EB = QM ? 1 : 2;
    const int K = g.K, lda = g.lda, nt = K * EB / (BK * 2);
    const char* gA = (const char*)g.A; const char* gB = (const char*)g.Bt;
    asm volatile("" : "+s"(gA), "+s"(gB));
    const __amdgpu_buffer_rsrc_t rsA = __builtin_amdgcn_make_buffer_rsrc((void*)gA, 0, 0x7ffff000, 0x00020000), rsB = __builtin_amdgcn_make_buffer_rsrc((void*)gB, 0, 0x7ffff000, 0x00020000);
    unsigned voffA[2], voffB[2];
#pragma unroll
    for (int i = 0; i < 2; ++i) { int R, C; stage_rc(tid * 16 + i * 8192, R, C); const int Rb = Epi::PERM ? ((R & ~31) + perm32(R & 31)) : R;
        voffA[i] = (unsigned)(R * lda * EB + C * 2); voffB[i] = (unsigned)(Rb * K * EB + C * 2); }
    constexpr bool GATHER = Sched::GATHER;
    const unsigned kstep = (unsigned)(BK * 2);
    const unsigned hstepA = GATHER ? 0u : (unsigned)(HALF * lda * EB), hstepB = (unsigned)(HALF * K * EB);
    const unsigned tstepA = GATHER ? 0u : 2u * hstepA, tstepB = 2u * hstepB;
    unsigned va[2][2] = {{0u, 0u}, {0u, 0u}}, vaN[2][2] = {{0u, 0u}, {0u, 0u}};
    const unsigned ldsw = (unsigned)wid * 1024u;
    const int aoff = lds_byte(wr * 64 + fr, fq * 8), boff = lds_byte(wc * 32 + fr, fq * 8);
#define PG8_SA(b, h) (((b) * 2 + (h)) * HTB)
#define PG8_SB(b, h) ((4 + (b) * 2 + (h)) * HTB)
#define PG8_STAGE(bufoff, goff, voff) do { _Pragma("unroll") for (int _i = 0; _i < 2; ++_i) \
        __builtin_amdgcn_raw_ptr_buffer_load_lds(rsB, (LAS unsigned*)(lds + (bufoff) + ldsw + _i * 8192), 16, (voff)[_i], (goff), 0, 0); } while (0)
#define PG8_STAGE_A(bufoff, goff, NX, h) do { _Pragma("unroll") for (int _i = 0; _i < 2; ++_i) \
        __builtin_amdgcn_raw_ptr_buffer_load_lds(rsA, (LAS unsigned*)(lds + (bufoff) + ldsw + _i * 8192), 16, GATHER ? ((NX) ? vaN[h][_i] : va[h][_i]) : voffA[_i], (goff), 0, 0); } while (0)
#define PG8_GOFFS(dst, u) do { int gR0_, gC_; stage_rc((wid * 64 + lane_id_asm()) * 16, gR0_, gC_);     \
        _Pragma("unroll") for (int _h = 0; _h < 2; ++_h) _Pragma("unroll") for (int _i = 0; _i < 2; ++_i) dst[_h][_i] = S.row_off(u, _h * HALF + gR0_ + 64 * _i) + (unsigned)(gC_ * 2); } while (0)
#define PG8_LD32(base) ({ typedef int v4i_t __attribute__((ext_vector_type(4))); const v4i_t lo_ = *(const LAS v4i_t*)(base), hi_ = *(const LAS v4i_t*)((base) + 1024); __builtin_shufflevector(lo_, hi_, 0, 1, 2, 3, 4, 5, 6, 7); })
#define PG8_LDA(dst, b, h) do { if constexpr (FP8) { _Pragma("unroll") for (int m = 0; m < 4; ++m) A8[m] = PG8_LD32(lds + PG8_SA(b, h) + aoff + m * 2048); } \
        else { _Pragma("unroll") for (int m = 0; m < 4; ++m) _Pragma("unroll") for (int k = 0; k < 2; ++k) dst[m][k] = *(const LAS bf16x8*)(lds + PG8_SA(b, h) + aoff + m * 2048 + k * 1024); } } while (0)
#define PG8_LDB(dst, b, h) do { if constexpr (FP8) { _Pragma("unroll") for (int n = 0; n < 2; ++n) dst##8[n] = PG8_LD32(lds + PG8_SB(b, h) + boff + n * 2048); } \
        else { _Pragma("unroll") for (int n = 0; n < 2; ++n) _Pragma("unroll") for (int k = 0; k < 2; ++k) dst[n][k] = *(const LAS bf16x8*)(lds + PG8_SB(b, h) + boff + n * 2048 + k * 1024); } } while (0)
#define PG8_MMA(ai, bj, At, Bt) do { __builtin_amdgcn_s_setprio(1); _Pragma("unroll") for (int m = 0; m < 4; ++m) _Pragma("unroll") for (int n = 0; n < 2; ++n) { \
        if constexpr (FP8) acc[ai][bj][m][n] = __builtin_amdgcn_mfma_scale_f32_16x16x128_f8f6f4(Bt##8[n], A8[m], acc[ai][bj][m][n], 0, 0, 0, 0, 0, 0); \
        else if constexpr (I8) { _Pragma("unroll") for (int k = 0; k < 2; ++k) acc[ai][bj][m][n] = __builtin_bit_cast(f32x4, __builtin_amdgcn_mfma_i32_16x16x64_i8(__builtin_bit_cast(i32x4_t, Bt[n][k]), __builtin_bit_cast(i32x4_t, At[m][k]), __builtin_bit_cast(i32x4_t, acc[ai][bj][m][n]), 0, 0, 0)); } \
        else { _Pragma("unroll") for (int k = 0; k < 2; ++k) acc[ai][bj][m][n] = __builtin_amdgcn_mfma_f32_16x16x32_bf16(Bt[n][k], At[m][k], acc[ai][bj][m][n], 0, 0, 0); } } \
        __builtin_amdgcn_s_setprio(0); } while (0)
#define PG8_WAIT_V(n) asm volatile("s_waitcnt vmcnt(" #n ")" ::: "memory")
#define PG8_WAIT_L(n) asm volatile("s_waitcnt lgkmcnt(" #n ")" ::: "memory")
#define PG8_BAR __builtin_amdgcn_s_barrier()
#define PG8_SCHED __builtin_amdgcn_sched_barrier(0)
    Unit cur, nxt; int ui = 0;
    if (!S.next(0, cur)) return;
    f32x4 acc[2][2][4][2];
#pragma unroll
    for (int a = 0; a < 2; ++a)
#pragma unroll
        for (int b = 0; b < 2; ++b)
#pragma unroll
            for (int m = 0; m < 4; ++m)
#pragma unroll
                for (int n = 0; n < 2; ++n) acc[a][b][m][n] = (f32x4){0.f, 0.f, 0.f, 0.f};
    typedef int v8i_t __attribute__((ext_vector_type(8)));
    bf16x8 At[FP8 ? 1 : 4][2], B0[2][FP8 ? 1 : 2], B1[2][FP8 ? 1 : 2];
    v8i_t A8[FP8 ? 4 : 1], B08[FP8 ? 2 : 1], B18[FP8 ? 2 : 1];
    unsigned cA = (unsigned)cur.aoff + (unsigned)cur.pm * tstepA, cB = (unsigned)cur.boff + (unsigned)cur.pn * tstepB;
    S.a_ready(cur);
    if constexpr (GATHER) PG8_GOFFS(va, cur);
    PG8_STAGE(PG8_SB(0, 0), cB, voffB); PG8_STAGE(PG8_SB(0, 1), cB + hstepB, voffB); PG8_STAGE_A(PG8_SA(0, 0), cA, false, 0); PG8_STAGE_A(PG8_SA(0, 1), cA + hstepA, false, 1);
    if (wr == 1) PG8_BAR;
    PG8_WAIT_V(2); PG8_BAR;
    PG8_STAGE(PG8_SB(1, 0), cB + kstep, voffB); PG8_STAGE_A(PG8_SA(1, 0), cA + kstep, false, 0); PG8_STAGE(PG8_SB(1, 1), cB + hstepB + kstep, voffB);
    PG8_WAIT_V(6); PG8_BAR;
    for (;;) {
        const bool has_next = S.next(ui + 1, nxt);
        if constexpr (GATHER) { if (has_next) PG8_GOFFS(vaN, nxt); else { _Pragma("unroll") for (int _h = 0; _h < 2; ++_h) _Pragma("unroll") for (int _i = 0; _i < 2; ++_i) vaN[_h][_i] = va[_h][_i]; } }
        const unsigned nA = has_next ? (unsigned)nxt.aoff + (unsigned)nxt.pm * tstepA : cA, nB = has_next ? (unsigned)nxt.boff + (unsigned)nxt.pn * tstepB : cB;
#pragma unroll 1
        for (int t = 0; t < nt; t += 2) {
            const bool last = (t == nt - 2);
            const unsigned a1 = cA + (unsigned)(t + 1) * kstep;
            const unsigned a2 = last ? nA : cA + (unsigned)(t + 2) * kstep, b2 = last ? nB : cB + (unsigned)(t + 2) * kstep;
            const unsigned a3 = a2 + kstep, b3 = b2 + kstep;
            if (last && has_next) S.a_ready(nxt);
            PG8_LDB(B0, 0, 0); PG8_LDB(B1, 0, 1); PG8_SCHED; PG8_LDA(At, 0, 0); PG8_STAGE_A(PG8_SA(1, 1), a1 + hstepA, false, 1);
            PG8_WAIT_V(8); PG8_WAIT_L(0); PG8_BAR; PG8_MMA(0, 0, At, B0); PG8_MMA(0, 1, At, B1); PG8_BAR; PG8_SCHED;
            PG8_LDA(At, 0, 1); PG8_STAGE(PG8_SB(0, 0), b2, voffB); PG8_STAGE(PG8_SB(0, 1), b2 + hstepB, voffB); PG8_STAGE_A(PG8_SA(0, 0), a2, last, 0);
            PG8_WAIT_V(8); PG8_WAIT_L(0); PG8_BAR; PG8_MMA(1, 0, At, B0); PG8_MMA(1, 1, At, B1); PG8_BAR; PG8_SCHED;
            PG8_LDB(B0, 1, 0); PG8_LDB(B1, 1, 1); PG8_SCHED; PG8_LDA(At, 1, 0); PG8_STAGE_A(PG8_SA(0, 1), a2 + hstepA, last, 1);
            PG8_WAIT_V(8); PG8_WAIT_L(0); PG8_BAR; PG8_MMA(0, 0, At, B0); PG8_MMA(0, 1, At, B1); PG8_BAR; PG8_SCHED;
            PG8_LDA(At, 1, 1); PG8_STAGE(PG8_SB(1, 0), b3, voffB); PG8_STAGE(PG8_SB(1, 1), b3 + hstepB, voffB); PG8_STAGE_A(PG8_SA(1, 0), a3, last, 0);
            PG8_WAIT_V(8); PG8_WAIT_L(0); PG8_BAR; PG8_MMA(1, 0, At, B0); PG8_MMA(1, 1, At, B1); PG8_BAR; PG8_SCHED;
        }
        if constexpr (ALIGN_EPI) { if (wr == 0) PG8_BAR; }
        if constexpr (I8) { const int l2 = lane_id_asm();
            const float* sAp = g.sA + cur.pm * BM + wr * 64 + (l2 & 15); const float* sBp = g.sB + cur.pn * BM + wc * 32 + 8 * (l2 >> 4);
            float rs[2][4]; f32x4 cs[2][2];
#pragma unroll
            for (int ai = 0; ai < 2; ++ai)
#pragma unroll
                for (int m = 0; m < 4; ++m) rs[ai][m] = sAp[ai * HALF + m * 16];
#pragma unroll
            for (int bj = 0; bj < 2; ++bj)
#pragma unroll
                for (int n = 0; n < 2; ++n) cs[bj][n] = *(const f32x4*)(sBp + bj * HALF + 4 * n);
#pragma unroll
            for (int bj = 0; bj < 2; ++bj)
#pragma unroll
                for (int n = 0; n < 2; ++n) cs[bj][n] = cs[bj][n] * (1.f / 127.f);
#pragma unroll
            for (int ai = 0; ai < 2; ++ai)
#pragma unroll
                for (int m = 0; m < 4; ++m)
#pragma unroll
                    for (int bj = 0; bj < 2; ++bj)
#pragma unroll
                        for (int n = 0; n < 2; ++n) { const i32x4_t iv = __builtin_bit_cast(i32x4_t, acc[ai][bj][m][n]);
                            acc[ai][bj][m][n] = (f32x4){(float)iv[0], (float)iv[1], (float)iv[2], (float)iv[3]} * (cs[bj][n] * rs[ai][m]); }
        }
        { const int l2 = lane_id_asm();
          if constexpr (Epi::TWOSEG) { if (cur.kind == 0) E.mid(acc, cur, wr, wc, l2 & 15, l2 >> 4); else E(acc, cur, wr, wc, l2 & 15, l2 >> 4); }
          else E(acc, cur, wr, wc, l2 & 15, l2 >> 4); } S.done(cur);
        if (!has_next) break;
        if (!(Epi::TWOSEG && cur.kind == 0))
#pragma unroll
        for (int a = 0; a < 2; ++a)
#pragma unroll
            for (int b = 0; b < 2; ++b)
#pragma unroll
                for (int m = 0; m < 4; ++m)
#pragma unroll
                    for (int n = 0; n < 2; ++n) acc[a][b][m][n] = (f32x4){0.f, 0.f, 0.f, 0.f};
        cur = nxt; cA = nA; cB = nB; ++ui;
        if constexpr (GATHER) { _Pragma("unroll") for (int _h = 0; _h < 2; ++_h) _Pragma("unroll") for (int _i = 0; _i < 2; ++_i) va[_h][_i] = vaN[_h][_i]; }
        if constexpr (ALIGN_EPI) { if (wr == 1) PG8_BAR; }
    }
    PG8_WAIT_V(0);
    if constexpr (!ALIGN_EPI) { if (wr == 0) PG8_BAR; }
    PG8_BAR;
    if constexpr (Epi::AFTER_DRAIN) { const int l2 = lane_id_asm(); E.after(acc, cur, wr, wc, l2 & 15, l2 >> 4, lds, wid * 64 + l2); }
#undef PG8_SA
#undef PG8_SB
#undef PG8_STAGE
#undef PG8_STAGE_A
#undef PG8_GOFFS
#undef PG8_LD32
#undef PG8_LDA
#undef PG8_LDB
#undef PG8_MMA
#undef PG8_WAIT_V
#undef PG8_WAIT_L
#undef PG8_BAR
#undef PG8_SCHED
}
}
#define XB_TMO      128
#define XB_XCNT(j)  (256  + 64 * (j))
#define XB_XSUB(j)  (1280 + 64 * (j))
#define XB_XGEN(j)  (2304 + 64 * (j))
#define XB_TOP      3328
#define XB_TOPGEN   3392
#define XCD_BAR_WORDS 3456
#define XB_SPIN_CAP (1u << 18)

__device__ __forceinline__ unsigned xb_ld(unsigned* p)              { return __hip_atomic_load(p, __ATOMIC_RELAXED, __HIP_MEMORY_SCOPE_AGENT); }
__device__ __forceinline__ unsigned xb_add(unsigned* p, unsigned v) { return __hip_atomic_fetch_add(p, v, __ATOMIC_RELAXED, __HIP_MEMORY_SCOPE_AGENT); }
__device__ __forceinline__ unsigned xb_xcc_id() { return (unsigned)__builtin_amdgcn_s_getreg((3 << 11) | 20) & 0xFu; }
#define XB_SPIN(cond, bar) do { unsigned _sp = 0; while (cond) { __builtin_amdgcn_s_sleep(1); \
    if ((++_sp & 255u) == 0u) { if (xb_ld(&(bar)[XB_TMO])) break; if (_sp > XB_SPIN_CAP) { atomicAdd(&(bar)[XB_TMO], 1u); break; } } } } while (0)

struct XcdBarrier {
    unsigned* bar; unsigned x; int wave;
    volatile LAS unsigned* st;
};

__device__ __forceinline__ XcdBarrier xcd_barrier_post(unsigned* bar, volatile LAS unsigned* st) {
    XcdBarrier b; b.bar = bar; b.x = xb_xcc_id(); b.st = st;
    if (threadIdx.x == 0) (void)xb_add(&bar[XB_XCNT(b.x)], 1u);
    return b;
}
__device__ __forceinline__ void xcd_barrier_complete(unsigned* bar, unsigned x, unsigned& nloc, unsigned& nx) {
    const unsigned G = gridDim.x * gridDim.y * gridDim.z;
    unsigned sum, cnt, mine, sp = 0u;
    for (;;) {
        sum = 0u; cnt = 0u; mine = 0u;
#pragma unroll
        for (unsigned j = 0; j < 16; ++j) { const unsigned c = xb_ld(&bar[XB_XCNT(j)]); sum += c; cnt += (c > 0u) ? 1u : 0u; mine = (j == x) ? c : mine; }
        if (sum == G) break;
        __builtin_amdgcn_s_sleep(1);
        if ((++sp & 255u) == 0u) { if (xb_ld(&bar[XB_TMO])) break; if (sp > XB_SPIN_CAP) { atomicAdd(&bar[XB_TMO], 1u); break; } }
    }
    nloc = mine > 0u ? mine : 1u; nx = cnt > 0u ? cnt : 1u;
}

__device__ __noinline__ void xcd_barrier(const XcdBarrier b) {
    asm volatile("s_waitcnt vmcnt(0)" ::: "memory");
    __syncthreads();
    if (b.wave == 0 && lane_id_asm() == 0) {
        unsigned* bar = b.bar;
        __builtin_amdgcn_s_waitcnt(0);
        unsigned nloc = b.st[0], nx = b.st[1];
        if (nloc == 0u) { xcd_barrier_complete(bar, b.x, nloc, nx); b.st[0] = nloc; b.st[1] = nx; }
        const unsigned old = xb_add(&bar[XB_XSUB(b.x)], 1u);
        const unsigned gen = old / nloc;
        if (old + 1u == (gen + 1u) * nloc) {
            __builtin_amdgcn_fence(__ATOMIC_RELEASE, "agent");
            asm volatile("s_waitcnt vmcnt(0)" ::: "memory");
            const unsigned og = xb_add(&bar[XB_TOP], 1u);
            const unsigned tg = og / nx;
            if (og + 1u == (tg + 1u) * nx) xb_add(&bar[XB_TOPGEN], 1u);
            else XB_SPIN(xb_ld(&bar[XB_TOPGEN]) == tg, bar);
            __builtin_amdgcn_fence(__ATOMIC_ACQUIRE, "agent");
            xb_add(&bar[XB_XGEN(b.x)], 1u);
            asm volatile("s_waitcnt vmcnt(0)" ::: "memory");
        } else {
            XB_SPIN(xb_ld(&bar[XB_XGEN(b.x)]) == gen, bar);
            __builtin_amdgcn_fence(__ATOMIC_ACQUIRE, "agent");
            asm volatile("s_waitcnt vmcnt(0)" ::: "memory");
        }
    }
    __syncthreads();
}
namespace att {
constexpr float ATT_THR = 8.f;
constexpr int KROW = 208;
constexpr int KBUF = 64 * KROW;
constexpr int VBUF = 8192;
constexpr int BUF = KBUF + VBUF;
constexpr int WSF_OFF = 3 * BUF;
constexpr int LDS_NEED = WSF_OFF + 8 * 256;
typedef short v4i16_t __attribute__((ext_vector_type(4)));
DI s16x4 vtr(const LAS unsigned char* p) { return __builtin_bit_cast(s16x4, __builtin_amdgcn_ds_read_tr16_b64_v4i16((LAS v4i16_t*)p)); }
DI float xor32_max(float v) { const auto rr = __builtin_amdgcn_permlane32_swap(__float_as_uint(v), __float_as_uint(v), false, false); return fmaxf(__uint_as_float(rr[0]), __uint_as_float(rr[1])); }
DI bf16x8 pack_p(const f32x16& x, int s) {
    u32x4 p;
    p.x = pg8::cvt_pk_bf16(x[8 * s + 0], x[8 * s + 1]); p.y = pg8::cvt_pk_bf16(x[8 * s + 2], x[8 * s + 3]);
    p.z = pg8::cvt_pk_bf16(x[8 * s + 4], x[8 * s + 5]); p.w = pg8::cvt_pk_bf16(x[8 * s + 6], x[8 * s + 7]);
    return __builtin_bit_cast(bf16x8, p);
}

DI void qk_tile(f32x16& s0, f32x16& s1, const LAS unsigned char* buf, int koff, const bf16x8 (&qf)[6], const f32x16& negv) {
    s0 = negv; s1 = negv;
    __builtin_amdgcn_s_setprio(1);
#pragma unroll
    for (int ks = 0; ks < 6; ++ks) {
        const bf16x8 a0 = *(const LAS bf16x8*)(buf + koff + ks * 32);
        const bf16x8 a1 = *(const LAS bf16x8*)(buf + koff + 32 * KROW + ks * 32);
        s0 = __builtin_amdgcn_mfma_f32_32x32x16_bf16(a0, qf[ks], s0, 0, 0, 0);
        s1 = __builtin_amdgcn_mfma_f32_32x32x16_bf16(a1, qf[ks], s1, 0, 0, 0);
    }
    __builtin_amdgcn_s_setprio(0);
}
DI void attn_unit(LAS unsigned char* lds, const bf16_t* Q, const bf16_t* K, const bf16_t* V, bf16_t* AO, int b, int h, int qb, int tid_, int wave, int lane_) {
    const int lane = lane_id_asm(), tid = wave * 64 + lane; (void)tid_; (void)lane_;
    const int r32 = lane & 31, hi = lane >> 5;
    const int NT = 4 * (qb + 1);
    const size_t rowbase = (size_t)b * SEQ;
    const int q0 = qb * 256 + wave * 32;
    const int cw = q0 >> 6;
    bf16x8 qf[6];
    { const bf16_t* qp = Q + (rowbase + q0 + r32) * 768 + h * 96 + hi * 8;
#pragma unroll
      for (int ks = 0; ks < 6; ++ks) qf[ks] = *(const bf16x8*)(qp + ks * 16); }
    f32x16 o0, o1;
#pragma unroll
    for (int r = 0; r < 16; ++r) { o0[r] = 0.f; o1[r] = 0.f; }
    float mref = 0.f, lrun = 0.f, pend = 0.f;
    f32x16 negv;
#pragma unroll
    for (int r = 0; r < 16; ++r) negv[r] = 0.f;
    const int vkey = tid >> 3, vc = tid & 7;
    const bf16_t* vsrc = V + (rowbase + vkey) * 512 + h * 64 + vc * 8;
    const int vdst = KBUF + (vc >> 2) * 4096 + vkey * 64 + (vc & 3) * 16;
    const int ka = tid / 12, kac = tid - ka * 12;
    const bf16_t* ksrc0 = K + (rowbase + ka) * 768 + h * 96 + kac * 8;
    const int kdst0 = ka * KROW + kac * 16;
    const int i1 = tid + 512, kb = i1 / 12, kbc = i1 - kb * 12;
    const bf16_t* ksrc1 = K + (rowbase + kb) * 768 + h * 96 + kbc * 8;
    const int kdst1 = kb * KROW + kbc * 16;
    const bool has1 = tid < 256;
    u32x4 rk0, rk1 = (u32x4){0u, 0u, 0u, 0u}, rv;
#pragma unroll
    for (int t0 = 0; t0 < 2; ++t0) {
        const size_t adv = (size_t)t0 * 64;
        rk0 = *(const u32x4*)(ksrc0 + adv * 768); if (has1) rk1 = *(const u32x4*)(ksrc1 + adv * 768); rv = *(const u32x4*)(vsrc + adv * 512);
        LAS unsigned char* d = lds + t0 * BUF;
        *(LAS u32x4*)(d + kdst0) = rk0; if (has1) *(LAS u32x4*)(d + kdst1) = rk1; *(LAS u32x4*)(d + vdst) = rv;
    }
    { const size_t adv = (size_t)2 * 64; rk0 = *(const u32x4*)(ksrc0 + adv * 768); if (has1) rk1 = *(const u32x4*)(ksrc1 + adv * 768); rv = *(const u32x4*)(vsrc + adv * 512); }
    lds_barrier();
    LAS float* wsf = (LAS float*)(lds + WSF_OFF + wave * 256);
    const int koff = r32 * KROW + hi * 16;
    const int voff = KBUF + (((lane >> 4) & 1) * 16 + (lane & 3) * 4) * 2 + (4 * hi + ((lane & 15) >> 2)) * 64;
    f32x16 sa0, sa1, sb0, sb1;
    qk_tile(sa0, sa1, lds, koff, qf, negv);
    int scur = 0, snxt = BUF, sfree = 2 * BUF;
#define ATT_STEP(SA0, SA1, SB0, SB1) do { \
        if (t + 2 < NT) { LAS unsigned char* d = lds + sfree; *(LAS u32x4*)(d + kdst0) = rk0; if (has1) *(LAS u32x4*)(d + kdst1) = rk1; *(LAS u32x4*)(d + vdst) = rv; }     \
        if (t + 3 < NT) { const size_t adv = (size_t)(t + 3) * 64; rk0 = *(const u32x4*)(ksrc0 + adv * 768); if (has1) rk1 = *(const u32x4*)(ksrc1 + adv * 768); rv = *(const u32x4*)(vsrc + adv * 512); } \
        const bool act = (t <= cw), actn = (t + 1 <= cw) && (t + 1 < NT); \
        if (actn) qk_tile(SB0, SB1, lds + snxt, koff, qf, negv);         \
        if (act) { \
            if (__any(pend != 0.f)) {                                        \
                _Pragma("unroll") for (int r = 0; r < 16; ++r) { SA0[r] -= pend; SA1[r] -= pend; } \
            } \
            float mx = SA0[0]; \
            _Pragma("unroll") for (int r = 0; r < 16; ++r) mx = __builtin_fmaxf(__builtin_fmaxf(mx, SA0[r]), SA1[r]); \
            mx = xor32_max(mx); \
            pend = 0.f; \
            if (t == 0 || __any(mx > ATT_THR)) {                             \
                const float dl = (t == 0) ? mx : __builtin_fmaxf(mx, 0.f); \
                mref += dl; pend = dl; \
                _Pragma("unroll") for (int r = 0; r < 16; ++r) { SA0[r] -= dl; SA1[r] -= dl; negv[r] = -mref; } \
                if (t != 0) {                                                   \
                    const float f = __builtin_amdgcn_exp2f(-dl); \
                    lrun *= f; \
                    if (hi == 0) wsf[r32] = f; \
                    LDS_WAIT(); \
                    _Pragma("unroll") for (int g = 0; g < 4; ++g) { const f32x4 fv = *(const LAS f32x4*)(wsf + 8 * g + 4 * hi); \
                        _Pragma("unroll") for (int j = 0; j < 4; ++j) { o0[4 * g + j] *= fv[j]; o1[4 * g + j] *= fv[j]; } } \
                } \
            } \
            float ps = 0.f; \
            _Pragma("unroll") for (int r = 0; r < 16; ++r) { SA0[r] = __builtin_amdgcn_exp2f(SA0[r]); SA1[r] = __builtin_amdgcn_exp2f(SA1[r]); ps += SA0[r] + SA1[r]; } \
            lrun += ps; \
            const LAS unsigned char* cur = lds + scur; \
            _Pragma("unroll") for (int s = 0; s < 4; ++s) { \
                const bf16x8 pa = pack_p((s < 2) ? SA0 : SA1, s & 1); \
                const LAS unsigned char* vp = cur + voff + s * 16 * 64; \
                const s16x4 l0 = vtr(vp), h0 = vtr(vp + 8 * 64), l1 = vtr(vp + 4096), h1 = vtr(vp + 4096 + 8 * 64); \
                const bf16x8 vb0 = (bf16x8){l0[0], l0[1], l0[2], l0[3], h0[0], h0[1], h0[2], h0[3]}; \
                const bf16x8 vb1 = (bf16x8){l1[0], l1[1], l1[2], l1[3], h1[0], h1[1], h1[2], h1[3]}; \
                o0 = __builtin_amdgcn_mfma_f32_32x32x16_bf16(pa, vb0, o0, 0, 0, 0); \
                o1 = __builtin_amdgcn_mfma_f32_32x32x16_bf16(pa, vb1, o1, 0, 0, 0); \
            } \
        } \
        lds_barrier(); \
        { const int tmp = scur; scur = snxt; snxt = sfree; sfree = tmp; } \
    } while (0)
#pragma unroll 1
    for (int t2 = 0; t2 < NT; t2 += 2) {
        { const int t = t2; ATT_STEP(sa0, sa1, sb0, sb1); }
        { const int t = t2 + 1; ATT_STEP(sb0, sb1, sa0, sa1); }
    }
#undef ATT_STEP
    lrun = xor32_sum(lrun);
    if (hi == 0) wsf[r32] = __builtin_amdgcn_rcpf(lrun);
    LDS_WAIT();
    LAS unsigned char* ot = lds + wave * 4608;
#pragma unroll
    for (int g = 0; g < 4; ++g) { const f32x4 fv = *(const LAS f32x4*)(wsf + 8 * g + 4 * hi);
#pragma unroll
        for (int j = 0; j < 4; ++j) { const int q = 8 * g + 4 * hi + j;
            *(LAS bf16_t*)(ot + q * 144 + r32 * 2) = (bf16_t)f2bf(o0[4 * g + j] * fv[j]); *(LAS bf16_t*)(ot + q * 144 + 64 + r32 * 2) = (bf16_t)f2bf(o1[4 * g + j] * fv[j]); } }
    LDS_WAIT(); asm volatile("" ::: "memory");
#pragma unroll
    for (int i = 0; i < 4; ++i) { const int pc = lane + 64 * i, row = pc >> 3, c8 = pc & 7;
        *(GAS u32x4*)(AO + (rowbase + q0 + row) * 512 + h * 64 + c8 * 8) = *(const LAS u32x4*)(ot + row * 144 + c8 * 16); }
    LDS_WAIT();
    __syncthreads();
}
}

DI void gdn_gate_rows(int gw, int NGW, int lane, const float* ORAW, const bf16_t* Zb, const float* out_norm, bf16_t* GO, int m0, int m1) {
    const int c0 = lane * 8, e0 = c0 & 127;
    const f32x4 n0 = *(const f32x4*)(out_norm + e0), n1 = *(const f32x4*)(out_norm + e0 + 4);
    f32x4 na = (f32x4){0.f, 0.f, 0.f, 0.f}, nb = na; u32x4 nz = (u32x4){0u, 0u, 0u, 0u};
    if (m0 + gw < m1) { const GAS f32x4* o4 = (const GAS f32x4*)(ORAW + (size_t)(m0 + gw) * 512 + c0); na = o4[0]; nb = o4[1]; nz = *(const GAS u32x4*)(Zb + (size_t)(m0 + gw) * Z_LD + c0); }
    for (int m = m0 + gw; m < m1; m += NGW) {
        f32x4 a = na, b = nb; u32x4 zz = nz;
        asm volatile("" : "+v"(a), "+v"(b), "+v"(zz));
        if (m + NGW < m1) { const GAS f32x4* o4 = (const GAS f32x4*)(ORAW + (size_t)(m + NGW) * 512 + c0); na = o4[0]; nb = o4[1]; nz = *(const GAS u32x4*)(Zb + (size_t)(m + NGW) * Z_LD + c0); }
        float ss = (a.x * a.x + a.y * a.y) + (a.z * a.z + a.w * a.w) + (b.x * b.x + b.y * b.y) + (b.z * b.z + b.w * b.w);
        ss = row16_sum(ss);
        const float r = rsqrtf(ss * (1.f / 128.f) + EPS);
        u32x4 o;
        o.x = pk2(a.x * r * n0.x * siluf(bflo(zz.x)), a.y * r * n0.y * siluf(bfhi(zz.x)));
        o.y = pk2(a.z * r * n0.z * siluf(bflo(zz.y)), a.w * r * n0.w * siluf(bfhi(zz.y)));
        o.z = pk2(b.x * r * n1.x * siluf(bflo(zz.z)), b.y * r * n1.y * siluf(bfhi(zz.z)));
        o.w = pk2(b.z * r * n1.z * siluf(bflo(zz.w)), b.w * r * n1.w * siluf(bfhi(zz.w)));
        *(GAS u32x4*)(GO + (size_t)m * 512 + c0) = o;
    }
}

DI void mla_prep_rows(int gw, int NGW, int lane, const bf16_t* MISC, float* rstdq, float* rstdkv) {
    unsigned nq[3] = {0u, 0u, 0u}, nk[2] = {0u, 0u};
#define MLA_ISSUE(mm) do { const bf16_t* pr_ = MISC + (size_t)(mm) * MISC_LD; \
        _Pragma("unroll") for (int i = 0; i < 3; ++i) nq[i] = *(const GAS unsigned*)(pr_ + MC_CQ + 2 * lane + 128 * i); \
        _Pragma("unroll") for (int i = 0; i < 2; ++i) nk[i] = *(const GAS unsigned*)(pr_ + MC_CKV + 2 * lane + 128 * i); } while (0)
    if (gw < M) MLA_ISSUE(gw);
    for (int m = gw; m < M; m += NGW) {
        unsigned q0 = nq[0], q1 = nq[1], q2 = nq[2], k0 = nk[0], k1 = nk[1];
        asm volatile("" : "+v"(q0), "+v"(q1), "+v"(q2), "+v"(k0), "+v"(k1));
        if (m + NGW < M) MLA_ISSUE(m + NGW);
        float ss = (bflo(q0) * bflo(q0) + bfhi(q0) * bfhi(q0)) + (bflo(q1) * bflo(q1) + bfhi(q1) * bfhi(q1)) + (bflo(q2) * bflo(q2) + bfhi(q2) * bfhi(q2));
        ss = wave_sum(ss);
        const float rq = rsqrtf(ss * (1.f / 384.f) + EPS);
        ss = (bflo(k0) * bflo(k0) + bfhi(k0) * bfhi(k0)) + (bflo(k1) * bflo(k1) + bfhi(k1) * bfhi(k1));
        ss = wave_sum(ss);
        const float rkv = rsqrtf(ss * (1.f / 256.f) + EPS);
        if (lane == 0) { rstdq[m] = rq; rstdkv[m] = rkv; }
    }
#undef MLA_ISSUE
}
DI void mla_kpe_rows(int gw, int NGW, int lane, const bf16_t* MISC, const float* COS, const float* SIN, bf16_t* Kb) {
    const int sub = lane >> 4, j = lane & 15;
    for (int m = 4 * gw + sub; m < M; m += 4 * NGW) {
        const bf16_t* pr = MISC + (size_t)m * MISC_LD;
        const float c = COS[(size_t)m * 16 + j], s = SIN[(size_t)m * 16 + j];
        const float t1 = bf2f(pr[MC_KR + j]), t2 = bf2f(pr[MC_KR + 16 + j]);
        const bf16_t o1 = (bf16_t)f2bf(t1 * c - t2 * s), o2 = (bf16_t)f2bf(t2 * c + t1 * s);
#pragma unroll
        for (int h = 0; h < 8; ++h) { Kb[(size_t)m * 768 + h * 96 + 64 + j] = o1; Kb[(size_t)m * 768 + h * 96 + 80 + j] = o2; }
    }
}

namespace gdn {
constexpr int ROWB = 272;
constexpr int GV = 0, LS = 1024, PART = 18432, QS = 26624, KS = 44032, VS = 61440;
constexpr int LDS_NEED = VS + 17408;


constexpr int T_GV = 0, T_LS = 1024, T_PART = 1024  , T_QS = 18432, T_KS = 35840, T_VS = 53248, TEAM_LDS = 70656;
DI void conv8(float (&y)[8][8], float (&ps)[8], const bf16_t* QKV, const float* conv_w, size_t m0, int c, int ch, int rg) {
    f32x4 cw[4][2];
#pragma unroll
    for (int j = 0; j < 4; ++j) { cw[j][0] = *(const f32x4*)(conv_w + j * 1536 + ch); cw[j][1] = *(const f32x4*)(conv_w + j * 1536 + ch + 4); }
    u32x4 xw[11];
#pragma unroll
    for (int i = 0; i < 11; ++i) {
        const int row = 8 * rg - 3 + i;
        xw[i] = (u32x4){0u, 0u, 0u, 0u};
        if (row >= 0 || c > 0) xw[i] = *(const GAS u32x4*)((const GAS char*)(QKV + (m0 - 3) * QKV_LD) + (unsigned)(((row + 3) * QKV_LD + ch) * 2));
    }
#pragma unroll
    for (int r = 0; r < 8; ++r) {
        float p = 0.f;
#pragma unroll
        for (int i = 0; i < 8; ++i) {
            float a = 0.f;
#pragma unroll
            for (int j = 0; j < 4; ++j) { const unsigned w = xw[r + j][i >> 1]; a += cw[j][i >> 2][i & 3] * ((i & 1) ? bfhi(w) : bflo(w)); }
            a = siluf(a); y[r][i] = a; p += a * a;
        }
        ps[r] = p;
    }
}
DI void local_pair(LAS unsigned char* lds_, const bf16_t* QKV, const bf16_t* MISC, const float* conv_w, const float* a_log, const float* dt_bias,
                   bf16_t* UT, bf16_t* Wb, bf16_t* QD, bf16_t* KDT, bf16_t* AT, float* CD, int up, int wave8) {
    const int lane = lane_id_asm();
    const int team = wave8 >> 2, w4 = wave8 & 3, un = 2 * up + team;
    LAS unsigned char* lds = lds_ + team * TEAM_LDS;
    const int bh = un >> 5, c = un & 31, b = bh >> 2, h = bh & 3;
    const size_t m0 = (size_t)b * SEQ + (size_t)c * 64;
    unsigned vz = 0u; asm volatile("" : "+v"(vz));
    LAS unsigned char* ldv = lds + vz;
    LAS float* Gs = (LAS float*)(ldv + T_GV); LAS float* Bs = Gs + 64; LAS float* EGs = Gs + 128; LAS float* ELs = Gs + 192;
    const int cg = lane & 15, rg = 4 * (w4 & 1) + (lane >> 4);
    if (w4 < 2) {
        float y[8][8], ps[8];
        conv8(y, ps, QKV, conv_w, m0, c, 1024 + h * 128 + cg * 8, rg);
#pragma unroll
        for (int r = 0; r < 8; ++r) { u32x4 w; w.x = pk2(y[r][0], y[r][1]); w.y = pk2(y[r][2], y[r][3]); w.z = pk2(y[r][4], y[r][5]); w.w = pk2(y[r][6], y[r][7]);
            *(LAS u32x4*)(lds + T_VS + (8 * rg + r) * ROWB + cg * 16) = w; }
    } else if (w4 == 2) {
        const size_t m = m0 + lane;
        const float a = bf2f(MISC[m * MISC_LD + MC_A + h]) + dt_bias[h];
        const float ea = __expf(a);
        const float sp = a > 20.f ? a : (ea < 0.015625f ? ea * (1.f - ea * (0.5f - ea * (1.f / 3.f - 0.25f * ea))) : __logf(1.f + ea));
        const float g = -__expf(a_log[h]) * sp;
        Bs[lane] = sigmf(bf2f(MISC[m * MISC_LD + MC_B + h]));
        Gs[lane] = g;
        LDS_WAIT();
        float G = 0.f;
#pragma unroll
        for (int j4 = 0; j4 < 16; ++j4) { const f32x4 gv = *(const LAS f32x4*)(Gs + 4 * j4);
#pragma unroll
            for (int jj = 0; jj < 4; ++jj) G += (4 * j4 + jj <= lane) ? gv[jj] : 0.f; }
        const float GL = __int_as_float(__builtin_amdgcn_readlane(__float_as_int(G), 63));
        LDS_WAIT();
        Gs[lane] = G; EGs[lane] = __expf(G); ELs[lane] = __expf(GL - G);
        if (lane == 63) CD[un] = __expf(GL);
    }
    const int mat = w4 >> 1;
    float y[8][8];
    {
        float ps[8];
        conv8(y, ps, QKV, conv_w, m0, c, mat * 512 + h * 128 + cg * 8, rg);
#pragma unroll
        for (int r = 0; r < 8; ++r) ((LAS float*)(lds + T_PART))[(mat * 64 + 8 * rg + r) * 16 + cg] = ps[r];
    }
    lds_barrier();
    {
        LAS unsigned char* tile = lds + (mat == 0 ? T_QS : T_KS);
#pragma unroll
        for (int r = 0; r < 8; ++r) {
            const LAS f32x4* pp = (const LAS f32x4*)(ldv + T_PART) + (mat * 64 + 8 * rg + r) * 4;
            const f32x4 p0 = pp[0], p1 = pp[1], p2 = pp[2], p3 = pp[3];
            const float ss = ((p0.x + p0.y) + (p0.z + p0.w)) + ((p1.x + p1.y) + (p1.z + p1.w)) + ((p2.x + p2.y) + (p2.z + p2.w)) + ((p3.x + p3.y) + (p3.z + p3.w));
            const float rn = rsqrtf(ss + EPS) * (mat == 0 ? 0.08838834764831845f : 1.f);
            const int row = 8 * rg + r;
            u32x4 w; w.x = pk2(y[r][0] * rn, y[r][1] * rn); w.y = pk2(y[r][2] * rn, y[r][3] * rn); w.z = pk2(y[r][4] * rn, y[r][5] * rn); w.w = pk2(y[r][6] * rn, y[r][7] * rn);
            *(LAS u32x4*)(tile + row * ROWB + cg * 16) = w;
            if (mat == 0) {
                const float eg = EGs[row];
                u32x4 d; d.x = pk2(bflo(w.x) * eg, bfhi(w.x) * eg); d.y = pk2(bflo(w.y) * eg, bfhi(w.y) * eg); d.z = pk2(bflo(w.z) * eg, bfhi(w.z) * eg); d.w = pk2(bflo(w.w) * eg, bfhi(w.w) * eg);
                *(GAS u32x4*)(QD + (((size_t)un * 16 + (row >> 4) * 4 + (cg >> 2)) * 64 + (row & 15) + 16 * (cg & 3)) * 8) = d;
            }
        }
    }
    lds_barrier();
    {
        const int r32 = lane & 31, hi = lane >> 5, bi = w4 >> 1, bj = w4 & 1;
        const int j = 32 * bj + r32; const float Gj = Gs[j];
#pragma unroll
        for (int pass = 0; pass < 2; ++pass) {
            const bool qk = pass == 1;
            f32x16 acc;
#pragma unroll
            for (int r = 0; r < 16; ++r) acc[r] = 0.f;
            if (w4 != 1) {
                const LAS unsigned char* At = lds + (qk ? T_QS : T_KS) + (32 * bi + r32) * ROWB + hi * 16;
                const LAS unsigned char* Bt = lds + T_KS + (32 * bj + r32) * ROWB + hi * 16;
#pragma unroll
                for (int ks = 0; ks < 8; ++ks) acc = __builtin_amdgcn_mfma_f32_32x32x16_bf16(*(const LAS bf16x8*)(At + ks * 32), *(const LAS bf16x8*)(Bt + ks * 32), acc, 0, 0, 0);
            }
#pragma unroll
            for (int g4 = 0; g4 < 4; ++g4) {
                const int ib = 32 * bi + 8 * g4 + 4 * hi;
                const f32x4 Gi = *(const LAS f32x4*)(Gs + ib), Bi = *(const LAS f32x4*)(Bs + ib);
#pragma unroll
                for (int jj = 0; jj < 4; ++jj) {
                    const int i = ib + jj; const float d = __expf(Gi[jj] - Gj); const float cv = acc[4 * g4 + jj];
                    if (!qk) ((LAS float*)(lds + T_LS))[i * 68 + j] = (i > j) ? Bi[jj] * cv * d : 0.f;
                    else AT[(((size_t)un * 8 + (i >> 4) * 2 + (j >> 5)) * 64 + (i & 15) + 16 * ((j & 31) >> 3)) * 8 + (j & 7)] = (bf16_t)f2bf((i >= j) ? cv * d : 0.f);
                }
            }
        }
    }
    lds_barrier();
    {
        const int col = 64 * w4 + lane;
        const bool isk = w4 >= 2;
        const LAS unsigned char* src = lds + (isk ? T_KS : T_VS) + (col & 127) * 2;
        f32x2 sol[32];
#pragma unroll
        for (int t = 0; t < 32; ++t) { sol[t].x = bf2f(*(const LAS bf16_t*)(src + (2 * t) * ROWB)); sol[t].y = bf2f(*(const LAS bf16_t*)(src + (2 * t + 1) * ROWB)); }
        if (isk) {
            const int dkk = col & 127;
#pragma unroll
            for (int t8 = 0; t8 < 8; ++t8) { const f32x4 e0 = *(const LAS f32x4*)(ELs + 8 * t8), e1 = *(const LAS f32x4*)(ELs + 8 * t8 + 4);
                u32x4 w; w.x = pk2(sol[4 * t8].x * e0.x, sol[4 * t8].y * e0.y); w.y = pk2(sol[4 * t8 + 1].x * e0.z, sol[4 * t8 + 1].y * e0.w);
                w.z = pk2(sol[4 * t8 + 2].x * e1.x, sol[4 * t8 + 2].y * e1.y); w.w = pk2(sol[4 * t8 + 3].x * e1.z, sol[4 * t8 + 3].y * e1.w);
                *(GAS u32x4*)(KDT + (((size_t)un * 16 + (dkk >> 4) * 2 + (t8 >> 2)) * 64 + (dkk & 15) + 16 * (t8 & 3)) * 8) = w; }
        }
#pragma unroll
        for (int t4 = 0; t4 < 16; ++t4) { const f32x4 bb = *(const LAS f32x4*)(Bs + 4 * t4); f32x4 ee = (f32x4){1.f, 1.f, 1.f, 1.f}; if (isk) ee = *(const LAS f32x4*)(EGs + 4 * t4);
            sol[2 * t4].x *= bb[0] * ee[0]; sol[2 * t4].y *= bb[1] * ee[1]; sol[2 * t4 + 1].x *= bb[2] * ee[2]; sol[2 * t4 + 1].y *= bb[3] * ee[3]; }
        const LAS float* Lm = (const LAS float*)(ldv + T_LS);
        f32x4 La[8], Lb[8]; f32x2 acc = (f32x2){0.f, 0.f};
#define GL_INFO(sx) const int i_ = (sx) < 32 ? (sx) + 1 : 33 + (((sx) - 32) >> 1); const int tot_ = (i_ + 3) / 4; const int q0_ = ((sx) >= 32 && (((sx) - 32) & 1)) ? 8 : 0; const int nq_ = (sx) < 32 ? tot_ : ((((sx) - 32) & 1) ? tot_ - 8 : 8)
#define GL_LOAD(buf, sx) do { GL_INFO(sx); _Pragma("unroll") for (int q_ = 0; q_ < nq_; ++q_) buf[q_] = *(const LAS f32x4*)(Lm + i_ * 68 + 4 * (q0_ + q_)); } while (0)
#define GL_APPLY(buf, sx) do { GL_INFO(sx); if (q0_ == 0) acc = (f32x2){(i_ & 1) ? sol[i_ >> 1].y : sol[i_ >> 1].x, 0.f}; \
            _Pragma("unroll") for (int q_ = 0; q_ < nq_; ++q_) { acc = acc - (f32x2){buf[q_].x, buf[q_].y} * sol[2 * (q0_ + q_)]; acc = acc - (f32x2){buf[q_].z, buf[q_].w} * sol[2 * (q0_ + q_) + 1]; } \
            if (q0_ + nq_ == tot_) { if (i_ & 1) sol[i_ >> 1].y = acc.x + acc.y; else sol[i_ >> 1].x = acc.x + acc.y; } } while (0)
        GL_LOAD(La, 0);
#pragma unroll
        for (int sx = 0; sx < 94; sx += 2) {
            GL_LOAD(Lb, sx + 1);
            __builtin_amdgcn_sched_barrier(0);
            GL_APPLY(La, sx);
            if (sx + 2 < 94) GL_LOAD(La, sx + 2);
            __builtin_amdgcn_sched_barrier(0);
            GL_APPLY(Lb, sx + 1);
        }
#undef GL_INFO
#undef GL_LOAD
#undef GL_APPLY
        if (!isk) {
            GAS u32x4* upp = (GAS u32x4*)(UT + ((size_t)un * 128 + col) * 64);
#pragma unroll
            for (int t8 = 0; t8 < 8; ++t8) { u32x4 w; w.x = pk2(sol[4 * t8].x, sol[4 * t8].y); w.y = pk2(sol[4 * t8 + 1].x, sol[4 * t8 + 1].y); w.z = pk2(sol[4 * t8 + 2].x, sol[4 * t8 + 2].y); w.w = pk2(sol[4 * t8 + 3].x, sol[4 * t8 + 3].y); upp[t8] = w; }
        } else {
            const int dk = col & 127;
#pragma unroll
            for (int t = 0; t < 64; ++t) *(LAS bf16_t*)(lds + T_QS + t * ROWB + dk * 2) = (bf16_t)f2bf((t & 1) ? sol[t >> 1].y : sol[t >> 1].x);
        }
    }
    lds_barrier();
    {
        const int q = w4 * 64 + lane;
#pragma unroll
        for (int i = 0; i < 4; ++i) { const int pc = q + 256 * i, t = pc >> 4, d8 = pc & 15;
            const u32x4 w = *(const LAS u32x4*)(lds + T_QS + t * ROWB + d8 * 16);
            *(GAS u32x4*)(Wb + (((size_t)un * 16 + (t >> 4) * 4 + (d8 >> 2)) * 64 + (t & 15) + 16 * (d8 & 3)) * 8) = w; }
    }
    lds_barrier();
}

constexpr int ST_OFF = 0, ST_ROWB = 272, VN_OFF = 4352, VN_ROWB = 144, SCAN_LDS = VN_OFF + 16 * VN_ROWB;
struct Frag { bf16x8 w[4], qd[4], at[2], kd[2][2]; u32x2 u; float cd; };
struct ScanRs { __amdgpu_buffer_rsrc_t w, qd, kdt, at, ut; const float* CD; };
DI ScanRs scan_rs(const bf16_t* UT, const bf16_t* Wb, const bf16_t* QD, const bf16_t* KDT, const bf16_t* AT, const float* CD) {
    ScanRs r; r.w = __builtin_amdgcn_make_buffer_rsrc((void*)Wb, 0, 0x7ffff000, 0x00020000); r.qd = __builtin_amdgcn_make_buffer_rsrc((void*)QD, 0, 0x7ffff000, 0x00020000);
    r.kdt = __builtin_amdgcn_make_buffer_rsrc((void*)KDT, 0, 0x7ffff000, 0x00020000); r.at = __builtin_amdgcn_make_buffer_rsrc((void*)AT, 0, 0x7ffff000, 0x00020000);
    r.ut = __builtin_amdgcn_make_buffer_rsrc((void*)UT, 0, 0x7ffff000, 0x00020000); r.CD = CD; return r;
}
DI bf16x8 ld128(__amdgpu_buffer_rsrc_t rs, unsigned voff, unsigned soff) { return __builtin_bit_cast(bf16x8, __builtin_amdgcn_raw_buffer_load_b128(rs, voff, soff, 0)); }
DI void load_frag(Frag& f, const ScanRs& R, int un, int sl, int wave, unsigned vl16, unsigned vut) {
    const unsigned sw = (unsigned)((un * 16 + wave * 4) * 1024);
#pragma unroll
    for (int ks = 0; ks < 4; ++ks) { f.w[ks] = ld128(R.w, vl16, sw + ks * 1024); f.qd[ks] = ld128(R.qd, vl16, sw + ks * 1024); }
    const unsigned sa = (unsigned)((un * 8 + wave * 2) * 1024);
#pragma unroll
    for (int ks = 0; ks < 2; ++ks) f.at[ks] = ld128(R.at, vl16, sa + ks * 1024);
#pragma unroll
    for (int rb = 0; rb < 2; ++rb) { const unsigned sk = (unsigned)((un * 16 + (2 * wave + rb) * 2) * 1024);
#pragma unroll
        for (int ks = 0; ks < 2; ++ks) f.kd[rb][ks] = ld128(R.kdt, vl16, sk + ks * 1024); }
    f.u = __builtin_bit_cast(u32x2, __builtin_amdgcn_raw_buffer_load_b64(R.ut, vut, (unsigned)(((un * 128 + 16 * sl) * 64 + 16 * wave) * 2), 0));
    f.cd = R.CD[un];
}
DI void scan_step(LAS unsigned char* lds, const Frag& cur, f32x4& S0, f32x4& S1, __amdgpu_buffer_rsrc_t ro, unsigned vo, int n, int b, int h, int sl, int wave, int e, int kc) {
    f32x4 oq = (f32x4){0.f, 0.f, 0.f, 0.f};
    {
        f32x4 ws = (f32x4){0.f, 0.f, 0.f, 0.f};
#pragma unroll
        for (int ks = 0; ks < 4; ++ks) { const bf16x8 sb = *(const LAS bf16x8*)(lds + ST_OFF + e * ST_ROWB + (32 * ks + 8 * kc) * 2);
            ws = __builtin_amdgcn_mfma_f32_16x16x32_bf16(cur.w[ks], sb, ws, 0, 0, 0);
            oq = __builtin_amdgcn_mfma_f32_16x16x32_bf16(cur.qd[ks], sb, oq, 0, 0, 0); }
        const float v0 = bflo(cur.u.x) - ws[0], v1 = bfhi(cur.u.x) - ws[1], v2 = bflo(cur.u.y) - ws[2], v3 = bfhi(cur.u.y) - ws[3];
        u32x2 vw; vw.x = pk2(v0, v1); vw.y = pk2(v2, v3);
        *(LAS u32x2*)(lds + VN_OFF + e * VN_ROWB + (16 * wave + 4 * kc) * 2) = vw;
    }
    lds_barrier();
    {
        bf16x8 vb[2];
#pragma unroll
        for (int ks = 0; ks < 2; ++ks) vb[ks] = *(const LAS bf16x8*)(lds + VN_OFF + e * VN_ROWB + (32 * ks + 8 * kc) * 2);
#pragma unroll
        for (int ks = 0; ks < 2; ++ks) oq = __builtin_amdgcn_mfma_f32_16x16x32_bf16(cur.at[ks], vb[ks], oq, 0, 0, 0);
        const unsigned so = (unsigned)((((b * SEQ + 64 * n + 16 * wave) * 512) + h * 128 + 16 * sl) * 4);
#pragma unroll
        for (int i = 0; i < 4; ++i) __builtin_amdgcn_raw_buffer_store_b32(__float_as_uint(oq[i]), ro, vo + i * 2048, so, 0);
        S0 = S0 * cur.cd; S1 = S1 * cur.cd;
#pragma unroll
        for (int ks = 0; ks < 2; ++ks) { S0 = __builtin_amdgcn_mfma_f32_16x16x32_bf16(cur.kd[0][ks], vb[ks], S0, 0, 0, 0); S1 = __builtin_amdgcn_mfma_f32_16x16x32_bf16(cur.kd[1][ks], vb[ks], S1, 0, 0, 0); }
        u32x2 s0w, s1w; s0w.x = pk2(S0[0], S0[1]); s0w.y = pk2(S0[2], S0[3]); s1w.x = pk2(S1[0], S1[1]); s1w.y = pk2(S1[2], S1[3]);
        *(LAS u32x2*)(lds + ST_OFF + e * ST_ROWB + (32 * wave + 4 * kc) * 2) = s0w;
        *(LAS u32x2*)(lds + ST_OFF + e * ST_ROWB + (32 * wave + 16 + 4 * kc) * 2) = s1w;
    }
    lds_barrier();
}
DI void scan_unit(LAS unsigned char* lds, const bf16_t* UT, const bf16_t* Wb, const bf16_t* QD, const bf16_t* KDT, const bf16_t* AT, const float* CD, float* ORAW,
                  int bh, int sl, int tid, int wave, int lane) {
    static_assert(NCHUNK == 32, "the trip structure below is 10 x 3 + 2 steps");
    const int e = lane & 15, kc = lane >> 4, b = bh >> 2, h = bh & 3;
    for (int i = tid; i < SCAN_LDS / 4; i += 256) ((LAS unsigned*)lds)[i] = 0u;
    f32x4 S0 = (f32x4){0.f, 0.f, 0.f, 0.f}, S1 = S0;
    const ScanRs R = scan_rs(UT, Wb, QD, KDT, AT, CD);
    const __amdgpu_buffer_rsrc_t ro = __builtin_amdgcn_make_buffer_rsrc((void*)ORAW, 0, 0x7ffff000, 0x00020000);
    const unsigned vl16 = (unsigned)lane * 16u, vut = (unsigned)((e * 64 + 4 * kc) * 2), vo = (unsigned)((4 * kc * 512 + e) * 4);
    Frag f0, f1, f2;
    load_frag(f0, R, bh * 32, sl, wave, vl16, vut); load_frag(f1, R, bh * 32 + 1, sl, wave, vl16, vut);
    lds_barrier();
#pragma unroll 1
    for (int n = 0; n < 30; n += 3) {
        load_frag(f2, R, bh * 32 + n + 2, sl, wave, vl16, vut);
        scan_step(lds, f0, S0, S1, ro, vo, n, b, h, sl, wave, e, kc);
        load_frag(f0, R, bh * 32 + n + 3, sl, wave, vl16, vut);
        scan_step(lds, f1, S0, S1, ro, vo, n + 1, b, h, sl, wave, e, kc);
        load_frag(f1, R, bh * 32 + n + 4, sl, wave, vl16, vut);
        scan_step(lds, f2, S0, S1, ro, vo, n + 2, b, h, sl, wave, e, kc);
    }
    scan_step(lds, f0, S0, S1, ro, vo, 30, b, h, sl, wave, e, kc);
    scan_step(lds, f1, S0, S1, ro, vo, 31, b, h, sl, wave, e, kc);
}
}
constexpr int NWAVES = 8;
constexpr int RING_OFF = 0, RING_BYTES = 155648;
constexpr int LDSCTL_OFF = RING_BYTES, MISC_OFF = LDSCTL_OFF + 320;
constexpr int LDS_BYTES = 163840;

struct Frame {
    LAS unsigned char* lds;
    int tid, lane, wave;
    int vcu, G;
};

struct Args {
    const float* in[25]; float* out; unsigned char* ws;
    int ph_lo, ph_hi, flags, pad;
};
typedef const __attribute__((address_space(4))) Args* KArgs;

enum { WJ_PLAIN = 0, WJ_IN = 1, WJ_KV = 2, WJ_GLU = 3 };
struct WJob { const float* W; const float* W2; const float* gain; bf16_t* dst; int ldw, K, type, nblk; int fp8; unsigned* cmax; };
DI void wjob_src(const WJob& J, int db, const float*& src, int& scol, int& nvalid) {
    src = J.W; scol = 32 * db; nvalid = 32;
    if (J.type == WJ_IN) {
        if (db < 64) scol = 32 * db;
        else if (db < 76) scol = WC_CQ + 32 * (db - 64);
        else if (db < 84) scol = WC_CKV + 32 * (db - 76);
        else if (db == 84) scol = WC_KR;
        else if (db == 85) { scol = WC_A; nvalid = 8; }
        else if (db < 88) { scol = 0; nvalid = 0; }
        else { const int d2 = db - 88, j = d2 >> 3, w = d2 & 7;
               scol = WC_GATE + (w < 4 ? 0 : 1024) + j * 128 + 32 * (w & 3); }
    } else if (J.type == WJ_KV) {
        if (db < 16) scol = (db >> 1) * 128 + 32 * (db & 1);
        else scol = ((db - 16) >> 1) * 128 + 64 + 32 * (db & 1);
    } else if (J.type == WJ_GLU) {
        const int j = db >> 3, w = db & 7;
        if (w < 4) scol = j * 128 + 32 * w; else { src = J.W2; scol = j * 128 + 32 * (w - 4); }
    }
}
DI void wjob_absmax_item(const WJob& J, int item, int lane) {
    const int nkb = J.K >> 6; const int db = item / nkb, kb = item - db * nkb, k0 = kb << 6;
    const float* src; int scol, nvalid; wjob_src(J, db, src, scol, nvalid);
    const int n4 = (lane & 7) * 4, kr = lane >> 3;
    if (nvalid == 0) return;
    f32x4 mx = (f32x4){0.f, 0.f, 0.f, 0.f};
    if (n4 < nvalid) {
#pragma unroll
        for (int i = 0; i < 8; ++i) { const f32x4 v = *(const GAS f32x4*)(src + (size_t)(k0 + kr + 8 * i) * J.ldw + scol + n4);
            mx.x = fmaxf(mx.x, fabsf(v.x)); mx.y = fmaxf(mx.y, fabsf(v.y)); mx.z = fmaxf(mx.z, fabsf(v.z)); mx.w = fmaxf(mx.w, fabsf(v.w)); }
    }
#pragma unroll
    for (int e = 0; e < 4; ++e) { float t = mx[e]; t = fmaxf(t, xor8_f(t)); t = fmaxf(t, swz_xor<16>(t));
        const auto rr = __builtin_amdgcn_permlane32_swap(__float_as_uint(t), __float_as_uint(t), false, false); mx[e] = fmaxf(__uint_as_float(rr[0]), __uint_as_float(rr[1])); }
    if (lane < 8) {
#pragma unroll
        for (int e = 0; e < 4; ++e) __hip_atomic_fetch_max(J.cmax + 32 * db + n4 + e, __float_as_uint(mx[e]), RLX_AGENT);
    }
}
DI void wjob_absmax_run(const WJob& J, int& base, int gw, int NGW, int lane) {
    const int nitems = J.nblk * (J.K >> 6);
    int it = gw - (base % NGW); if (it < 0) it += NGW;
    for (; it < nitems; it += NGW) wjob_absmax_item(J, it, lane);
    base += nitems;
}
DI void wjob_load(const WJob& J, int item, int lane, f32x4 (&v)[8]) {
    const int nkb = J.K >> 6; const int db = item / nkb, kb = item - db * nkb, k0 = kb << 6;
    const float* src; int scol, nvalid; wjob_src(J, db, src, scol, nvalid);
    const int n4 = (lane & 7) * 4, kr = lane >> 3;
    const bool nin = n4 < nvalid;
#pragma unroll
    for (int i = 0; i < 8; ++i) { v[i] = (f32x4){0.f, 0.f, 0.f, 0.f}; if (nin) v[i] = __builtin_nontemporal_load((const GAS f32x4*)(src + (size_t)(k0 + kr + 8 * i) * J.ldw + scol + n4)); }
}
DI void wjob_fin1(const WJob& J, int item, LAS float* scr, int lane, const f32x4 (&v)[8]) {
    const int nkb = J.K >> 6; const int db = item / nkb, kb = item - db * nkb, k0 = kb << 6;
    const int n4 = (lane & 7) * 4, kr = lane >> 3;
#pragma unroll
    for (int i = 0; i < 8; ++i) { const int kk = kr + 8 * i; f32x4 t = v[i];
        if (J.gain) t = t * J.gain[k0 + kk];
        LAS float* d = scr + kk * 33 + n4;
        d[0] = t.x; d[1] = t.y; d[2] = t.z; d[3] = t.w; }
}
DI void wjob_fin2(const WJob& J, int item, LAS float* scr, int lane, const float (&inv)[4]) {
    const int nkb = J.K >> 6; const int db = item / nkb, kb = item - db * nkb, k0 = kb << 6;
    const int c = lane & 7;
#pragma unroll
    for (int j = 0; j < 4; ++j) { const int nn = (lane >> 3) + 8 * j; const LAS float* s = scr + (8 * c) * 33 + nn;
        if (J.fp8 == 2) {
            unsigned w0 = 0u, w1 = 0u;
#pragma unroll
            for (int i = 0; i < 4; ++i) { w0 = __builtin_amdgcn_cvt_pk_u8_f32(__builtin_rintf(s[i * 33] * inv[j]) + 128.f, i, w0); w1 = __builtin_amdgcn_cvt_pk_u8_f32(__builtin_rintf(s[(i + 4) * 33] * inv[j]) + 128.f, i, w1); }
            u32x2 o; o.x = w0 ^ 0x80808080u; o.y = w1 ^ 0x80808080u;
            *(GAS u32x2*)((unsigned char*)J.dst + (size_t)(32 * db + nn) * J.K + k0 + 8 * c) = o;
        } else if (J.fp8) {
            float q[8];
#pragma unroll
            for (int i = 0; i < 8; ++i) q[i] = __builtin_amdgcn_fmed3f(s[i * 33] * W8_SCALE, -448.f, 448.f);
            unsigned w0 = __builtin_amdgcn_cvt_pk_fp8_f32(q[0], q[1], 0, false); w0 = __builtin_amdgcn_cvt_pk_fp8_f32(q[2], q[3], w0, true);
            unsigned w1 = __builtin_amdgcn_cvt_pk_fp8_f32(q[4], q[5], 0, false); w1 = __builtin_amdgcn_cvt_pk_fp8_f32(q[6], q[7], w1, true);
            u32x2 o; o.x = w0; o.y = w1;
            *(GAS u32x2*)((unsigned char*)J.dst + (size_t)(32 * db + nn) * J.K + k0 + 8 * c) = o;
        } else {
        u32x4 o; o.x = pk2(s[0 * 33], s[1 * 33]); o.y = pk2(s[2 * 33], s[3 * 33]); o.z = pk2(s[4 * 33], s[5 * 33]); o.w = pk2(s[6 * 33], s[7 * 33]);
        *(GAS u32x4*)(J.dst + (size_t)(32 * db + nn) * J.K + k0 + 8 * c) = o; } }
}
DI void wjob_item(const WJob& J, int item, LAS float* scr, int lane) {
    f32x4 v[8]; wjob_load(J, item, lane, v);
    float inv[4] = {0.f, 0.f, 0.f, 0.f};
    if (J.fp8 == 2) { const int db = item / (J.K >> 6);
#pragma unroll
        for (int j = 0; j < 4; ++j) { const float cm = __uint_as_float(__hip_atomic_load(J.cmax + 32 * db + (lane >> 3) + 8 * j, RLX_AGENT)); inv[j] = cm > 0.f ? 127.f / cm : 0.f; } }
    wjob_fin1(J, item, scr, lane, v);
    LDS_WAIT(); asm volatile("" ::: "memory");
    wjob_fin2(J, item, scr, lane, inv);
    LDS_WAIT(); asm volatile("" ::: "memory");
}
DI void wjob_run(const WJob& J, int& base, int gw, int NGW, LAS float* scr, int lane) {
    const int nitems = J.nblk * (J.K >> 6);
    int it = gw - (base % NGW); if (it < 0) it += NGW;
    for (; it < nitems; it += NGW) wjob_item(J, it, scr, lane);
    base += nitems;
}

DI void dec_proj(KArgs ap, unsigned char* ws, int l, int idx, WJob& J, int& item) {
    if (idx < 256) { J = WJob{ap->in[9] + (size_t)l * 512 * D, nullptr, nullptr, (bf16_t*)(ws + WS_WGDNO + l * MiB), D, 512, WJ_PLAIN, 32, 0, nullptr}; item = idx; }
    else if (idx < 512) { J = WJob{ap->in[14] + (size_t)l * 512 * D, nullptr, nullptr, (bf16_t*)(ws + WS_WMLAO + l * MiB), D, 512, WJ_PLAIN, 32, 0, nullptr}; item = idx - 256; }
    else { J = WJob{ap->in[15] + (size_t)l * D * D, nullptr, nullptr, (bf16_t*)(ws + WS_WOUT + l * 2 * MiB), D, 1024, WJ_PLAIN, 32, 0, nullptr}; item = idx - 512; }
}
DI void dec_qkv(KArgs ap, unsigned char* ws, int l, int idx, WJob& J, int& item) {
    if (idx < 144) { J = WJob{ap->in[11] + (size_t)l * 384 * 768, nullptr, ap->in[10] + l * 384, (bf16_t*)(ws + WS_WQB + l * 768 * KiB), 768, 384, WJ_PLAIN, 24, 0, nullptr}; item = idx; }
    else { J = WJob{ap->in[13] + (size_t)l * 256 * 1024, nullptr, ap->in[12] + l * 256, (bf16_t*)(ws + WS_WKVB + l * 512 * KiB), 1024, 256, WJ_KV, 32, 0, nullptr}; item = idx - 144; }
}
constexpr int NPROJ_ITEMS = 1024, NQKV_ITEMS = 272, NCONV_L0 = NPROJ_ITEMS + 32 * (D_FF / 64);
constexpr int MOE_ITEMS_E = (2 * DFE / 32) * 16 + 32 * (DFE / 64), MOE_ITEMS = NE * MOE_ITEMS_E;
DI void dec_moe(KArgs ap, unsigned char* ws, int idx, WJob& J, int& item) {
    const int e = idx / MOE_ITEMS_E, r = idx - e * MOE_ITEMS_E;
    if (r < (2 * DFE / 32) * 16) { J = WJob{ap->in[21] + (size_t)e * D * DFE, ap->in[22] + (size_t)e * D * DFE, nullptr, (bf16_t*)((unsigned char*)ap->out + e * (7 * MiB / 2)), DFE, 1024, WJ_GLU, 2 * DFE / 32, 1, nullptr}; item = r; }
    else { J = WJob{ap->in[23] + (size_t)e * DFE * D, nullptr, nullptr, (bf16_t*)(ws + WS_WM2 + e * (7 * MiB / 4)), D, DFE, WJ_PLAIN, 32, 1, nullptr}; item = r - (2 * DFE / 32) * 16; }
}
DI void conv_dec(KArgs ap, unsigned char* ws, int mode, int idx, WJob& J, int& item) {
    if (mode == 2) dec_moe(ap, ws, idx, J, item);
    else if (idx < NPROJ_ITEMS) dec_proj(ap, ws, 1, idx, J, item);
    else { J = WJob{ap->in[19], nullptr, nullptr, (bf16_t*)(ws + WS_WD2), D, D_FF, WJ_PLAIN, 32, DENSE_DN_FP8, nullptr}; item = idx - NPROJ_ITEMS; }
}
#define CONV_BAR0() do { asm volatile("s_waitcnt lgkmcnt(0)" ::: "memory"); __builtin_amdgcn_s_barrier(); asm volatile("" ::: "memory"); } while (0)
constexpr unsigned OOB = 0x80000000u;
DI void cjob_load(const WJob& J, int item, bool valid, int lane, f32x4 (&v)[8]) {
    const int nkb = J.K >> 6; const int db = item / nkb, kb = item - db * nkb, k0 = kb << 6;
    const float* src; int scol, nvalid; wjob_src(J, db, src, scol, nvalid);
    const __amdgpu_buffer_rsrc_t rs = __builtin_amdgcn_make_buffer_rsrc((void*)src, 0, 0x7ffff000, 0x00020000);
    const int n4 = (lane & 7) * 4, kr = lane >> 3;
    const unsigned bad = (valid && n4 < nvalid) ? 0u : OOB;
#pragma unroll
    for (int i = 0; i < 8; ++i) v[i] = __builtin_bit_cast(f32x4, __builtin_amdgcn_raw_buffer_load_b128(rs, (unsigned)(((k0 + kr + 8 * i) * J.ldw + scol + n4) * 4) | bad, 0, 2));
}
DI void cjob_fin1(LAS float* scr, int lane, const f32x4 (&v)[8]) {
    const int n4 = (lane & 7) * 4, kr = lane >> 3;
#pragma unroll
    for (int i = 0; i < 8; ++i) { LAS float* d = scr + (kr + 8 * i) * 33 + n4; d[0] = v[i].x; d[1] = v[i].y; d[2] = v[i].z; d[3] = v[i].w; }
}
DI void cjob_fin2(const WJob& J, int item, bool valid, LAS float* scr, int lane, const float (&inv)[4]) {
    const int nkb = J.K >> 6; const int db = item / nkb, kb = item - db * nkb, k0 = kb << 6;
    const int c = lane & 7;
    const __amdgpu_buffer_rsrc_t rd = __builtin_amdgcn_make_buffer_rsrc((void*)J.dst, 0, 0x7ffff000, 0x00020000);
    const unsigned bad = valid ? 0u : OOB;
#pragma unroll
    for (int j = 0; j < 4; ++j) { const int nn = (lane >> 3) + 8 * j; const LAS float* s = scr + (8 * c) * 33 + nn;
        if (J.fp8 == 2) {
            unsigned w0 = 0u, w1 = 0u;
#pragma unroll
            for (int i = 0; i < 4; ++i) { w0 = __builtin_amdgcn_cvt_pk_u8_f32(__builtin_rintf(s[i * 33] * inv[j]) + 128.f, i, w0); w1 = __builtin_amdgcn_cvt_pk_u8_f32(__builtin_rintf(s[(i + 4) * 33] * inv[j]) + 128.f, i, w1); }
            u32x2 o; o.x = w0 ^ 0x80808080u; o.y = w1 ^ 0x80808080u;
            __builtin_amdgcn_raw_buffer_store_b64(o, rd, (unsigned)((32 * db + nn) * J.K + k0 + 8 * c) | bad, 0, 2);
        } else if (J.fp8) {
            float q[8];
#pragma unroll
            for (int i = 0; i < 8; ++i) q[i] = __builtin_amdgcn_fmed3f(s[i * 33] * W8_SCALE, -448.f, 448.f);
            unsigned w0 = __builtin_amdgcn_cvt_pk_fp8_f32(q[0], q[1], 0, false); w0 = __builtin_amdgcn_cvt_pk_fp8_f32(q[2], q[3], w0, true);
            unsigned w1 = __builtin_amdgcn_cvt_pk_fp8_f32(q[4], q[5], 0, false); w1 = __builtin_amdgcn_cvt_pk_fp8_f32(q[6], q[7], w1, true);
            u32x2 o; o.x = w0; o.y = w1;
            __builtin_amdgcn_raw_buffer_store_b64(o, rd, (unsigned)((32 * db + nn) * J.K + k0 + 8 * c) | bad, 0, 2);
        } else {
            u32x4 o; o.x = pk2(s[0 * 33], s[1 * 33]); o.y = pk2(s[2 * 33], s[3 * 33]); o.z = pk2(s[4 * 33], s[5 * 33]); o.w = pk2(s[6 * 33], s[7 * 33]);
            __builtin_amdgcn_raw_buffer_store_b128(o, rd, (unsigned)(((32 * db + nn) * J.K + k0 + 8 * c) * 2) | bad, 0, 2); } }
}
DI void cjob_pad_stores(unsigned char* ws, int lane) {
    const __amdgpu_buffer_rsrc_t rd = __builtin_amdgcn_make_buffer_rsrc((void*)ws, 0, 0x7ffff000, 0x00020000);
    u32x2 z; z.x = (unsigned)lane; z.y = (unsigned)lane;
#pragma unroll
    for (int j = 0; j < 4; ++j) __builtin_amdgcn_raw_buffer_store_b64(z, rd, OOB, 0, 0);
}
DI void conv_stream(KArgs ap, unsigned char* ws, int mode, int first, int stride, int total, int nbar, LAS float* scr, int lane) {
    f32x4 va[8], vb[8]; WJob J; int item; const float inv0[4] = {0.f, 0.f, 0.f, 0.f};
    int pa = first, pb2 = first + stride, nxt = first + 2 * stride;
    conv_dec(ap, ws, mode, pa < total ? pa : 0, J, item); cjob_load(J, item, pa < total, lane, va); cjob_pad_stores(ws, lane);
    conv_dec(ap, ws, mode, pb2 < total ? pb2 : 0, J, item); cjob_load(J, item, pb2 < total, lane, vb); cjob_pad_stores(ws, lane);
    int step = 0;
    if (nbar > 0) CONV_BAR0();
#pragma unroll 1
    for (;;) {
        const bool paced = nbar > 0 && step < NCHUNK;
        if (!paced && pa >= total) break;
        { const int pc = pa; WJob Jc; int ic;
          conv_dec(ap, ws, mode, pc < total ? pc : 0, Jc, ic); cjob_fin1(scr, lane, va);
          pa = nxt; nxt += stride; conv_dec(ap, ws, mode, pa < total ? pa : 0, J, item); cjob_load(J, item, pa < total, lane, va);
          if (paced) lds_barrier(); else { LDS_WAIT(); asm volatile("" ::: "memory"); }
          cjob_fin2(Jc, ic, pc < total, scr, lane, inv0);
          if (paced) lds_barrier(); else { LDS_WAIT(); asm volatile("" ::: "memory"); } }
        { const int pc = pb2; WJob Jc; int ic;
          conv_dec(ap, ws, mode, pc < total ? pc : 0, Jc, ic); cjob_fin1(scr, lane, vb);
          pb2 = nxt; nxt += stride; conv_dec(ap, ws, mode, pb2 < total ? pb2 : 0, J, item); cjob_load(J, item, pb2 < total, lane, vb);
          if (paced) lds_barrier(); else { LDS_WAIT(); asm volatile("" ::: "memory"); }
          cjob_fin2(Jc, ic, pc < total, scr, lane, inv0);
          if (paced) lds_barrier(); else { LDS_WAIT(); asm volatile("" ::: "memory"); } }
        step += 2;
    }
#pragma unroll 1
    for (int u = 1; u < nbar; ++u) { CONV_BAR0();
#pragma unroll 1
        for (int n = 0; n < 2 * NCHUNK; ++n) lds_barrier(); }
}
DI void absmax_acc(f32x4& mx, const f32x4 (&v)[8]) {
#pragma unroll
    for (int i = 0; i < 8; ++i) { mx.x = fmaxf(mx.x, fabsf(v[i].x)); mx.y = fmaxf(mx.y, fabsf(v[i].y)); mx.z = fmaxf(mx.z, fabsf(v[i].z)); mx.w = fmaxf(mx.w, fabsf(v[i].w)); }
}
DI void conv_i8_block(const WJob& J, int db, bool bars, LAS float* scr, int lane) {
    f32x4 va[8], vb[8]; f32x4 mx = (f32x4){0.f, 0.f, 0.f, 0.f};
    cjob_load(J, db * 16, true, lane, va); cjob_load(J, db * 16 + 1, true, lane, vb);
    if (bars) CONV_BAR0();
#pragma unroll 1
    for (int kb = 0; kb < 16; kb += 2) {
        absmax_acc(mx, va); cjob_load(J, db * 16 + ((kb + 2) & 15), true, lane, va);
        if (bars) { lds_barrier(); lds_barrier(); }
        absmax_acc(mx, vb); cjob_load(J, db * 16 + ((kb + 3) & 15), true, lane, vb);
        if (bars) { lds_barrier(); lds_barrier(); }
    }
#pragma unroll
    for (int e = 0; e < 4; ++e) { float t = mx[e]; t = fmaxf(t, xor8_f(t)); t = fmaxf(t, swz_xor<16>(t));
        const auto rr = __builtin_amdgcn_permlane32_swap(__float_as_uint(t), __float_as_uint(t), false, false); mx[e] = fmaxf(__uint_as_float(rr[0]), __uint_as_float(rr[1])); }
    if (lane < 8) {
#pragma unroll
        for (int e = 0; e < 4; ++e) { J.cmax[32 * db + 4 * lane + e] = __float_as_uint(mx[e]); scr[2112 + 4 * lane + e] = mx[e]; } }
    LDS_WAIT(); asm volatile("" ::: "memory");
    float inv[4];
#pragma unroll
    for (int j = 0; j < 4; ++j) { const float cm = scr[2112 + (lane >> 3) + 8 * j]; inv[j] = cm > 0.f ? 127.f / cm : 0.f; }
#pragma unroll 1
    for (int kb = 0; kb < 16; kb += 2) {
        cjob_fin1(scr, lane, va); cjob_load(J, db * 16 + ((kb + 2) & 15), kb + 2 < 16, lane, va);
        if (bars) lds_barrier(); else { LDS_WAIT(); asm volatile("" ::: "memory"); }
        cjob_fin2(J, db * 16 + kb, true, scr, lane, inv);
        if (bars) lds_barrier(); else { LDS_WAIT(); asm volatile("" ::: "memory"); }
        cjob_fin1(scr, lane, vb); cjob_load(J, db * 16 + ((kb + 3) & 15), kb + 3 < 16, lane, vb);
        if (bars) lds_barrier(); else { LDS_WAIT(); asm volatile("" ::: "memory"); }
        cjob_fin2(J, db * 16 + kb + 1, true, scr, lane, inv);
        if (bars) lds_barrier(); else { LDS_WAIT(); asm volatile("" ::: "memory"); }
    }
}
constexpr int NI8_L1 = NPROJ / 32, NI8_BLOCKS = NPROJ / 32 + 2 * D_FF / 32;
DI void conv_i8_job(KArgs ap, unsigned char* ws, int b, WJob& J, int& db) {
    unsigned* cmx = (unsigned*)(ws + WS_CTL) + CW_CMAX;
    if (b < NI8_L1) { J = WJob{ap->in[3] + (size_t)D * IN_COLS, nullptr, nullptr, (bf16_t*)(ws + WS_WIN + WIN_STRIDE), IN_COLS, 1024, WJ_IN, NPROJ / 32, 2, cmx + NPROJ}; db = b; }
    else { J = WJob{ap->in[17], ap->in[18], nullptr, (bf16_t*)(ws + WS_WD13), D_FF, 1024, WJ_GLU, 2 * D_FF / 32, 2, cmx + 2 * NPROJ}; db = b - NI8_L1; }
}
DI void scan_converter(KArgs ap, unsigned char* ws, int l, int cw, int NCW, int nun, LAS float* scr, int lane) {
    int nb = nun;
    if (l == 0) {
        const bool split = NCW >= NI8_BLOCKS + 64;
#pragma unroll 1
        for (int b = cw; b < NI8_BLOCKS; b += NCW) { WJob J; int db; conv_i8_job(ap, ws, b, J, db); conv_i8_block(J, db, nb > 0, scr, lane); if (nb > 0) --nb; }
        if (split) { if (cw >= NI8_BLOCKS) conv_stream(ap, ws, 1, cw - NI8_BLOCKS, NCW - NI8_BLOCKS, NCONV_L0, nb, scr, lane); else conv_stream(ap, ws, 1, 0, 1, 0, nb, scr, lane); }
        else conv_stream(ap, ws, 1, cw, NCW, NCONV_L0, nb, scr, lane);
    } else conv_stream(ap, ws, 2, cw, NCW, MOE_ITEMS, nb, scr, lane);
}

DI float rms_row_load(const float* xrow, const float* gain, int lane, f32x4 (&v)[4]) {
    const GAS f32x4* xr = (const GAS f32x4*)xrow + lane;
    float ss = 0.f;
#pragma unroll
    for (int j = 0; j < 4; ++j) { v[j] = xr[64 * j]; ss += (v[j].x * v[j].x + v[j].y * v[j].y) + (v[j].z * v[j].z + v[j].w * v[j].w); }
    ss = wave_sum(ss);
    const float rstd = rsqrtf(ss * (1.f / D) + EPS);
    const GAS f32x4* gr = (const GAS f32x4*)gain + lane;
#pragma unroll
    for (int j = 0; j < 4; ++j) v[j] = v[j] * gr[64 * j] * rstd;
    return rstd;
}
DI float rms_row_load_b(const bf16_t* xrow, const float* gain, int lane, f32x4 (&v)[4]) {
    const GAS u32x2* xr = (const GAS u32x2*)xrow + lane;
    float ss = 0.f;
#pragma unroll
    for (int j = 0; j < 4; ++j) { const u32x2 w = xr[64 * j]; v[j] = (f32x4){bflo(w.x), bfhi(w.x), bflo(w.y), bfhi(w.y)}; ss += (v[j].x * v[j].x + v[j].y * v[j].y) + (v[j].z * v[j].z + v[j].w * v[j].w); }
    ss = wave_sum(ss);
    const float rstd = rsqrtf(ss * (1.f / D) + EPS);
    const GAS f32x4* gr = (const GAS f32x4*)gain + lane;
#pragma unroll
    for (int j = 0; j < 4; ++j) v[j] = v[j] * gr[64 * j] * rstd;
    return rstd;
}
DI void row_store_bf16(bf16_t* orow, int lane, const f32x4 (&v)[4]) {
    GAS u32x2* o8 = (GAS u32x2*)orow + lane;
#pragma unroll
    for (int j = 0; j < 4; ++j) { u32x2 w; w.x = pk2(v[j].x, v[j].y); w.y = pk2(v[j].z, v[j].w); o8[64 * j] = w; }
}
DI float wave_max(float v) {
    v = row16_max(v); v = fmaxf(v, swz_xor<16>(v));
    const auto rr = __builtin_amdgcn_permlane32_swap(__float_as_uint(v), __float_as_uint(v), false, false); return fmaxf(__uint_as_float(rr[0]), __uint_as_float(rr[1]));
}
DI void row_store_i8(unsigned char* orow, float* srow, int lane, const f32x4 (&v)[4]) {
    float am = 0.f;
#pragma unroll
    for (int j = 0; j < 4; ++j) am = fmaxf(fmaxf(am, fmaxf(fabsf(v[j].x), fabsf(v[j].y))), fmaxf(fabsf(v[j].z), fabsf(v[j].w)));
    am = wave_max(am);
    const float inv = am > 0.f ? 127.f / am : 0.f;
    GAS unsigned* o = (GAS unsigned*)orow + lane;
#pragma unroll
    for (int j = 0; j < 4; ++j) { unsigned w = 0u;
        w = __builtin_amdgcn_cvt_pk_u8_f32(__builtin_rintf(v[j].x * inv) + 128.f, 0, w); w = __builtin_amdgcn_cvt_pk_u8_f32(__builtin_rintf(v[j].y * inv) + 128.f, 1, w);
        w = __builtin_amdgcn_cvt_pk_u8_f32(__builtin_rintf(v[j].z * inv) + 128.f, 2, w); w = __builtin_amdgcn_cvt_pk_u8_f32(__builtin_rintf(v[j].w * inv) + 128.f, 3, w);
        o[64 * j] = w ^ 0x80808080u; }
    if (lane == 0) *srow = am * (1.f / 127.f);
}
DI void row_issue_b(const bf16_t* xrow, int lane, u32x2 (&w)[4]) { const GAS u32x2* xr = (const GAS u32x2*)xrow + lane;
#pragma unroll
    for (int j = 0; j < 4; ++j) w[j] = xr[64 * j]; }
DI void row_issue_f(const float* xrow, int lane, f32x4 (&w)[4]) { const GAS f32x4* xr = (const GAS f32x4*)xrow + lane;
#pragma unroll
    for (int j = 0; j < 4; ++j) w[j] = __builtin_nontemporal_load(xr + 64 * j); }
DI void row_norm_b(const u32x2 (&w)[4], const f32x4 (&g)[4], f32x4 (&v)[4]) {
    float ss = 0.f;
#pragma unroll
    for (int j = 0; j < 4; ++j) { v[j] = (f32x4){bflo(w[j].x), bfhi(w[j].x), bflo(w[j].y), bfhi(w[j].y)}; ss += (v[j].x * v[j].x + v[j].y * v[j].y) + (v[j].z * v[j].z + v[j].w * v[j].w); }
    ss = wave_sum(ss); const float rstd = rsqrtf(ss * (1.f / D) + EPS);
#pragma unroll
    for (int j = 0; j < 4; ++j) v[j] = v[j] * g[j] * rstd;
}
DI void row_norm_f(const f32x4 (&w)[4], const f32x4 (&g)[4], f32x4 (&v)[4]) {
    float ss = 0.f;
#pragma unroll
    for (int j = 0; j < 4; ++j) { v[j] = w[j]; ss += (v[j].x * v[j].x + v[j].y * v[j].y) + (v[j].z * v[j].z + v[j].w * v[j].w); }
    ss = wave_sum(ss); const float rstd = rsqrtf(ss * (1.f / D) + EPS);
#pragma unroll
    for (int j = 0; j < 4; ++j) v[j] = v[j] * g[j] * rstd;
}
DI void norm_rows_i8(int gw, int NGW, int lane, const float* X, const float* gain, bf16_t* XN8, float* sA) {
    f32x4 g[4]; { const GAS f32x4* gr = (const GAS f32x4*)gain + lane;
#pragma unroll
        for (int j = 0; j < 4; ++j) g[j] = gr[64 * j]; }
    f32x4 wn[4];
#pragma unroll
    for (int j = 0; j < 4; ++j) wn[j] = (f32x4){0.f, 0.f, 0.f, 0.f};
    if (gw < M) row_issue_f(X + (size_t)gw * D, lane, wn);
#pragma unroll 1
    for (int m = gw; m < M; m += NGW) {
        f32x4 wc[4];
#pragma unroll
        for (int j = 0; j < 4; ++j) wc[j] = wn[j];
        asm volatile("" : "+v"(wc[0]), "+v"(wc[1]), "+v"(wc[2]), "+v"(wc[3]));
        if (m + NGW < M) row_issue_f(X + (size_t)(m + NGW) * D, lane, wn);
        f32x4 v[4]; row_norm_f(wc, g, v); row_store_i8((unsigned char*)XN8 + (size_t)m * D, sA + m, lane, v);
    }
}
DI void norm_rows_bi8(int gw, int NGW, int lane, const bf16_t* X, const float* gain, bf16_t* XN8, float* sA) {
    f32x4 g[4]; { const GAS f32x4* gr = (const GAS f32x4*)gain + lane;
#pragma unroll
        for (int j = 0; j < 4; ++j) g[j] = gr[64 * j]; }
    u32x2 wn[4];
#pragma unroll
    for (int j = 0; j < 4; ++j) wn[j] = (u32x2){0u, 0u};
    if (gw < M) row_issue_b(X + (size_t)gw * D, lane, wn);
#pragma unroll 1
    for (int m = gw; m < M; m += NGW) {
        u32x2 wc[4];
#pragma unroll
        for (int j = 0; j < 4; ++j) wc[j] = wn[j];
        asm volatile("" : "+v"(wc[0]), "+v"(wc[1]), "+v"(wc[2]), "+v"(wc[3]));
        if (m + NGW < M) row_issue_b(X + (size_t)(m + NGW) * D, lane, wn);
        f32x4 v[4]; row_norm_b(wc, g, v); row_store_i8((unsigned char*)XN8 + (size_t)m * D, sA + m, lane, v);
    }
}
DI void norm_rows_b8(int gw, int NGW, int lane, const bf16_t* X, const float* gain, bf16_t* XN8) {
    for (int m = gw; m < M; m += NGW) { f32x4 v[4]; rms_row_load_b(X + (size_t)m * D, gain, lane, v);
        GAS unsigned* o8 = (GAS unsigned*)((unsigned char*)XN8 + (size_t)m * D) + lane;
#pragma unroll
        for (int j = 0; j < 4; ++j) { const float c0 = __builtin_amdgcn_fmed3f(v[j].x, -448.f, 448.f), c1 = __builtin_amdgcn_fmed3f(v[j].y, -448.f, 448.f), c2 = __builtin_amdgcn_fmed3f(v[j].z, -448.f, 448.f), c3 = __builtin_amdgcn_fmed3f(v[j].w, -448.f, 448.f);
            unsigned w = __builtin_amdgcn_cvt_pk_fp8_f32(c0, c1, 0, false); w = __builtin_amdgcn_cvt_pk_fp8_f32(c2, c3, w, true); o8[64 * j] = w; } }
}
DI void norm_rows_b(int gw, int NGW, int lane, const bf16_t* X, const float* gain, bf16_t* XN) {
    for (int m = gw; m < M; m += NGW) { f32x4 v[4]; rms_row_load_b(X + (size_t)m * D, gain, lane, v); row_store_bf16(XN + (size_t)m * D, lane, v); }
}
DI void norm_rows(int gw, int NGW, int lane, const float* X, const float* gain, bf16_t* XN) {
    for (int m = gw; m < M; m += NGW) { f32x4 v[4]; rms_row_load(X + (size_t)m * D, gain, lane, v); row_store_bf16(XN + (size_t)m * D, lane, v); }
}

#ifdef PROBE_MFMA
typedef int i32x4 __attribute__((ext_vector_type(4)));
__device__ __noinline__ void mfma_rate_probe(unsigned* sink, int iters) {
    const int l = lane_id_asm();
    i32x4 a = (i32x4){l, l * 3, l * 5, l * 7}, b = (i32x4){l * 11, l * 13, l * 17, l * 19};
#if PROBE_MFMA == 2
    i32x4 acc[8];
#pragma unroll
    for (int i = 0; i < 8; ++i) acc[i] = (i32x4){0, 0, 0, 0};
#pragma unroll 1
    for (int it = 0; it < iters; ++it) {
#pragma unroll
        for (int i = 0; i < 8; ++i) acc[i] = __builtin_amdgcn_mfma_i32_16x16x64_i8(a, b, acc[i], 0, 0, 0);
        asm volatile("" : "+v"(a), "+v"(b));
    }
    int s = 0;
#pragma unroll
    for (int i = 0; i < 8; ++i) s += acc[i][0] + acc[i][1] + acc[i][2] + acc[i][3];
    if (s == 0x12345678) sink[l] = (unsigned)s;
#else
    f32x4 acc[8];
#pragma unroll
    for (int i = 0; i < 8; ++i) acc[i] = (f32x4){0.f, 0.f, 0.f, 0.f};
    bf16x8 a8 = __builtin_bit_cast(bf16x8, a), b8 = __builtin_bit_cast(bf16x8, b);
#pragma unroll 1
    for (int it = 0; it < iters; ++it) {
#pragma unroll
        for (int i = 0; i < 8; ++i) acc[i] = __builtin_amdgcn_mfma_f32_16x16x32_bf16(a8, b8, acc[i], 0, 0, 0);
        asm volatile("" : "+v"(a8), "+v"(b8));
    }
    float s = 0.f;
#pragma unroll
    for (int i = 0; i < 8; ++i) s += acc[i][0] + acc[i][1] + acc[i][2] + acc[i][3];
    if (s == 123.456f) sink[l] = __float_as_uint(s);
#endif
}
#endif
#define PHASE_BUFS \
    const float* x = ap->in[0]; const int* pos = (const int*)ap->in[1]; \
    const float* mix_norm = ap->in[2]; const float* w_in = ap->in[3]; const float* gate_bias = ap->in[4]; \
    const float* conv_w = ap->in[5]; const float* a_log = ap->in[6]; const float* dt_bias = ap->in[7]; const float* gdn_out_norm = ap->in[8]; \
    const float* w_gdn_o = ap->in[9]; const float* q_a_norm = ap->in[10]; \
    const float* w_q_b = ap->in[11]; const float* kv_a_norm = ap->in[12]; const float* w_kv_b = ap->in[13]; \
    const float* w_mla_o = ap->in[14]; const float* w_out = ap->in[15]; const float* ffn_norm = ap->in[16]; \
    const float* dense_w1 = ap->in[17]; const float* dense_w3 = ap->in[18]; const float* dense_w2 = ap->in[19]; \
    const float* router_w = ap->in[20]; const float* moe_w1 = ap->in[21]; const float* moe_w3 = ap->in[22]; \
    const float* moe_w2 = ap->in[23]; const float* final_norm = ap->in[24]; \
    float* X = ap->out; \
    bf16_t* GATE = (bf16_t*)(ws + WS_GATE); bf16_t* Zb = (bf16_t*)(ws + WS_Z); bf16_t* MISC = (bf16_t*)(ws + WS_MISC); bf16_t* QKV = (bf16_t*)(ws + WS_QKV); \
    bf16_t* Qb = (bf16_t*)(ws + WS_Q); bf16_t* Kb = (bf16_t*)(ws + WS_K); bf16_t* Vb = (bf16_t*)(ws + WS_V); bf16_t* AO = (bf16_t*)(ws + WS_AO); bf16_t* GO = (bf16_t*)(ws + WS_GO); \
    bf16_t* XN = (bf16_t*)((unsigned char*)ap->out + OUT_XN); bf16_t* MERGED = XN; bf16_t* XB = (bf16_t*)(ws + WS_XB); \
    bf16_t* HB = (bf16_t*)(ws + WS_HB); bf16_t* XG = (bf16_t*)(ws + WS_XG); bf16_t* Hm = (bf16_t*)(ws + WS_H); bf16_t* Yb = (bf16_t*)(ws + WS_Y); \
    float* ORAW = (float*)((unsigned char*)ap->out + OUT_XN); float* COS = (float*)(ws + WS_COS); float* SIN = (float*)(ws + WS_SIN); float* rstdq = (float*)(ws + WS_RSTD); float* rstdkv = rstdq + M; \
    int* topi = (int*)(ws + WS_MOE); float* topw = (float*)(topi + 2 * M); int* pairrow = (int*)(topw + 2 * M); int* list = pairrow + 2 * M; int* offs = list + NE * M; \
    unsigned* cnt = (unsigned*)(ws + WS_CTL) + CW_CNT; unsigned* cmx = (unsigned*)(ws + WS_CTL) + CW_CMAX; float* SAq = (float*)(ws + WS_SA);
__global__ void __launch_bounds__(NWAVES * 64, 2) mega_fwd(Args args) {
    extern __shared__ __attribute__((aligned(16))) unsigned char lds_raw[];
    Frame F;
    F.lds = (LAS unsigned char*)lds_raw;
    volatile LAS unsigned* MISCW = (volatile LAS unsigned*)(F.lds + MISC_OFF);
    F.tid = threadIdx.x; F.lane = F.tid & 63; F.wave = __builtin_amdgcn_readfirstlane(F.tid >> 6);
    F.G = gridDim.x; { const int bx = blockIdx.x; F.vcu = (F.G % 8 == 0) ? (bx % 8) * (F.G / 8) + bx / 8 : bx; }
    unsigned* ctl = (unsigned*)(args.ws + WS_CTL);
    for (int u = F.tid; u < (LDS_BYTES - LDSCTL_OFF) / 4; u += NWAVES * 64) ((LAS unsigned*)(F.lds + LDSCTL_OFF))[u] = 0u;
    __syncthreads();
    XcdBarrier bar = xcd_barrier_post(ctl + CW_BAR, MISCW + 8); bar.wave = F.wave;
    const int lo = args.ph_lo, hi = args.ph_hi;
#ifndef PROBE_LOCAL_X
#define PROBE_LOCAL_X 1
#endif
#ifndef PHASE_ENABLE
#define PHASE_ENABLE 0xFFFFFFF
#endif
#define P_ON(k) (((PHASE_ENABLE) >> (k)) & 1)
#define IN(k) (lo <= (k) && (k) < hi)
#define PHASE_BEGIN int pw = F.wave, pbx = (int)blockIdx.x, pG = F.G; asm volatile("" : "+s"(pw), "+s"(pbx), "+s"(pG)); int lane_ = lane_id_asm(); const int lane = lane_, tid = pw * 64 + lane_; (void)tid; const int gw = F.vcu * NWAVES + pw, NGW = F.G * NWAVES; (void)gw; (void)NGW; LAS float* scr = (LAS float*)(F.lds + RING_OFF + pw * 16384); (void)scr; KArgs ap = (KArgs)__builtin_amdgcn_kernarg_segment_ptr(); asm volatile("" : "+s"(ap)); unsigned char* ws = ap->ws; PHASE_BUFS
#define SEAM(k) do { if (IN(k) && IN((k) + 1)) xcd_barrier(bar); } while (0)


#ifdef PROBE_MFMA
    mfma_rate_probe((unsigned*)(args.ws + WS_END), 2000);
#endif
    if (IN(0) && P_ON(12)) { PHASE_BEGIN;
        WJob Jin{w_in, nullptr, nullptr, (bf16_t*)(ws + WS_WIN), IN_COLS, 1024, WJ_IN, NPROJ / 32, 2, cmx};
        const int nin = (NPROJ / 32) * 16;
        const bool small_later = pG > 192;
        for (int i = gw; i < nin + (small_later ? 0 : NPROJ_ITEMS + 2 * NQKV_ITEMS); i += NGW) {
            if (i < nin) wjob_absmax_item(Jin, i, lane);
            else { WJob J; int item; const int r = i - nin;
                if (r < NPROJ_ITEMS) dec_proj(ap, ws, 0, r, J, item); else if (r < NPROJ_ITEMS + NQKV_ITEMS) dec_qkv(ap, ws, 0, r - NPROJ_ITEMS, J, item); else dec_qkv(ap, ws, 1, r - NPROJ_ITEMS - NQKV_ITEMS, J, item);
                wjob_item(J, item, scr, lane); }
        }
        for (int i = pbx * (NWAVES * 64) + tid; i < M * 16; i += pG * NWAVES * 64) {
            const int m = i >> 4, j = i & 15;
            const float ang = (float)pos[m] * powf(10000.f, -(float)j / 16.f);
            COS[i] = cosf(ang); SIN[i] = sinf(ang);
        }
    }
    if (IN(0)) xcd_barrier(bar);
    if (IN(0) && P_ON(12)) { PHASE_BEGIN;
        WJob Jin{w_in, nullptr, nullptr, (bf16_t*)(ws + WS_WIN), IN_COLS, 1024, WJ_IN, NPROJ / 32, 2, cmx};
        for (int i = gw; i < (NPROJ / 32) * 16; i += NGW) wjob_item(Jin, i, scr, lane);
        norm_rows_i8(gw, NGW, lane, x, mix_norm, XN, SAq);
    }
    SEAM(0);

#pragma unroll 1
    for (int l = 0; l < 2; ++l) {
        const int pb = 1 + 12 * l;
        if (IN(pb + 0) && P_ON(0)) { PHASE_BEGIN;
            pg8::Gemm g{XN, (const bf16_t*)(ws + WS_WIN + l * WIN_STRIDE), D, D, SAq, (const float*)(cmx + l * NPROJ)}; pg8::StaticOrder S; S.init(M, NPROJ, pG, pbx);
            pg8::EpiInProj E{QKV, Zb, MISC, GATE, gate_bias + l * 2048};
            pg8::gemm_phase<pg8::EpiInProj, pg8::StaticOrder, true, I8_INPROJ ? 2 : 0>(F.lds + RING_OFF, g, S, E, pw);
            if (l == 0 && pG > 192 && pbx >= 192) {
                __syncthreads();
                for (int i = (pbx - 192) * NWAVES + pw; i < NPROJ_ITEMS + 2 * NQKV_ITEMS; i += (pG - 192) * NWAVES) { WJob J; int item;
                    if (i < NPROJ_ITEMS) dec_proj(ap, ws, 0, i, J, item); else if (i < NPROJ_ITEMS + NQKV_ITEMS) dec_qkv(ap, ws, 0, i - NPROJ_ITEMS, J, item); else dec_qkv(ap, ws, 1, i - NPROJ_ITEMS - NQKV_ITEMS, J, item);
                    wjob_item(J, item, scr, lane); }
            }
        }
        SEAM(pb + 0);
        if (IN(pb + 1) && P_ON(1)) { PHASE_BEGIN;
            bf16_t* UT = (bf16_t*)(ws + WS_UT); bf16_t* Wg = (bf16_t*)(ws + WS_W); bf16_t* QD = (bf16_t*)(ws + WS_QD); bf16_t* KDT = (bf16_t*)(ws + WS_KDT); bf16_t* ATb = (bf16_t*)(ws + WS_AT); float* CD = (float*)(ws + WS_CD);
            for (int up = F.vcu; up < 512; up += pG) gdn::local_pair(F.lds + RING_OFF, QKV, MISC, conv_w + l * 4 * 1536, a_log + l * 4, dt_bias + l * 4, UT, Wg, QD, KDT, ATb, CD, up, pw);
            if (!(args.flags & 2)) mla_prep_rows(gw, NGW, lane, MISC, rstdq, rstdkv);
        }
        SEAM(pb + 1);
        if (IN(pb + 2) && P_ON(2)) { PHASE_BEGIN;
            bf16_t* UT = (bf16_t*)(ws + WS_UT); bf16_t* Wg = (bf16_t*)(ws + WS_W); bf16_t* QD = (bf16_t*)(ws + WS_QD); bf16_t* KDT = (bf16_t*)(ws + WS_KDT); bf16_t* ATb = (bf16_t*)(ws + WS_AT); float* CD = (float*)(ws + WS_CD);
            if (pw < 4) { __builtin_amdgcn_s_setprio(3);
                for (int u = F.vcu; u < 256; u += pG) gdn::scan_unit(F.lds + RING_OFF, UT, Wg, QD, KDT, ATb, CD, ORAW, u >> 3, u & 7, tid, pw, lane);
                __builtin_amdgcn_s_setprio(0); }
            else scan_converter(ap, ws, l, (pw - 4) * pG + pbx  , 4 * pG, F.vcu < 256 ? (256 - F.vcu + pG - 1) / pG : 0, scr, lane);
        }
        SEAM(pb + 2);
        if (IN(pb + 3) && P_ON(3)) { PHASE_BEGIN;
            mla_kpe_rows(gw, NGW, lane, MISC, COS, SIN, Kb);
            if (pG > 192 && pbx >= 192) gdn_gate_rows((pbx - 192) * NWAVES + pw, (pG - 192) * NWAVES, lane, ORAW, Zb, gdn_out_norm + l * 128, GO, 0, M / 2);
            { pg8::Gemm g{MISC + MC_CQ, (const bf16_t*)(ws + WS_WQB + l * 768 * KiB), MISC_LD, 384}; pg8::StaticOrder S; S.init(M, 768, pG, pbx);
              pg8::EpiQRope E{Qb, rstdq, COS, SIN};
              pg8::gemm_phase<pg8::EpiQRope, pg8::StaticOrder, false>(F.lds + RING_OFF, g, S, E, pw); }
            { pg8::Gemm g{MISC + MC_CKV, (const bf16_t*)(ws + WS_WKVB + l * 512 * KiB), MISC_LD, 256}; pg8::StaticOrder S; S.init(M, 1024, pG, pbx);
              pg8::EpiKV E{Kb, Vb, rstdkv};
              pg8::gemm_phase<pg8::EpiKV, pg8::StaticOrder, false>(F.lds + RING_OFF, g, S, E, pw); }
        }
        SEAM(pb + 3);
        if (IN(pb + 4) && P_ON(4)) { PHASE_BEGIN;
            if (!(args.flags & 1)) {
                for (int u = F.vcu; u < 256; u += pG) {
                    const int bh = u >> 2, sp = u & 3, b = bh >> 3, h = bh & 7;
                    att::attn_unit(F.lds + RING_OFF, Qb, Kb, Vb, AO, b, h, 7 - sp, tid, pw, lane);
                    att::attn_unit(F.lds + RING_OFF, Qb, Kb, Vb, AO, b, h, sp, tid, pw, lane);
                }
            }
            gdn_gate_rows(gw, NGW, lane, ORAW, Zb, gdn_out_norm + l * 128, GO, pG > 192 ? M / 2 : 0, M);
        }
        SEAM(pb + 4);
        if (IN(pb + 5) && P_ON(5)) { PHASE_BEGIN;
            pg8::Gemm g{AO, (const bf16_t*)(ws + WS_WGDNO + l * MiB), 512, 512}; pg8::TwoSegOrder S;
            S.init(M, D, pG, pbx, (size_t)(WS_GO - WS_AO), (size_t)(WS_WMLAO - WS_WGDNO));
            pg8::EpiMerge2 E{MERGED, GATE};
            pg8::gemm_phase<pg8::EpiMerge2, pg8::TwoSegOrder, false>(F.lds + RING_OFF, g, S, E, pw);
        }
        SEAM(pb + 5);
        if (IN(pb + 6) && P_ON(6)) { PHASE_BEGIN;
            pg8::Gemm g{MERGED, (const bf16_t*)(ws + WS_WOUT + l * 2 * MiB), D, D}; pg8::StaticOrder S; S.init(M, D, pG, pbx);
            if (l == 0) { pg8::EpiResidB<true> E{x, XB, 1.f}; pg8::gemm_phase<pg8::EpiResidB<true>, pg8::StaticOrder, false>(F.lds + RING_OFF, g, S, E, pw); }
            else { pg8::EpiResidB<false> E{XB, XB, 1.f}; pg8::gemm_phase<pg8::EpiResidB<false>, pg8::StaticOrder, false>(F.lds + RING_OFF, g, S, E, pw); }
        }
        SEAM(pb + 6);
        if (IN(pb + 7) && P_ON(7)) { PHASE_BEGIN;
            if (l == 0) { if (I8_DUP) norm_rows_bi8(gw, NGW, lane, XB, ffn_norm, XN, SAq); else if (DENSE_UP_FP8) norm_rows_b8(gw, NGW, lane, XB, ffn_norm, XN); else norm_rows_b(gw, NGW, lane, XB, ffn_norm, XN); }
            else {
                __syncthreads();
                LAS unsigned* rbc = (LAS unsigned*)(F.lds + 131072);
                LAS int* rinfo = (LAS int*)(F.lds + 131072 + 64);
                if (tid < 16) rbc[tid] = 0u;
                __syncthreads();
                int nrow = 0;
                f32x4 gn[4]; { const GAS f32x4* gr = (const GAS f32x4*)(ffn_norm + D) + lane;
#pragma unroll
                    for (int j = 0; j < 4; ++j) gn[j] = gr[64 * j]; }
                u32x2 wc[4], wn[4];
#pragma unroll
                for (int j = 0; j < 4; ++j) { wc[j] = (u32x2){0u, 0u}; wn[j] = wc[j]; }
                if (gw < M) row_issue_b(XB + (size_t)gw * D, lane, wn);
                f32x4 rw[16][2];
#pragma unroll
                for (int j = 0; j < 4; ++j)
#pragma unroll
                    for (int i = 0; i < 4; ++i) { const float* rp = router_w + (size_t)(4 * (lane + 64 * j) + i) * NE; rw[4 * j + i][0] = *(const f32x4*)rp; rw[4 * j + i][1] = *(const f32x4*)(rp + 4); }
                for (int m = gw; m < M; m += NGW) {
#pragma unroll
                    for (int j = 0; j < 4; ++j) wc[j] = wn[j];
                    asm volatile("" : "+v"(wc[0]), "+v"(wc[1]), "+v"(wc[2]), "+v"(wc[3]));
                    if (m + NGW < M) row_issue_b(XB + (size_t)(m + NGW) * D, lane, wn);
                    f32x4 v[4]; row_norm_b(wc, gn, v);
                    { GAS unsigned* o8 = (GAS unsigned*)((unsigned char*)XN + (size_t)m * D) + lane;
#pragma unroll
                      for (int j = 0; j < 4; ++j) { const float c0 = __builtin_amdgcn_fmed3f(v[j].x, -448.f, 448.f), c1 = __builtin_amdgcn_fmed3f(v[j].y, -448.f, 448.f), c2 = __builtin_amdgcn_fmed3f(v[j].z, -448.f, 448.f), c3 = __builtin_amdgcn_fmed3f(v[j].w, -448.f, 448.f);
                        unsigned w = __builtin_amdgcn_cvt_pk_fp8_f32(c0, c1, 0, false); w = __builtin_amdgcn_cvt_pk_fp8_f32(c2, c3, w, true); o8[64 * j] = w; } }
                    float lg[NE];
#pragma unroll
                    for (int e = 0; e < NE; ++e) lg[e] = 0.f;
#pragma unroll
                    for (int j = 0; j < 4; ++j) {
                        const int c = 4 * (lane + 64 * j);
#pragma unroll
                        for (int i = 0; i < 4; ++i) {
                            const f32x4 r0 = rw[4 * j + i][0], r1 = rw[4 * j + i][1];
                            const float xv = v[j][i];
                            lg[0] += xv * r0.x; lg[1] += xv * r0.y; lg[2] += xv * r0.z; lg[3] += xv * r0.w;
                            lg[4] += xv * r1.x; lg[5] += xv * r1.y; lg[6] += xv * r1.z; lg[7] += xv * r1.w;
                        }
                    }
#pragma unroll
                    for (int e = 0; e < NE; ++e) lg[e] = wave_sum(lg[e]);
                    if (lane == 0) {
                        int i0 = 0; float b0 = lg[0];
#pragma unroll
                        for (int e = 1; e < NE; ++e) if (lg[e] > b0) { b0 = lg[e]; i0 = e; }
                        int i1 = 0; float b1 = -3.4e38f;
#pragma unroll
                        for (int e = 0; e < NE; ++e) if (e != i0 && lg[e] > b1) { b1 = lg[e]; i1 = e; }
                        const float e1 = __expf(b1 - b0); const float w0 = 1.f / (1.f + e1), w1 = e1 / (1.f + e1);
                        topw[2 * m] = w0; topw[2 * m + 1] = w1;
                        const unsigned q0 = __hip_atomic_fetch_add((LAS unsigned*)(rbc + i0), 1u, __ATOMIC_RELAXED, __HIP_MEMORY_SCOPE_WORKGROUP);
                        const unsigned q1 = __hip_atomic_fetch_add((LAS unsigned*)(rbc + i1), 1u, __ATOMIC_RELAXED, __HIP_MEMORY_SCOPE_WORKGROUP);
                        if (nrow < 16) { rinfo[(pw * 16 + nrow) * 2] = (i0 << 20) | (int)q0; rinfo[(pw * 16 + nrow) * 2 + 1] = (i1 << 20) | (int)q1; }
                    }
                    ++nrow;
                }
                __syncthreads();
                if (tid < NE) rbc[8 + tid] = atomicAdd(&cnt[tid], rbc[tid]);
                __syncthreads();
                { int k = 0;
                  for (int m = gw; m < M; m += NGW, ++k) if (lane == 0 && k < 16) {
#pragma unroll
                    for (int s2 = 0; s2 < 2; ++s2) { const int q = rinfo[(pw * 16 + k) * 2 + s2]; const int e = q >> 20; const int p = (int)rbc[8 + e] + (q & 0xfffff);
                        list[e * M + p] = 2 * m + s2; pairrow[2 * m + s2] = (e << 20) | p; }
                  } }
            }
        }
        SEAM(pb + 7);
        if (IN(pb + 9) && P_ON(9)) { PHASE_BEGIN;
            if (l == 0) {
                pg8::Gemm g{XN, (const bf16_t*)(ws + WS_WD13), D, D, SAq, (const float*)(cmx + 2 * NPROJ)}; pg8::StaticOrder S; S.init(M, 2 * D_FF, pG, pbx);
                pg8::EpiSwiGLU E{HB, D_FF, (!I8_DUP && DENSE_UP_FP8) ? 1.f / W8_SCALE : 1.f, DENSE_DN_FP8 ? H8_SCALE : 0.f};
                pg8::gemm_phase<pg8::EpiSwiGLU, pg8::StaticOrder, true, I8_DUP ? 2 : (DENSE_UP_FP8 ? 1 : 0)>(F.lds + RING_OFF, g, S, E, pw);
            } else {
                pg8::Gemm g{XN, (const bf16_t*)ap->out, D, D}; pg8::MoeGatherOrder S; S.init(cnt, list, 2 * DFE, pG, F.vcu, 7 * MiB / 2, D, pbx);
                pg8::EpiSwiGLU E{Hm, DFE, 1.f / W8_SCALE, H8_SCALE};
                pg8::gemm_phase<pg8::EpiSwiGLU, pg8::MoeGatherOrder, true, true>(F.lds + RING_OFF, g, S, E, pw);
            }
        }
        SEAM(pb + 9);
        if (IN(pb + 10) && P_ON(10)) { PHASE_BEGIN;
            if (l == 0) {
                pg8::Gemm g{HB, (const bf16_t*)(ws + WS_WD2), D_FF, D_FF}; pg8::StaticOrder S; S.init(M, D, pG, pbx);
                pg8::EpiResidB<false> E{XB, XB, DENSE_DN_FP8 ? 1.f / (W8_SCALE * H8_SCALE) : 1.f};
                pg8::gemm_phase<pg8::EpiResidB<false>, pg8::StaticOrder, false, DENSE_DN_FP8 != 0>(F.lds + RING_OFF, g, S, E, pw);
            } else {
                pg8::Gemm g{Hm, (const bf16_t*)(ws + WS_WM2), DFE, DFE}; pg8::MoeOrder S; S.init(cnt, D, pG, F.vcu, 7 * MiB / 4, pbx);
                pg8::EpiStore E{Yb, D, 1.f / (W8_SCALE * H8_SCALE)};
                pg8::gemm_phase<pg8::EpiStore, pg8::MoeOrder, true, true>(F.lds + RING_OFF, g, S, E, pw);
            }
        }
        SEAM(pb + 10);
        if (IN(pb + 11) && P_ON(11)) { PHASE_BEGIN;
            if (l == 0) { if (I8_INPROJ) norm_rows_bi8(gw, NGW, lane, XB, mix_norm + D, XN, SAq); else norm_rows_b(gw, NGW, lane, XB, mix_norm + D, XN); }
            else {
                int oo[NE]; { int a = 0; int cn8[8]; pg8::load_counts8(cnt, cn8);
#pragma unroll
                    for (int e = 0; e < NE; ++e) { oo[e] = a; a += (cn8[e] + 255) & ~255; } }
                const int nrow = (M - gw + NGW - 1) / NGW;
                int mq0 = 0, mq1 = 0; float mw0 = 0.f, mw1 = 0.f;
                if (lane < nrow) { const int mk = gw + lane * NGW; mq0 = pairrow[2 * mk]; mq1 = pairrow[2 * mk + 1]; mw0 = topw[2 * mk]; mw1 = topw[2 * mk + 1]; }
                f32x4 gfin[4]; { const GAS f32x4* gr = (const GAS f32x4*)final_norm + lane;
#pragma unroll
                    for (int j = 0; j < 4; ++j) gfin[j] = gr[64 * j]; }
#define FIN_ISSUE(k, YA, YB, XW) do { const int m_ = gw + (k) * NGW; const int q0_ = __builtin_amdgcn_readlane(mq0, (k)), q1_ = __builtin_amdgcn_readlane(mq1, (k)); int r0_ = q0_ & 0xfffff, r1_ = q1_ & 0xfffff; \
                    _Pragma("unroll") for (int e = 0; e < NE; ++e) { if ((q0_ >> 20) == e) r0_ += oo[e]; if ((q1_ >> 20) == e) r1_ += oo[e]; } \
                    const GAS u32x2* xb_ = (const GAS u32x2*)(XB + (size_t)m_ * D) + lane; const GAS u32x2* y0_ = (const GAS u32x2*)(Yb + (size_t)r0_ * D) + lane; const GAS u32x2* y1_ = (const GAS u32x2*)(Yb + (size_t)r1_ * D) + lane; \
                    _Pragma("unroll") for (int j = 0; j < 4; ++j) { YA[j] = y0_[64 * j]; YB[j] = y1_[64 * j]; XW[j] = xb_[64 * j]; } } while (0)
#define FIN_DO(k, YA, YB, XW) do { const int m_ = gw + (k) * NGW; const float w0 = __builtin_bit_cast(float, __builtin_amdgcn_readlane(__builtin_bit_cast(int, mw0), (k))), w1 = __builtin_bit_cast(float, __builtin_amdgcn_readlane(__builtin_bit_cast(int, mw1), (k))); \
                    GAS f32x4* xr = (GAS f32x4*)(X + (size_t)m_ * D) + lane;                 \
                    f32x4 v[4]; float ss = 0.f; \
                    _Pragma("unroll") for (int j = 0; j < 4; ++j) { const u32x2 a = YA[j], b = YB[j], xw = XW[j]; f32x4 t = (f32x4){bflo(xw.x), bfhi(xw.x), bflo(xw.y), bfhi(xw.y)}; \
                        t.x += w0 * bflo(a.x) + w1 * bflo(b.x); t.y += w0 * bfhi(a.x) + w1 * bfhi(b.x); t.z += w0 * bflo(a.y) + w1 * bflo(b.y); t.w += w0 * bfhi(a.y) + w1 * bfhi(b.y); \
                        v[j] = t; ss += (t.x * t.x + t.y * t.y) + (t.z * t.z + t.w * t.w); } \
                    ss = wave_sum(ss); const float rstd = rsqrtf(ss * (1.f / D) + EPS); \
                    _Pragma("unroll") for (int j = 0; j < 4; ++j) xr[64 * j] = v[j] * gfin[j] * rstd; } while (0)
                u32x2 yan[4], ybn[4], xwn[4];
#pragma unroll
                for (int j = 0; j < 4; ++j) { yan[j] = (u32x2){0u, 0u}; ybn[j] = yan[j]; xwn[j] = yan[j]; }
                if (nrow > 0) FIN_ISSUE(0, yan, ybn, xwn);
#pragma unroll 1
                for (int k = 0; k < nrow; ++k) {
                    u32x2 yac[4], ybc[4], xwc[4];
#pragma unroll
                    for (int j = 0; j < 4; ++j) { yac[j] = yan[j]; ybc[j] = ybn[j]; xwc[j] = xwn[j]; }
                    asm volatile("" : "+v"(yac[0]), "+v"(yac[1]), "+v"(yac[2]), "+v"(yac[3]), "+v"(ybc[0]), "+v"(ybc[1]), "+v"(ybc[2]), "+v"(ybc[3]), "+v"(xwc[0]), "+v"(xwc[1]), "+v"(xwc[2]), "+v"(xwc[3]));
                    if (k + 1 < nrow) FIN_ISSUE(k + 1, yan, ybn, xwn);
                    FIN_DO(k, yac, ybc, xwc);
                }
#undef FIN_ISSUE
#undef FIN_DO
            }
        }
        SEAM(pb + 11);
    }
#undef IN
#undef SEAM
}
#ifndef MEGA_MASK
#define MEGA_MASK 0xFFF
#endif
#ifndef ONE_LAUNCH
#define ONE_LAUNCH 0
#endif
static void launch_mega(hipStream_t st, Args a, int lo, int hi, int grid) {
    a.ph_lo = lo; a.ph_hi = hi;
    hipLaunchKernelGGL(mega_fwd, dim3(grid), dim3(NWAVES * 64), LDS_BYTES, st, a);
}

extern "C" void kernel_launch(void* const* d_in, const int* in_sizes, int n_in, void* d_out, int out_size, void* d_ws, size_t ws_size, hipStream_t stream) {
    static int grid = 0;
    if (grid == 0) {
        int dev = 0, cus = 0, per_cu = 0;
        if (n_in != 25 || out_size != M * D || ws_size < WS_END) { grid = -1; return; }
        if (hipGetDevice(&dev) != hipSuccess || hipDeviceGetAttribute(&cus, hipDeviceAttributeMultiprocessorCount, dev) != hipSuccess) { grid = -1; return; }
        if (hipFuncSetAttribute((const void*)mega_fwd, hipFuncAttributeMaxDynamicSharedMemorySize, LDS_BYTES) != hipSuccess) { grid = -1; return; }
        if (hipOccupancyMaxActiveBlocksPerMultiprocessor(&per_cu, (const void*)mega_fwd, NWAVES * 64, LDS_BYTES) != hipSuccess || per_cu < 1) { (void)hipGetLastError(); }
        (void)hipGetLastError();
        grid = cus;
    }
    if (grid < 0) return;
    (void)hipMemsetAsync((char*)d_ws + WS_CTL, 0, CTL_ZERO_BYTES, stream);
    Args a{};
    for (int i = 0; i < 25; ++i) a.in[i] = (const float*)d_in[i];
    a.out = (float*)d_out; a.ws = (unsigned char*)d_ws; a.flags = 0; a.pad = 0;
#if ONE_LAUNCH
    launch_mega(stream, a, 0, 25, grid);
#else
    const float* x = (const float*)d_in[0]; const int* pos = (const int*)d_in[1];
    const float* mix_norm = (const float*)d_in[2]; const float* w_in = (const float*)d_in[3]; const float* gate_bias = (const float*)d_in[4];
    const float* conv_w = (const float*)d_in[5]; const float* a_log = (const float*)d_in[6]; const float* dt_bias = (const float*)d_in[7];
    const float* gdn_out_norm = (const float*)d_in[8]; const float* w_gdn_o = (const float*)d_in[9]; const float* q_a_norm = (const float*)d_in[10];
    const float* w_q_b = (const float*)d_in[11]; const float* kv_a_norm = (const float*)d_in[12]; const float* w_kv_b = (const float*)d_in[13];
    const float* w_mla_o = (const float*)d_in[14]; const float* w_out = (const float*)d_in[15]; const float* ffn_norm = (const float*)d_in[16];
    const float* dense_w1 = (const float*)d_in[17]; const float* dense_w3 = (const float*)d_in[18]; const float* dense_w2 = (const float*)d_in[19];
    const float* router_w = (const float*)d_in[20]; const float* moe_w1 = (const float*)d_in[21]; const float* moe_w3 = (const float*)d_in[22];
    const float* moe_w2 = (const float*)d_in[23]; const float* final_norm = (const float*)d_in[24];
    float* X = (float*)d_out;
    unsigned char* ws = (unsigned char*)d_ws;
    unsigned* ctl = (unsigned*)(ws + WS_CTL);
    bf16_t* GATE = (bf16_t*)(ws + WS_GATE); bf16_t* Zb = (bf16_t*)(ws + WS_Z); bf16_t* MISC = (bf16_t*)(ws + WS_MISC); bf16_t* QKV = (bf16_t*)(ws + WS_QKV);
    bf16_t* Qb = (bf16_t*)(ws + WS_Q); bf16_t* Kb = (bf16_t*)(ws + WS_K); bf16_t* Vb = (bf16_t*)(ws + WS_V); bf16_t* AO = (bf16_t*)(ws + WS_AO); bf16_t* GO = (bf16_t*)(ws + WS_GO);
    bf16_t* XN = (bf16_t*)(ws + WS_XN); bf16_t* MERGED = (bf16_t*)(ws + WS_MERGED);
    bf16_t* HB = (bf16_t*)(ws + WS_HB); bf16_t* XG = (bf16_t*)(ws + WS_XG); bf16_t* Hm = (bf16_t*)(ws + WS_H); bf16_t* Yb = (bf16_t*)(ws + WS_Y);
    bf16_t* QN = (bf16_t*)(ws + WS_QN); bf16_t* KN = (bf16_t*)(ws + WS_KN); bf16_t* VN = (bf16_t*)(ws + WS_VN); bf16_t* QRAW = (bf16_t*)(ws + WS_QRAW);
    float* ORAW = (float*)(ws + WS_ORAW);
    float* rstdq = (float*)(ws + WS_RSTD); float* rstdkv = rstdq + M;
    float* gbuf = (float*)(ws + WS_GB); float* bbuf = gbuf + M * 4;
    int* topi = (int*)(ws + WS_MOE); float* topw = (float*)(topi + 2 * M); int* pairrow = (int*)(topw + 2 * M); int* list = pairrow + 2 * M; int* offs = list + NE * M;
    unsigned* cnt = ctl + CW_CNT;
    const int mask = MEGA_MASK;
#define USE_MEGA(s) ((mask >> (s)) & 1)
    launch_mega(stream, a, 0, 1, grid);
    for (int l = 0; l < 2; ++l) {
        const int pb = 1 + 12 * l;
        const float* xin = (l == 0) ? x : X;
        const float* wi = w_in + (size_t)l * D * IN_COLS;
        if (USE_MEGA(0)) launch_mega(stream, a, pb + 0, pb + 1, grid);
        else {
            EpiArgs e0{}; e0.mode = 0;
            e0.ob = QKV; e0.ldo = QKV_LD; e0.col0 = 0;      gemm(stream, false, XN, D, wi, nullptr, IN_COLS, WC_Q, M, 1536, D, e0);
            e0.ob = Zb; e0.ldo = Z_LD; e0.col0 = 0;         gemm(stream, false, XN, D, wi, nullptr, IN_COLS, WC_Z, M, 512, D, e0);
            e0.ob = MISC; e0.ldo = MISC_LD; e0.col0 = MC_A; gemm(stream, false, XN, D, wi, nullptr, IN_COLS, WC_A, M, 8, D, e0);
            e0.col0 = MC_CQ;  gemm(stream, false, XN, D, wi, nullptr, IN_COLS, WC_CQ, M, 384, D, e0);
            e0.col0 = MC_CKV; gemm(stream, false, XN, D, wi, nullptr, IN_COLS, WC_CKV, M, 256, D, e0);
            e0.col0 = MC_KR;  gemm(stream, false, XN, D, wi, nullptr, IN_COLS, WC_KR, M, 32, D, e0);
            EpiArgs e1{}; e1.mode = 1; e1.ob = GATE; e1.ldo = GATE_LD; e1.col0 = 0; e1.bias = gate_bias + l * 2048;
            gemm(stream, false, XN, D, wi, nullptr, IN_COLS, WC_GATE, M, 2048, D, e1);
        }
        if (USE_MEGA(1)) { launch_mega(stream, a, pb + 1, pb + 2, grid); launch_mega(stream, a, pb + 2, pb + 3, grid); }
        else {
            hipLaunchKernelGGL(k_gdn_prep, dim3(M), dim3(256), 0, stream, (const bf16_t*)QKV, (const bf16_t*)MISC, conv_w + l * 4 * 1536, a_log + l * 4, dt_bias + l * 4, QN, KN, VN, gbuf, bbuf);
            hipLaunchKernelGGL(k_gdn_rec, dim3(32, 16), dim3(1024), 0, stream, (const bf16_t*)QN, (const bf16_t*)KN, (const bf16_t*)VN, (const float*)gbuf, (const float*)bbuf, ORAW);
            hipLaunchKernelGGL(k_mla_prep, dim3(M / 4), dim3(256), 0, stream, (const bf16_t*)MISC, pos, rstdq, rstdkv, Kb);
        }
        if (USE_MEGA(3)) launch_mega(stream, a, pb + 3, pb + 4, grid);
        else {
            EpiArgs eq{}; eq.mode = 0; eq.ob = QRAW; eq.ldo = 768; eq.col0 = 0; eq.kgain = q_a_norm + l * 384; eq.rowscale = rstdq;
            gemm(stream, false, MISC + MC_CQ, MISC_LD, w_q_b + (size_t)l * 384 * 768, nullptr, 768, 0, M, 768, 384, eq);
            hipLaunchKernelGGL(k_q_rope, dim3(M * 768 / 256), dim3(256), 0, stream, (const bf16_t*)QRAW, pos, Qb);
            EpiArgs ekv{}; ekv.mode = 6; ekv.ob = Kb; ekv.ob2 = Vb; ekv.kgain = kv_a_norm + l * 256; ekv.rowscale = rstdkv;
            gemm(stream, false, MISC + MC_CKV, MISC_LD, w_kv_b + (size_t)l * 256 * 1024, nullptr, 1024, 0, M, 1024, 256, ekv);
        }
        if (USE_MEGA(4)) launch_mega(stream, a, pb + 4, pb + 5, grid);
        else {
            hipLaunchKernelGGL(k_attn, dim3(M * 8 / 4), dim3(256), 0, stream, (const bf16_t*)Qb, (const bf16_t*)Kb, (const bf16_t*)Vb, AO);
            hipLaunchKernelGGL(k_gdn_gate, dim3(M / 4), dim3(256), 0, stream, (const float*)ORAW, (const bf16_t*)Zb, gdn_out_norm + l * 128, GO);
        }
        if (USE_MEGA(5)) launch_mega(stream, a, pb + 5, pb + 6, grid);
        else {
            EpiArgs em{}; em.mode = 2; em.ob = MERGED; em.ldo = D; em.gate = GATE; em.ldg = GATE_LD; em.gcol0 = 0;
            gemm(stream, false, GO, 512, w_gdn_o + (size_t)l * 512 * D, nullptr, D, 0, M, D, 512, em);
            em.mode = 3; em.gcol0 = D;
            gemm(stream, false, AO, 512, w_mla_o + (size_t)l * 512 * D, nullptr, D, 0, M, D, 512, em);
        }
        if (USE_MEGA(6)) launch_mega(stream, a, pb + 6, pb + 7, grid);
        else { EpiArgs eo{}; eo.mode = 4; eo.res = xin; eo.of = X; gemm(stream, false, MERGED, D, w_out + (size_t)l * D * D, nullptr, D, 0, M, D, D, eo); }
        if (USE_MEGA(7)) launch_mega(stream, a, pb + 7, pb + 8, grid);
        else hipLaunchKernelGGL(k_rmsnorm, dim3(M / 4), dim3(256), 0, stream, (const float*)X, ffn_norm + l * D, XN, (float*)nullptr, l, router_w, topi, topw, cnt, list);
        if (l == 1) {
            if (USE_MEGA(8)) launch_mega(stream, a, pb + 8, pb + 9, grid);
            else {
                hipLaunchKernelGGL(k_moe_offsets, dim3(1), dim3(64), 0, stream, (const unsigned*)cnt, offs);
                hipLaunchKernelGGL(k_moe_gather, dim3(MOE_ROWS / 4), dim3(256), 0, stream, (const bf16_t*)XN, (const unsigned*)cnt, (const int*)offs, (const int*)list, XG, pairrow);
            }
        }
        if (USE_MEGA(9)) launch_mega(stream, a, pb + 9, pb + 10, grid);
        else if (l == 0) { EpiArgs eu{}; eu.mode = 5; eu.ob = HB; eu.ldo = D_FF; gemm(stream, true, XN, D, dense_w1, dense_w3, D_FF, 0, M, D_FF, D, eu); }
        else { EpiArgs eu{}; eu.mode = 5; eu.ob = Hm; eu.ldo = DFE; gemm(stream, true, XG, D, moe_w1, moe_w3, DFE, 0, MOE_ROWS, DFE, D, eu, offs, (size_t)D * DFE); }
        if (USE_MEGA(10)) launch_mega(stream, a, pb + 10, pb + 11, grid);
        else if (l == 0) { EpiArgs ed{}; ed.mode = 4; ed.res = X; ed.of = X; gemm(stream, false, HB, D_FF, dense_w2, nullptr, D, 0, M, D, D_FF, ed); }
        else { EpiArgs ed{}; ed.mode = 0; ed.ob = Yb; ed.ldo = D; ed.col0 = 0; gemm(stream, false, Hm, DFE, moe_w2, nullptr, D, 0, MOE_ROWS, D, DFE, ed, offs, (size_t)DFE * D); }
        if (USE_MEGA(11)) launch_mega(stream, a, pb + 11, pb + 12, grid);
        else if (l == 0) hipLaunchKernelGGL(k_rmsnorm, dim3(M / 4), dim3(256), 0, stream, (const float*)X, mix_norm + D, XN, (float*)nullptr, 0, (const float*)nullptr, (int*)nullptr, (float*)nullptr, (unsigned*)nullptr, (int*)nullptr);
        else {
            hipLaunchKernelGGL(k_moe_combine, dim3(M / 4), dim3(256), 0, stream, X, (const bf16_t*)Yb, (const int*)pairrow, (const float*)topw);
            hipLaunchKernelGGL(k_rmsnorm, dim3(M / 4), dim3(256), 0, stream, (const float*)X, final_norm, (bf16_t*)nullptr, X, 2, (const float*)nullptr, (int*)nullptr, (float*)nullptr, (unsigned*)nullptr, (int*)nullptr);
        }
    }
#undef USE_MEGA
#endif
}
```
